# Optimizing an MI355X kernel written in HIP

```python
import math
import jax, jax.numpy as jnp
from jax import lax
import numpy as np

D_MODEL = 2048
BATCH = 4
SEQ = 4096
DEPTH = 1

NORM_EPS = 1e-6
ROPE_THETA = 500000.0
MAX_POS_OFFSET = 1024
ADALN_CHUNKS = 6

MLA_HEADS = 8
Q_LORA_RANK = 512
KV_LORA_RANK = 512
QK_NOPE_DIM = 128
QK_ROPE_DIM = 64
V_HEAD_DIM = 128
MLA_QK_DIM = QK_NOPE_DIM + QK_ROPE_DIM
Q_BLOCK = 128

DIL_PATTERNS = ((128, 1), (512, 4), (2048, 16))
DIL_GROUPS = len(DIL_PATTERNS)
DIL_HEADS_PER_GROUP = 4
DIL_HEADS = DIL_GROUPS * DIL_HEADS_PER_GROUP
DIL_HEAD_DIM = 128
DIL_ROT_DIM = DIL_HEAD_DIM // 4
DIL_BLOCK = max(w // d for (w, d) in DIL_PATTERNS)

IN_SIZES = (Q_LORA_RANK, KV_LORA_RANK + QK_ROPE_DIM, 3 * DIL_HEADS * DIL_HEAD_DIM, D_MODEL, D_MODEL)
IN_COLS = sum(IN_SIZES)
IN_SPLITS = [int(v) for v in np.cumsum(IN_SIZES)[:-1]]

N_EXPERTS = 64
N_EXPERT_GROUPS = 8
TOPK_GROUPS = 4
TOP_K = 6
EXPERT_DIM = 512
SHARED_DIM = 512
ROUTED_SCALE = 2.5
MOE_BLOCK = 256

kernel_name = "hybrid_mla_dilated_moe_block"


def rms_norm(x, g):
    xf = x.astype(jnp.float32)
    xf = xf * lax.rsqrt(jnp.mean(xf * xf, axis=-1, keepdims=True) + NORM_EPS)
    return (xf * g.astype(jnp.float32)).astype(x.dtype)


def rope_cos_sin(positions, dim):
    inv_freq = 1.0 / (ROPE_THETA ** (jnp.arange(0, dim, 2, dtype=jnp.float32) / dim))
    ang = positions.astype(jnp.float32)[..., None] * inv_freq
    return jnp.cos(ang)[:, :, None, :], jnp.sin(ang)[:, :, None, :]


def apply_rope(t, cos, sin):
    half = t.shape[-1] // 2
    t1 = t[..., :half].astype(jnp.float32)
    t2 = t[..., half:].astype(jnp.float32)
    return jnp.concatenate([t1 * cos - t2 * sin, t2 * cos + t1 * sin], axis=-1).astype(t.dtype)


def causal_block_attention(q, k, v, scale):
    B, S, H, Dq = q.shape
    Dv = v.shape[-1]
    nb = S // Q_BLOCK
    qb = q.reshape(B, nb, Q_BLOCK, H, Dq).swapaxes(0, 1)
    kpos = jnp.arange(S)

    def one_block(args):
        qi, i = args
        s = jnp.einsum('bqhd,bkhd->bhqk', qi, k, preferred_element_type=jnp.float32) * scale
        qpos = i * Q_BLOCK + jnp.arange(Q_BLOCK)
        s = jnp.where((kpos[None, :] <= qpos[:, None])[None, None], s, -jnp.inf)
        p = jax.nn.softmax(s, axis=-1).astype(v.dtype)
        return jnp.einsum('bhqk,bkhd->bqhd', p, v)

    o = lax.map(one_block, (qb, jnp.arange(nb)))
    return o.swapaxes(0, 1).reshape(B, S, H, Dv)


def mla_branch(q_a, kv_a, cos, sin, q_a_norm_g, w_q_up, kv_a_norm_g, w_kv_up, w_mla_o):
    B, S, _ = q_a.shape
    q = (rms_norm(q_a, q_a_norm_g) @ w_q_up).reshape(B, S, MLA_HEADS, MLA_QK_DIM)
    q_nope, q_rope = q[..., :QK_NOPE_DIM], q[..., QK_NOPE_DIM:]
    q = jnp.concatenate([q_nope, apply_rope(q_rope, cos, sin)], axis=-1)
    c_kv, k_rope = kv_a[..., :KV_LORA_RANK], kv_a[..., KV_LORA_RANK:]
    kv = (rms_norm(c_kv, kv_a_norm_g) @ w_kv_up).reshape(B, S, MLA_HEADS, QK_NOPE_DIM + V_HEAD_DIM)
    k_nope, v = kv[..., :QK_NOPE_DIM], kv[..., QK_NOPE_DIM:]
    k_rope = apply_rope(k_rope[:, :, None, :], cos, sin)
    k = jnp.concatenate([k_nope, jnp.broadcast_to(k_rope, (B, S, MLA_HEADS, QK_ROPE_DIM))], axis=-1)
    o = causal_block_attention(q, k, v, MLA_QK_DIM ** -0.5)
    return o.reshape(B, S, MLA_HEADS * V_HEAD_DIM) @ w_mla_o


def dilated_group_attention(q, k, v, window, dilation):
    B, S, H, Dh = q.shape
    L = S // dilation
    W = window // dilation
    blk = DIL_BLOCK
    nb = -(-L // blk)
    Lp = nb * blk

    def to_blocks(t):
        t = t.reshape(B, L, dilation, H, Dh).transpose(0, 2, 1, 3, 4).reshape(B * dilation, L, H, Dh)
        t = jnp.pad(t, ((0, 0), (0, Lp - L), (0, 0), (0, 0)))
        return t.reshape(B * dilation, nb, blk, H, Dh)

    def with_prev(t):
        prev = jnp.pad(t[:, :-1], ((0, 0), (1, 0), (0, 0), (0, 0), (0, 0)))
        return jnp.concatenate([prev, t], axis=2)

    qb = to_blocks(q)
    kw = with_prev(to_blocks(k))
    vw = with_prev(to_blocks(v))
    s = jnp.einsum('nbqhd,nbkhd->nbhqk', qb, kw, preferred_element_type=jnp.float32) * (Dh ** -0.5)
    qi = jnp.arange(blk)
    kj = jnp.arange(2 * blk)
    dist = qi[:, None] + blk - kj[None, :]
    band = (dist >= 0) & (dist <= W)
    key_exists = (jnp.arange(nb)[:, None] * blk + kj[None, :] - blk) >= 0
    mask = band[None] & key_exists[:, None, :]
    s = jnp.where(mask[None, :, None], s, -jnp.inf)
    lse = jax.nn.logsumexp(s, axis=-1)
    p = jnp.exp(s - lse[..., None]).astype(v.dtype)
    o = jnp.einsum('nbhqk,nbkhd->nbqhd', p, vw)
    o = o.reshape(B * dilation, Lp, H, Dh)[:, :L]
    o = o.reshape(B, dilation, L, H, Dh).transpose(0, 2, 1, 3, 4).reshape(B, S, H, Dh)
    lse = lse.transpose(0, 1, 3, 2).reshape(B * dilation, Lp, H)[:, :L]
    lse = lse.reshape(B, dilation, L, H).transpose(0, 2, 1, 3).reshape(B, S, H)
    return o, lse


def dilated_branch(dil, cos, sin, w_dil_o):
    B, S, _ = dil.shape
    q, k, v = [t.reshape(B, S, DIL_HEADS, DIL_HEAD_DIM) for t in jnp.split(dil, 3, axis=-1)]

    def partial_rope(t):
        return jnp.concatenate([apply_rope(t[..., :DIL_ROT_DIM], cos, sin), t[..., DIL_ROT_DIM:]], axis=-1)

    q, k = partial_rope(q), partial_rope(k)
    outs, lses = [], []
    for gi, (window, dilation) in enumerate(DIL_PATTERNS):
        sl = slice(gi * DIL_HEADS_PER_GROUP, (gi + 1) * DIL_HEADS_PER_GROUP)
        o, lse = dilated_group_attention(q[:, :, sl], k[:, :, sl], v[:, :, sl], window, dilation)
        outs.append(o)
        lses.append(lse)
    wts = jax.nn.softmax(jnp.stack(lses), axis=0).astype(dil.dtype)
    o = jnp.einsum('gbsh,gbshd->bshd', wts, jnp.stack(outs))
    return o.reshape(B, S, DIL_HEADS_PER_GROUP * DIL_HEAD_DIM) @ w_dil_o


def token_mixer(h, cos_m, sin_m, cos_d, sin_d, w_in, q_a_norm_g, w_q_up, kv_a_norm_g, w_kv_up,
                w_mla_o, w_dil_o, w_out):
    proj = h @ w_in
    q_a, kv_a, dil, g_a, g_b = jnp.split(proj, IN_SPLITS, axis=-1)
    y_a = mla_branch(q_a, kv_a, cos_m, sin_m, q_a_norm_g, w_q_up, kv_a_norm_g, w_kv_up, w_mla_o)
    y_b = dilated_branch(dil, cos_d, sin_d, w_dil_o)
    merged = jax.nn.sigmoid(g_a) * y_a + jax.nn.sigmoid(g_b) * y_b
    return merged @ w_out


def swiglu(t, wg, wu, wd):
    return (jax.nn.silu(t @ wg) * (t @ wu)) @ wd


def moe(h, w_router, router_bias, w_exp_gate, w_exp_up, w_exp_down, w_sh_gate, w_sh_up, w_sh_down):
    N, D = h.shape
    scores = jax.nn.sigmoid((h @ w_router).astype(jnp.float32))
    biased = scores + router_bias.astype(jnp.float32)
    per_group = N_EXPERTS // N_EXPERT_GROUPS
    grp_score = lax.top_k(biased.reshape(N, N_EXPERT_GROUPS, per_group), 2)[0].sum(-1)
    _, grp_idx = lax.top_k(grp_score, TOPK_GROUPS)
    grp_mask = jax.nn.one_hot(grp_idx, N_EXPERT_GROUPS, dtype=jnp.float32).sum(1) > 0
    sel = jnp.where(jnp.repeat(grp_mask, per_group, axis=1), biased, -jnp.inf)
    _, top_idx = lax.top_k(sel, TOP_K)
    top_w = jnp.take_along_axis(scores, top_idx, axis=-1)
    top_w = top_w / (top_w.sum(-1, keepdims=True) + 1e-20) * ROUTED_SCALE

    A = N * TOP_K
    blk = MOE_BLOCK
    flat_e = top_idx.reshape(-1).astype(jnp.int32)
    flat_tok = jnp.repeat(jnp.arange(N, dtype=jnp.int32), TOP_K)
    flat_w = top_w.reshape(-1)
    order = jnp.argsort(flat_e)
    se, st, sw = flat_e[order], flat_tok[order], flat_w[order]
    counts = jnp.bincount(flat_e, length=N_EXPERTS).astype(jnp.int32)
    starts = jnp.cumsum(counts) - counts
    pcounts = (counts + blk - 1) // blk * blk
    pends = jnp.cumsum(pcounts)
    pstarts = pends - pcounts
    dest = pstarts[se] + (jnp.arange(A, dtype=jnp.int32) - starts[se])
    nb = -(-(A + N_EXPERTS * (blk - 1)) // blk)
    P = nb * blk
    buf_tok = jnp.full((P,), N, jnp.int32).at[dest].set(st)
    buf_w = jnp.zeros((P,), jnp.float32).at[dest].set(sw)
    blk_e = jnp.minimum(jnp.searchsorted(pends, jnp.arange(nb, dtype=jnp.int32) * blk, side='right'),
                        N_EXPERTS - 1).astype(jnp.int32)
    h_pad = jnp.concatenate([h, jnp.zeros((1, D), h.dtype)], axis=0)

    def expert_block(args):
        tok, wt, e = args
        xi = h_pad[tok]
        y = swiglu(xi, w_exp_gate[e], w_exp_up[e], w_exp_down[e])
        return y * wt[:, None].astype(y.dtype)

    yb = lax.map(expert_block, (buf_tok.reshape(nb, blk), buf_w.reshape(nb, blk), blk_e))
    routed = jax.ops.segment_sum(yb.reshape(P, D), buf_tok, num_segments=N + 1)[:N]
    return routed + swiglu(h, w_sh_gate, w_sh_up, w_sh_down)


def setup_inputs(seed: int = 0) -> dict:
    key = jax.random.key(seed)
    ks = jax.random.split(key, 32)
    L = DEPTH

    def nrm(k, shape, scale):
        return jax.random.normal(k, shape, jnp.float32) * scale

    return {
        "x": nrm(ks[0], (BATCH, SEQ, D_MODEL), 1.0),
        "c": nrm(ks[1], (BATCH, D_MODEL), 1.0),
        "positions": (jnp.arange(SEQ, dtype=jnp.int32)[None, :]
                      + jax.random.randint(ks[2], (BATCH, 1), 0, MAX_POS_OFFSET, dtype=jnp.int32)),
        "w_ada": nrm(ks[3], (L, D_MODEL, ADALN_CHUNKS * D_MODEL), 0.5 * D_MODEL ** -0.5),
        "b_ada": nrm(ks[4], (L, ADALN_CHUNKS * D_MODEL), 0.02),
        "attn_pre_g": 1.0 + nrm(ks[5], (L, D_MODEL), 0.1),
        "w_in": nrm(ks[6], (L, D_MODEL, IN_COLS), D_MODEL ** -0.5),
        "q_a_norm_g": 1.0 + nrm(ks[7], (L, Q_LORA_RANK), 0.1),
        "w_q_up": nrm(ks[8], (L, Q_LORA_RANK, MLA_HEADS * MLA_QK_DIM), Q_LORA_RANK ** -0.5),
        "kv_a_norm_g": 1.0 + nrm(ks[9], (L, KV_LORA_RANK), 0.1),
        "w_kv_up": nrm(ks[10], (L, KV_LORA_RANK, MLA_HEADS * (QK_NOPE_DIM + V_HEAD_DIM)), KV_LORA_RANK ** -0.5),
        "w_mla_o": nrm(ks[11], (L, MLA_HEADS * V_HEAD_DIM, D_MODEL), (MLA_HEADS * V_HEAD_DIM) ** -0.5),
        "w_dil_o": nrm(ks[12], (L, DIL_HEADS_PER_GROUP * DIL_HEAD_DIM, D_MODEL),
                       (DIL_HEADS_PER_GROUP * DIL_HEAD_DIM) ** -0.5),
        "w_out": nrm(ks[13], (L, D_MODEL, D_MODEL), D_MODEL ** -0.5),
        "attn_post_g": 1.0 + nrm(ks[14], (L, D_MODEL), 0.1),
        "ffn_pre_g": 1.0 + nrm(ks[15], (L, D_MODEL), 0.1),
        "w_router": nrm(ks[16], (L, D_MODEL, N_EXPERTS), D_MODEL ** -0.5),
        "router_bias": nrm(ks[17], (L, N_EXPERTS), 0.01),
        "w_exp_gate": nrm(ks[18], (L, N_EXPERTS, D_MODEL, EXPERT_DIM), D_MODEL ** -0.5),
        "w_exp_up": nrm(ks[19], (L, N_EXPERTS, D_MODEL, EXPERT_DIM), D_MODEL ** -0.5),
        "w_exp_down": nrm(ks[20], (L, N_EXPERTS, EXPERT_DIM, D_MODEL), EXPERT_DIM ** -0.5),
        "w_sh_gate": nrm(ks[21], (L, D_MODEL, SHARED_DIM), D_MODEL ** -0.5),
        "w_sh_up": nrm(ks[22], (L, D_MODEL, SHARED_DIM), D_MODEL ** -0.5),
        "w_sh_down": nrm(ks[23], (L, SHARED_DIM, D_MODEL), SHARED_DIM ** -0.5),
        "ffn_post_g": 1.0 + nrm(ks[24], (L, D_MODEL), 0.1),
    }


def reference(x, c, positions, w_ada, b_ada, attn_pre_g, w_in, q_a_norm_g, w_q_up, kv_a_norm_g,
              w_kv_up, w_mla_o, w_dil_o, w_out, attn_post_g, ffn_pre_g, w_router, router_bias,
              w_exp_gate, w_exp_up, w_exp_down, w_sh_gate, w_sh_up, w_sh_down, ffn_post_g):
    B, S, D = x.shape
    cos_m, sin_m = rope_cos_sin(positions, QK_ROPE_DIM)
    cos_d, sin_d = rope_cos_sin(positions, DIL_ROT_DIM)
    for l in range(DEPTH):
        mod = (jax.nn.silu(c) @ w_ada[l] + b_ada[l])[:, None, :]
        shift_a, scale_a, gate_a, shift_f, scale_f, gate_f = jnp.split(mod, ADALN_CHUNKS, axis=-1)
        h = rms_norm(x, attn_pre_g[l]) * (1.0 + scale_a) + shift_a
        y = token_mixer(h, cos_m, sin_m, cos_d, sin_d, w_in[l], q_a_norm_g[l], w_q_up[l],
                        kv_a_norm_g[l], w_kv_up[l], w_mla_o[l], w_dil_o[l], w_out[l])
        x = x + gate_a * rms_norm(y, attn_post_g[l])
        h = rms_norm(x, ffn_pre_g[l]) * (1.0 + scale_f) + shift_f
        y = moe(h.reshape(B * S, D), w_router[l], router_bias[l], w_exp_gate[l], w_exp_up[l],
                w_exp_down[l], w_sh_gate[l], w_sh_up[l], w_sh_down[l]).reshape(B, S, D)
        x = x + gate_f * rms_norm(y, ffn_post_g[l])
    return x
```

```cpp
#include <hip/hip_runtime.h>
#include <cstdio>
#include <cstdint>
#include <cmath>

#ifndef MK_LAUNCHES
#define MK_LAUNCHES 1
#endif
#ifndef MK_DIAG
#define MK_DIAG 0
#endif

#define GAS __attribute__((address_space(1)))
#define LAS __attribute__((address_space(3)))
typedef _Float16 h16;
typedef _Float16 h16x8 __attribute__((ext_vector_type(8)));
typedef _Float16 h16x4 __attribute__((ext_vector_type(4)));
typedef _Float16 h16x2 __attribute__((ext_vector_type(2)));
typedef short s16x4 __attribute__((ext_vector_type(4)));
typedef float f32x4 __attribute__((ext_vector_type(4)));
typedef float f32x2 __attribute__((ext_vector_type(2)));
typedef float f32x16 __attribute__((ext_vector_type(16)));
typedef unsigned u32x4 __attribute__((ext_vector_type(4)));
typedef unsigned u32x2 __attribute__((ext_vector_type(2)));

constexpr int NB = 4, SEQ = 4096, NTOK = NB * SEQ, DM = 2048;
constexpr int NPROJ = 9984;
constexpr int NEXP = 64, TOPK = 6, EDIM = 512;
constexpr int LISTCAP = 16384;
constexpr int MAXTILES = 512;
constexpr float EPS = 1e-6f;
constexpr float LOG2E = 1.4426950408889634f;
constexpr float QS_M = 0.07216878364870322f * LOG2E;
constexpr float QS_D = 0.08838834764831845f * LOG2E;

constexpr size_t MiB = 1u << 20;
constexpr size_t WS_CTL = 0, CTL_ZERO_BYTES = 1 * MiB;
constexpr size_t WS_ROWSQ = 1 * MiB;
constexpr size_t WS_MOD = 2 * MiB;
constexpr size_t WS_COSD = 3 * MiB, WS_SIND = 4 * MiB;
constexpr size_t WS_COSM = 5 * MiB, WS_SINM = 7 * MiB;
constexpr size_t WS_LSE = 9 * MiB;
constexpr size_t WS_TOKPOS = 10 * MiB;
constexpr size_t WS_TOKW = 10 * MiB + 512 * 1024;
constexpr size_t WS_LIST = 11 * MiB;
constexpr size_t WS_W = 16 * MiB;
constexpr size_t W_IN = WS_W;
constexpr size_t W_QUP = W_IN + 39 * MiB;
constexpr size_t W_KVUP = W_QUP + 3 * MiB / 2;
constexpr size_t W_MO = W_KVUP + 2 * MiB;
constexpr size_t W_DO = W_MO + 4 * MiB;
constexpr size_t W_OUT = W_DO + 2 * MiB;
constexpr size_t W_R = W_OUT + 8 * MiB;
constexpr size_t W_GU = W_R + MiB / 4;
constexpr size_t W_DN = W_GU + 260 * MiB;
constexpr size_t WS_AR = W_DN + 130 * MiB;
static_assert(WS_AR == (16 + 447) * MiB - MiB / 4, "weights");
constexpr size_t AR = ((WS_AR + MiB - 1) / MiB) * MiB;
constexpr size_t A_YS = AR + 0 * MiB;
constexpr size_t A_ACT = AR + 512 * MiB;
constexpr size_t A_H2 = AR + 0 * MiB;
constexpr size_t A_YAT = AR + 64 * MiB;
constexpr size_t A_MRG = AR + 128 * MiB;
constexpr size_t A_GATE = AR + 192 * MiB;
constexpr size_t A_M1 = AR + 320 * MiB;
constexpr size_t A_ODIL = AR + 384 * MiB;
constexpr size_t A_OMLA = AR + 400 * MiB;
constexpr size_t A_OD = AR + 432 * MiB;
constexpr size_t A_DIL = AR + 0 * MiB;
constexpr size_t A_QM = AR + 144 * MiB;
constexpr size_t A_KV = AR + 480 * MiB;
constexpr size_t A_KR = AR + 544 * MiB;
constexpr size_t A_QA = AR + 546 * MiB;
constexpr size_t A_H1 = AR + 480 * MiB;
constexpr size_t WS_END = AR + 640 * MiB;

constexpr int CW_BAR = 0;
constexpr int CW_CNT = 16384;
constexpr int CW_DIAG = 32768;

constexpr int LDS_BYTES = 147456;
constexpr int LDS_TAB = 131072;
constexpr int LDS_MISC = LDS_BYTES - 64;
constexpr int NWAVES = 8, NTHR = 512;

#define LDS_WAIT() asm volatile("s_waitcnt lgkmcnt(0)" ::: "memory")
#define VM_WAIT() asm volatile("s_waitcnt vmcnt(0)" ::: "memory")

__device__ __forceinline__ unsigned pkh(float a, float b) { h16x2 r; r.x = (h16)a; r.y = (h16)b; return __builtin_bit_cast(unsigned, r); }
__device__ __forceinline__ u32x4 pk8(f32x4 a, f32x4 b) { u32x4 w; w.x = pkh(a[0], a[1]); w.y = pkh(a[2], a[3]); w.z = pkh(b[0], b[1]); w.w = pkh(b[2], b[3]); return w; }
__device__ __forceinline__ float wave_sum(float v) {
#pragma unroll
    for (int o = 1; o < 64; o <<= 1) v += __shfl_xor(v, o);
    return v;
}
__device__ __forceinline__ float sigmoidf_(float x) { return 1.0f / (1.0f + __expf(-x)); }

#define XB_TMO      128
#define XB_XCNT(j)  (256  + 64 * (j))
#define XB_XSUB(j)  (1280 + 64 * (j))
#define XB_XGEN(j)  (2304 + 64 * (j))
#define XB_TOP      3328
#define XB_TOPGEN   3392
#define XCD_BAR_WORDS 3456
#define XB_SPIN_CAP (1u << 18)
__device__ __forceinline__ unsigned xb_ld(unsigned* p)              { return __hip_atomic_load(p, __ATOMIC_RELAXED, __HIP_MEMORY_SCOPE_AGENT); }
__device__ __forceinline__ unsigned xb_add(unsigned* p, unsigned v) { return __hip_atomic_fetch_add(p, v, __ATOMIC_RELAXED, __HIP_MEMORY_SCOPE_AGENT); }
__device__ __forceinline__ unsigned xb_xcc_id() { return (unsigned)__builtin_amdgcn_s_getreg((3 << 11) | 20) & 0xFu; }
#define XB_SPIN(cond, bar) do { unsigned _sp = 0; while (cond) { __builtin_amdgcn_s_sleep(1); \
    if ((++_sp & 255u) == 0u) { if (xb_ld(&(bar)[XB_TMO])) break; if (_sp > XB_SPIN_CAP) { atomicAdd(&(bar)[XB_TMO], 1u); break; } } } } while (0)
struct XcdBarrier { unsigned* bar; unsigned x; volatile LAS unsigned* st; };
__device__ __forceinline__ XcdBarrier xcd_barrier_post(unsigned* bar, volatile LAS unsigned* st) {
    XcdBarrier b; b.bar = bar; b.x = xb_xcc_id(); b.st = st;
    if (threadIdx.x == 0) (void)xb_add(&bar[XB_XCNT(b.x)], 1u);
    return b;
}
__device__ __forceinline__ void xcd_barrier_complete(unsigned* bar, unsigned x, unsigned& nloc, unsigned& nx) {
    const unsigned G = gridDim.x * gridDim.y * gridDim.z;
    unsigned sum, cnt, mine, sp = 0u;
    for (;;) {
        sum = 0u; cnt = 0u; mine = 0u;
#pragma unroll
        for (unsigned j = 0; j < 16; ++j) { const unsigned c = xb_ld(&bar[XB_XCNT(j)]); sum += c; cnt += (c > 0u) ? 1u : 0u; mine = (j == x) ? c : mine; }
        if (sum == G) break;
        __builtin_amdgcn_s_sleep(1);
        if ((++sp & 255u) == 0u) { if (xb_ld(&bar[XB_TMO])) break; if (sp > XB_SPIN_CAP) { atomicAdd(&bar[XB_TMO], 1u); break; } }
    }
    nloc = mine > 0u ? mine : 1u; nx = cnt > 0u ? cnt : 1u;
}
__device__ __forceinline__ void xcd_barrier(const XcdBarrier& b) {
    asm volatile("s_waitcnt vmcnt(0)" ::: "memory");
    __syncthreads();
    if (threadIdx.x == 0) {
        unsigned* bar = b.bar;
        __builtin_amdgcn_s_waitcnt(0);
        unsigned nloc = b.st[0], nx = b.st[1];
        if (nloc == 0u) { xcd_barrier_complete(bar, b.x, nloc, nx); b.st[0] = nloc; b.st[1] = nx; }
        const unsigned old = xb_add(&bar[XB_XSUB(b.x)], 1u);
        const unsigned gen = old / nloc;
        if (old + 1u == (gen + 1u) * nloc) {
            __builtin_amdgcn_fence(__ATOMIC_RELEASE, "agent");
            asm volatile("s_waitcnt vmcnt(0)" ::: "memory");
            const unsigned og = xb_add(&bar[XB_TOP], 1u);
            const unsigned tg = og / nx;
            if (og + 1u == (tg + 1u) * nx) xb_add(&bar[XB_TOPGEN], 1u);
            else XB_SPIN(xb_ld(&bar[XB_TOPGEN]) == tg, bar);
            __builtin_amdgcn_fence(__ATOMIC_ACQUIRE, "agent");
            xb_add(&bar[XB_XGEN(b.x)], 1u);
            asm volatile("s_waitcnt vmcnt(0)" ::: "memory");
        } else {
            XB_SPIN(xb_ld(&bar[XB_XGEN(b.x)]) == gen, bar);
            __builtin_amdgcn_fence(__ATOMIC_ACQUIRE, "agent");
            asm volatile("s_waitcnt vmcnt(0)" ::: "memory");
        }
    }
    __syncthreads();
}

struct Args {
    const float* x; const float* c; const int* pos; const float* w_ada; const float* b_ada; const float* attn_pre_g; const float* w_in;
    const float* q_a_norm_g; const float* w_q_up; const float* kv_a_norm_g; const float* w_kv_up; const float* w_mla_o; const float* w_dil_o;
    const float* w_out; const float* attn_post_g; const float* ffn_pre_g; const float* w_router; const float* router_bias;
    const float* w_exp_gate; const float* w_exp_up; const float* w_exp_down; const float* w_sh_gate; const float* w_sh_up; const float* w_sh_down;
    const float* ffn_post_g;
    float* out; unsigned char* ws;
    float invf_d[16]; float invf_m[32];
    int ph_lo, ph_hi;
};

struct Frame {
    LAS unsigned char* lds;
    int tid, lane, wave, vcu, G;
    unsigned char* ws;
};
template <class T> __device__ __forceinline__ T* wsp(const Frame& F, size_t off) { return (T*)(F.ws + off); }

namespace pg8 {
constexpr int BM = 256, BK = 64, HALF = 128, HTB = HALF * BK * 2, STAGE_BYTES = 8 * HTB;
__device__ __forceinline__ int lds_byte(int r, int c) { const int st = (r >> 4) * 2 + (c >> 5), rr = r & 15, cc = c & 31, ob = rr * 64 + cc * 2; return st * 1024 + (ob ^ (((ob >> 9) & 1) << 5)); }
__device__ __forceinline__ void stage_rc(int b, int& R, int& C) { const int st = b / 1024, sb = b % 1024, swz = sb ^ (((sb >> 9) & 1) << 5); R = (st >> 1) * 16 + swz / 64; C = (st & 1) * 32 + (swz % 64) / 2; }
__device__ __forceinline__ int perm32(int rho) { const int n = rho >> 4, i = rho & 15; return 8 * (i >> 2) + 4 * n + (i & 3); }

struct Unit { const char* A; const char* B; int pm, pn, e, slot0, cnt, tag; };
typedef f32x4 Acc[2][2][4][2];

template <class Epi, class Sched, bool GATHER>
__device__ __forceinline__ void gemm_phase(LAS unsigned char* lds, const int K, const int lda, const Sched& S, const Epi& E) {
    const int tid = threadIdx.x, wid = __builtin_amdgcn_readfirstlane(tid >> 6), lane = tid & 63, wr = wid >> 2, wc = wid & 3, fr = lane & 15, fq = lane >> 4;
    const int nt = K / BK;
    int sR[2], sC[2];
    unsigned voffB[2], va[2][2], vn[2][2];
#pragma unroll
    for (int i = 0; i < 2; ++i) { int R, C; stage_rc(tid * 16 + i * 8192, R, C); sR[i] = R; sC[i] = C; const int Rb = (R & ~31) + perm32(R & 31);
        voffB[i] = (unsigned)(Rb * K + C) * 2u;
        va[0][i] = (unsigned)(R * lda + C) * 2u; va[1][i] = (unsigned)((R + HALF) * lda + C) * 2u; vn[0][i] = va[0][i]; vn[1][i] = va[1][i]; }
    const size_t kstep = (size_t)(BK * 2);
    const size_t hstepB = (size_t)HALF * K * 2;
    const unsigned ldsw = (unsigned)wid * 1024u;
    const int aoff = lds_byte(wr * 64 + fr, fq * 8), boff = lds_byte(wc * 32 + fr, fq * 8);
#define PG8_SA(b, h) (((b) * 2 + (h)) * HTB)
#define PG8_SB(b, h) ((4 + (b) * 2 + (h)) * HTB)
#define PG8_STAGE(bufoff, gbase, voff) do { _Pragma("unroll") for (int _i = 0; _i < 2; ++_i) \
        __builtin_amdgcn_global_load_lds((const unsigned*)((const char*)(gbase) + (voff)[_i]), (LAS unsigned*)(lds + (bufoff) + ldsw + _i * 8192), 16, 0, 0); } while (0)
#define PG8_LDA(dst, b, h) do { _Pragma("unroll") for (int m = 0; m < 4; ++m) _Pragma("unroll") for (int k = 0; k < 2; ++k) dst[m][k] = *(const LAS h16x8*)(lds + PG8_SA(b, h) + aoff + m * 2048 + k * 1024); } while (0)
#define PG8_LDB(dst, b, h) do { _Pragma("unroll") for (int n = 0; n < 2; ++n) _Pragma("unroll") for (int k = 0; k < 2; ++k) dst[n][k] = *(const LAS h16x8*)(lds + PG8_SB(b, h) + boff + n * 2048 + k * 1024); } while (0)
#define PG8_MMA(ai, bj, At, Bt) do { __builtin_amdgcn_s_setprio(1); _Pragma("unroll") for (int m = 0; m < 4; ++m) _Pragma("unroll") for (int n = 0; n < 2; ++n) _Pragma("unroll") for (int k = 0; k < 2; ++k) \
        acc[ai][bj][m][n] = __builtin_amdgcn_mfma_f32_16x16x32_f16(Bt[n][k], At[m][k], acc[ai][bj][m][n], 0, 0, 0); __builtin_amdgcn_s_setprio(0); } while (0)
#define PG8_WAIT_V(n) asm volatile("s_waitcnt vmcnt(" #n ")" ::: "memory")
#define PG8_WAIT_L(n) asm volatile("s_waitcnt lgkmcnt(" #n ")" ::: "memory")
#define PG8_BAR __builtin_amdgcn_s_barrier()
#define PG8_SCHED __builtin_amdgcn_sched_barrier(0)
    Unit cur, nxt; int ui = 0;
    if (!S.next(0, cur)) return;
    Acc acc;
#pragma unroll
    for (int a = 0; a < 2; ++a)
#pragma unroll
        for (int b = 0; b < 2; ++b)
#pragma unroll
            for (int m = 0; m < 4; ++m)
#pragma unroll
                for (int n = 0; n < 2; ++n) acc[a][b][m][n] = (f32x4){0.f, 0.f, 0.f, 0.f};
    h16x8 At[4][2], B0[2][2], B1[2][2];
    const char* cA = cur.A; const char* cB = cur.B;
    if constexpr (GATHER) {
#pragma unroll
        for (int h = 0; h < 2; ++h)
#pragma unroll
            for (int i = 0; i < 2; ++i) va[h][i] = S.voff(cur, h * HALF + sR[i], sC[i]);
    }
    PG8_STAGE(PG8_SB(0, 0), cB, voffB); PG8_STAGE(PG8_SB(0, 1), cB + hstepB, voffB); PG8_STAGE(PG8_SA(0, 0), cA, va[0]); PG8_STAGE(PG8_SA(0, 1), cA, va[1]);
    if (wr == 1) PG8_BAR;
    PG8_WAIT_V(2); PG8_BAR;
    PG8_STAGE(PG8_SB(1, 0), cB + kstep, voffB); PG8_STAGE(PG8_SA(1, 0), cA + kstep, va[0]); PG8_STAGE(PG8_SB(1, 1), cB + hstepB + kstep, voffB);
    PG8_WAIT_V(6); PG8_BAR;
    for (;;) {
        const bool has_next = S.next(ui + 1, nxt);
        const char* nA = has_next ? nxt.A : cA; const char* nB = has_next ? nxt.B : cB;
        if constexpr (GATHER) {
            if (has_next) {
#pragma unroll
                for (int h = 0; h < 2; ++h)
#pragma unroll
                    for (int i = 0; i < 2; ++i) vn[h][i] = S.voff(nxt, h * HALF + sR[i], sC[i]);
            } else {
#pragma unroll
                for (int h = 0; h < 2; ++h)
#pragma unroll
                    for (int i = 0; i < 2; ++i) vn[h][i] = va[h][i];
            }
        }
        for (int t = 0; t < nt; t += 2) {
            const bool last = (t == nt - 2);
            const char* a1 = cA + (size_t)(t + 1) * kstep;
            const char* a2 = last ? nA : cA + (size_t)(t + 2) * kstep; const char* b2 = last ? nB : cB + (size_t)(t + 2) * kstep;
            const char* a3 = a2 + kstep; const char* b3 = b2 + kstep;
            unsigned v2[2][2];
#pragma unroll
            for (int h = 0; h < 2; ++h)
#pragma unroll
                for (int i = 0; i < 2; ++i) v2[h][i] = (GATHER && last) ? vn[h][i] : va[h][i];
            PG8_LDB(B0, 0, 0); PG8_LDB(B1, 0, 1); PG8_SCHED; PG8_LDA(At, 0, 0); PG8_STAGE(PG8_SA(1, 1), a1, va[1]);
            PG8_WAIT_V(8); PG8_WAIT_L(0); PG8_BAR; PG8_MMA(0, 0, At, B0); PG8_MMA(0, 1, At, B1); PG8_BAR; PG8_SCHED;
            PG8_LDA(At, 0, 1); PG8_STAGE(PG8_SB(0, 0), b2, voffB); PG8_STAGE(PG8_SB(0, 1), b2 + hstepB, voffB); PG8_STAGE(PG8_SA(0, 0), a2, v2[0]);
            PG8_WAIT_V(8); PG8_WAIT_L(0); PG8_BAR; PG8_MMA(1, 0, At, B0); PG8_MMA(1, 1, At, B1); PG8_BAR; PG8_SCHED;
            PG8_LDB(B0, 1, 0); PG8_LDB(B1, 1, 1); PG8_SCHED; PG8_LDA(At, 1, 0); PG8_STAGE(PG8_SA(0, 1), a2, v2[1]);
            PG8_WAIT_V(8); PG8_WAIT_L(0); PG8_BAR; PG8_MMA(0, 0, At, B0); PG8_MMA(0, 1, At, B1); PG8_BAR; PG8_SCHED;
            PG8_LDA(At, 1, 1); PG8_STAGE(PG8_SB(1, 0), b3, voffB); PG8_STAGE(PG8_SB(1, 1), b3 + hstepB, voffB); PG8_STAGE(PG8_SA(1, 0), a3, v2[0]);
            PG8_WAIT_V(8); PG8_WAIT_L(0); PG8_BAR; PG8_MMA(1, 0, At, B0); PG8_MMA(1, 1, At, B1); PG8_BAR; PG8_SCHED;
        }
        if (wr == 0) PG8_BAR;
        E(acc, cur, wr, wc, fr, fq);
        if (!has_next) break;
#pragma unroll
        for (int a = 0; a < 2; ++a)
#pragma unroll
            for (int b = 0; b < 2; ++b)
#pragma unroll
                for (int m = 0; m < 4; ++m)
#pragma unroll
                    for (int n = 0; n < 2; ++n) acc[a][b][m][n] = (f32x4){0.f, 0.f, 0.f, 0.f};
        cur = nxt; cA = nA; cB = nB; ++ui;
        if constexpr (GATHER) {
#pragma unroll
            for (int h = 0; h < 2; ++h)
#pragma unroll
                for (int i = 0; i < 2; ++i) va[h][i] = vn[h][i];
        }
        if (wr == 1) PG8_BAR;
    }
    PG8_WAIT_V(0);
    PG8_BAR;
#undef PG8_SA
#undef PG8_SB
#undef PG8_STAGE
#undef PG8_LDA
#undef PG8_LDB
#undef PG8_MMA
#undef PG8_WAIT_V
#undef PG8_WAIT_L
#undef PG8_BAR
#undef PG8_SCHED
}

struct StaticOrder {
    const char* A; const char* B; size_t a_tile, b_tile;
    int nM, nN, nwg, G, c;
    __device__ __forceinline__ void init(const void* A_, int lda, const void* B_, int K, int N, int G_, int c_) {
        A = (const char*)A_; B = (const char*)B_; a_tile = (size_t)256 * lda * 2; b_tile = (size_t)256 * K * 2; nM = NTOK / BM; nN = N / BM; nwg = nM * nN; G = G_; c = c_; }
    __device__ __forceinline__ bool next(int i, Unit& u) const {
        const long L = (long)i * G + c; if (L >= nwg) return false;
        int wgid = (int)L; { const int q = nwg / 8, r = nwg % 8, xcd = wgid % 8, off = wgid / 8; wgid = (xcd < r ? xcd * (q + 1) : r * (q + 1) + (xcd - r) * q) + off; }
        const int nig = 8 * nN, gid = wgid / nig, fm = gid * 8, gsz = (nM - fm) < 8 ? (nM - fm) : 8;
        u.pm = fm + ((wgid % nig) % gsz); u.pn = (wgid % nig) / gsz; u.e = 0; u.slot0 = 0; u.cnt = 0; u.tag = 0;
        u.A = A + (size_t)u.pm * a_tile; u.B = B + (size_t)u.pn * b_tile; return true;
    }
    __device__ __forceinline__ unsigned voff(const Unit&, int, int) const { return 0u; }
};
}
using pg8::Unit; using pg8::Acc;

#define ACC8(acc, ai, bj, m, v0, v1) const f32x4 v0 = acc[ai][bj][m][0], v1 = acc[ai][bj][m][1]
#define EPI_ROWS(u, wr, fr) const int row0 = (u).pm * 256 + (wr) * 64 + (fr)
__device__ __forceinline__ void rope8(f32x4& v0, f32x4& v1, const f32x4 cs, const f32x4 sn) {
    const float a0 = v0[0] * cs[0] - v0[1] * sn[0], b0 = v0[1] * cs[0] + v0[0] * sn[0];
    const float a1 = v0[2] * cs[1] - v0[3] * sn[1], b1 = v0[3] * cs[1] + v0[2] * sn[1];
    const float a2 = v1[0] * cs[2] - v1[1] * sn[2], b2 = v1[1] * cs[2] + v1[0] * sn[2];
    const float a3 = v1[2] * cs[3] - v1[3] * sn[3], b3 = v1[3] * cs[3] + v1[2] * sn[3];
    v0 = (f32x4){a0, b0, a1, b1}; v1 = (f32x4){a2, b2, a3, b3};
}
struct EpiIn {
    h16* qa; h16* krope; h16* dil; h16* gates; float* rowsq; const float* cosd; const float* sind; const float* cosm; const float* sinm;
    __device__ __forceinline__ void operator()(const Acc& acc, const Unit& u, int wr, int wc, int fr, int fq) const {
        asm volatile("" : "+v"(fr), "+v"(fq));
        EPI_ROWS(u, wr, fr); const int pn = u.pn, colin = wc * 32 + 8 * fq;
        if (pn < 4) {
#pragma unroll
            for (int ai = 0; ai < 2; ++ai)
#pragma unroll
                for (int m = 0; m < 4; ++m) { const int row = row0 + ai * 128 + m * 16; float ss = 0.f;
#pragma unroll
                    for (int bj = 0; bj < 2; ++bj) { ACC8(acc, ai, bj, m, v0, v1);
                        ss += (v0[0] * v0[0] + v0[1] * v0[1]) + (v0[2] * v0[2] + v0[3] * v0[3]) + (v1[0] * v1[0] + v1[1] * v1[1]) + (v1[2] * v1[2] + v1[3] * v1[3]);
                        *(u32x4*)(qa + (size_t)row * 1024 + pn * 256 + bj * 128 + colin) = pk8(v0, v1); }
                    ss += __shfl_xor(ss, 16); ss += __shfl_xor(ss, 32);
                    if (fq == 0) rowsq[(size_t)row * 16 + pn * 4 + wc] = ss; }
        } else if (pn == 4) {
            if (wc < 2) {
#pragma unroll
                for (int ai = 0; ai < 2; ++ai)
#pragma unroll
                    for (int m = 0; m < 4; ++m) { const int row = row0 + ai * 128 + m * 16; f32x4 v0 = acc[ai][0][m][0], v1 = acc[ai][0][m][1];
                        const f32x4 cs = *(const f32x4*)(cosm + (size_t)row * 32 + 16 * wc + 4 * fq), sn = *(const f32x4*)(sinm + (size_t)row * 32 + 16 * wc + 4 * fq);
                        rope8(v0, v1, cs, sn);
                        *(u32x4*)(krope + (size_t)row * 64 + colin) = pk8(v0, v1); }
            }
        } else if (pn < 23) {
            const int part = (pn - 5) / 6;
#pragma unroll
            for (int ai = 0; ai < 2; ++ai)
#pragma unroll
                for (int m = 0; m < 4; ++m) { const int row = row0 + ai * 128 + m * 16;
                    f32x4 cs = (f32x4){1.f, 1.f, 1.f, 1.f}, sn = (f32x4){0.f, 0.f, 0.f, 0.f};
                    if (part < 2 && wc == 0) { cs = *(const f32x4*)(cosd + (size_t)row * 16 + 4 * fq); sn = *(const f32x4*)(sind + (size_t)row * 16 + 4 * fq); }
#pragma unroll
                    for (int bj = 0; bj < 2; ++bj) { f32x4 v0 = acc[ai][bj][m][0], v1 = acc[ai][bj][m][1];
                        if (part < 2 && wc == 0) rope8(v0, v1, cs, sn);
                        if (part == 0) { v0 *= QS_D; v1 *= QS_D; }
                        *(u32x4*)(dil + (size_t)row * 4608 + (pn - 5) * 256 + bj * 128 + colin) = pk8(v0, v1); } }
        } else {
#pragma unroll
            for (int ai = 0; ai < 2; ++ai)
#pragma unroll
                for (int m = 0; m < 4; ++m) { const int row = row0 + ai * 128 + m * 16;
#pragma unroll
                    for (int bj = 0; bj < 2; ++bj) { f32x4 v0 = acc[ai][bj][m][0], v1 = acc[ai][bj][m][1];
#pragma unroll
                        for (int j = 0; j < 4; ++j) { v0[j] = sigmoidf_(v0[j]); v1[j] = sigmoidf_(v1[j]); }
                        *(u32x4*)(gates + (size_t)row * 4096 + (pn - 23) * 256 + bj * 128 + colin) = pk8(v0, v1); } }
        }
    }
};
struct EpiUp {
    h16* qm; h16* kv; const float* rowsq; const float* cosm; const float* sinm;
    __device__ __forceinline__ void operator()(const Acc& acc, const Unit& u, int wr, int wc, int fr, int fq) const {
        asm volatile("" : "+v"(fr), "+v"(fq));
        EPI_ROWS(u, wr, fr); const int pn = u.pn, colin = wc * 32 + 8 * fq;
#pragma unroll
        for (int ai = 0; ai < 2; ++ai)
#pragma unroll
            for (int m = 0; m < 4; ++m) { const int row = row0 + ai * 128 + m * 16;
                const f32x4 s0 = *(const f32x4*)(rowsq + (size_t)row * 16 + u.tag * 8), s1 = *(const f32x4*)(rowsq + (size_t)row * 16 + u.tag * 8 + 4);
                const float ss = ((s0[0] + s0[1]) + (s0[2] + s0[3])) + ((s1[0] + s1[1]) + (s1[2] + s1[3]));
                float rs = __builtin_amdgcn_rsqf(ss * (1.0f / 512.0f) + EPS);
                if (u.tag == 0) {
                    rs *= QS_M;
                    f32x4 cs, sn;
                    if (pn >= 4) { cs = *(const f32x4*)(cosm + (size_t)row * 32 + 16 * (wc & 1) + 4 * fq); sn = *(const f32x4*)(sinm + (size_t)row * 32 + 16 * (wc & 1) + 4 * fq); }
#pragma unroll
                    for (int bj = 0; bj < 2; ++bj) { f32x4 v0 = acc[ai][bj][m][0] * rs, v1 = acc[ai][bj][m][1] * rs;
                        if (pn >= 4) rope8(v0, v1, cs, sn);
                        *(u32x4*)(qm + (size_t)row * 1536 + pn * 256 + bj * 128 + colin) = pk8(v0, v1); }
                } else {
#pragma unroll
                    for (int bj = 0; bj < 2; ++bj) { const f32x4 v0 = acc[ai][bj][m][0] * rs, v1 = acc[ai][bj][m][1] * rs;
                        *(u32x4*)(kv + (size_t)row * 2048 + pn * 256 + bj * 128 + colin) = pk8(v0, v1); }
                }
            }
    }
};
__device__ __forceinline__ void unpk8(const u32x4 w, f32x4& a, f32x4& b) {
    const h16x8 h = __builtin_bit_cast(h16x8, w);
    a = (f32x4){(float)h[0], (float)h[1], (float)h[2], (float)h[3]}; b = (f32x4){(float)h[4], (float)h[5], (float)h[6], (float)h[7]};
}
template <int MODE> struct EpiOut {
    h16* out; int ldc; const h16* gate; int ldg; const h16* add;
    __device__ __forceinline__ void operator()(const Acc& acc, const Unit& u, int wr, int wc, int fr, int fq) const {
        asm volatile("" : "+v"(fr), "+v"(fq));
        EPI_ROWS(u, wr, fr); const int col0 = u.pn * 256 + wc * 32 + 8 * fq;
#pragma unroll
        for (int ai = 0; ai < 2; ++ai)
#pragma unroll
            for (int m = 0; m < 4; ++m) { const int row = row0 + ai * 128 + m * 16;
#pragma unroll
                for (int bj = 0; bj < 2; ++bj) { f32x4 v0 = acc[ai][bj][m][0], v1 = acc[ai][bj][m][1];
                    if (MODE >= 1) { f32x4 g0, g1; unpk8(*(const u32x4*)(gate + (size_t)row * ldg + col0 + bj * 128), g0, g1); v0 *= g0; v1 *= g1; }
                    if (MODE == 2) { f32x4 a0, a1; unpk8(*(const u32x4*)(add + (size_t)row * ldc + col0 + bj * 128), a0, a1); v0 += a0; v1 += a1; }
                    *(u32x4*)(out + (size_t)row * ldc + col0 + bj * 128) = pk8(v0, v1); } }
    }
};
struct EpiSwiglu {
    h16* act;
    __device__ __forceinline__ void operator()(const Acc& acc, const Unit& u, int wr, int wc, int fr, int fq) const {
        asm volatile("" : "+v"(fr), "+v"(fq));
        EPI_ROWS(u, wr, fr); const int col0 = u.pn * 128 + wc * 32 + 8 * fq;
#pragma unroll
        for (int ai = 0; ai < 2; ++ai)
#pragma unroll
            for (int m = 0; m < 4; ++m) { const int row = row0 + ai * 128 + m * 16;
                f32x4 g0 = acc[ai][0][m][0], g1 = acc[ai][0][m][1]; const f32x4 u0 = acc[ai][1][m][0], u1 = acc[ai][1][m][1];
#pragma unroll
                for (int j = 0; j < 4; ++j) { g0[j] = g0[j] * sigmoidf_(g0[j]) * u0[j]; g1[j] = g1[j] * sigmoidf_(g1[j]) * u1[j]; }
                *(u32x4*)(act + (size_t)row * 512 + col0) = pk8(g0, g1); }
    }
};

struct UpOrder {
    const char* qa; const char* wq; const char* wkv; int G, c;
    __device__ __forceinline__ bool next(int i, Unit& u) const {
        const int L = i * G + c; if (L >= 896) return false;
        u.e = 0; u.slot0 = 0; u.cnt = 0;
        if (L < 384) { u.pm = L / 6; u.pn = L % 6; u.tag = 0; u.A = qa + (size_t)u.pm * 256 * 2048; u.B = wq + (size_t)u.pn * 256 * 1024; }
        else { const int l = L - 384; u.pm = l >> 3; u.pn = l & 7; u.tag = 1; u.A = qa + (size_t)u.pm * 256 * 2048 + 1024; u.B = wkv + (size_t)u.pn * 256 * 1024; }
        return true;
    }
    __device__ __forceinline__ unsigned voff(const Unit&, int, int) const { return 0u; }
};
__device__ __forceinline__ void moe_tables(const Frame& F, const unsigned* cnt) {
    LAS int* tstart = (LAS int*)(F.lds + LDS_TAB); LAS int* cnts = (LAS int*)(F.lds + LDS_TAB + 512); LAS int* tmap = (LAS int*)(F.lds + LDS_TAB + 1024);
    __syncthreads();
    if (F.tid < 65) cnts[F.tid] = F.tid < 64 ? (int)__hip_atomic_load(cnt + F.tid, __ATOMIC_RELAXED, __HIP_MEMORY_SCOPE_AGENT) : NTOK;
    __syncthreads();
    if (F.tid == 0) { int s = 0; for (int e = 0; e < 65; ++e) { tstart[e] = s; s += (cnts[e] + 255) >> 8; } tstart[65] = s; }
    __syncthreads();
    { int e = 0; for (int j = 1; j < 65; ++j) e += (tstart[j] <= F.tid) ? 1 : 0; tmap[F.tid] = (F.tid < tstart[65]) ? e : 255; }
    __syncthreads();
}
template <int NPN, bool GU> struct MoeOrder {
    const LAS int* tstart; const LAS int* cnts; const LAS int* tmap; const char* A; const char* W; const unsigned* list; int G, c;
    __device__ __forceinline__ bool next(int i, Unit& u) const {
        const int L = i * G + c; const int mt = L / NPN; const int T = __builtin_amdgcn_readfirstlane(tstart[65]);
        if (mt >= T) return false;
        const int e = __builtin_amdgcn_readfirstlane(tmap[mt]);
        u.pm = mt; u.pn = L % NPN; u.e = e; u.slot0 = (mt - __builtin_amdgcn_readfirstlane(tstart[e])) * 256; u.cnt = __builtin_amdgcn_readfirstlane(cnts[e]); u.tag = 0;
        if (GU) { u.A = A; u.B = W + (size_t)e * (1024 * 2048 * 2) + (size_t)u.pn * (256 * 2048 * 2); }
        else { u.A = A + (size_t)mt * (256 * 512 * 2); u.B = W + (size_t)e * (2048 * 512 * 2) + (size_t)u.pn * (256 * 512 * 2); }
        return true;
    }
    __device__ __forceinline__ unsigned voff(const Unit& u, int row, int col) const {
        const int slot = u.slot0 + row; unsigned tok;
        if (u.e == 64) tok = (unsigned)slot; else tok = slot < u.cnt ? list[(size_t)u.e * LISTCAP + slot] : 0u;
        return tok * 4096u + (unsigned)col * 2u;
    }
};

namespace att {
constexpr int KVBLK = 64, SHM_K = 16384, SHM_V = 16384, SHM_KR = 8192;
constexpr int OFF_V = 0, OFF_K = 2 * SHM_V, OFF_KR = OFF_K + 2 * SHM_K, OFF_WS = OFF_KR + 2 * SHM_KR, OFF_QR = OFF_WS + 2048;
constexpr float THR2 = 11.5f;
#define KSWZ(row, colB) ((row) * 256 + ((colB) ^ (((row) & 7) << 4)))
#define RSWZ(row, colB) ((row) * 128 + ((colB) ^ (((row) & 7) << 4)))
#define SBAR() __builtin_amdgcn_sched_barrier(0)
__device__ __forceinline__ int v_st(int k, int c) { const int kk = (k & ~0xC) | ((k & 4) << 1) | ((k & 8) >> 1); return ((kk >> 3) * 4 + (c >> 5)) * 512 + ((kk & 7) * 32 + (c & 31)) * 2; }
__device__ __forceinline__ int v_rd_base(int lane) { return ((lane & 3) << 3) | (((lane >> 2) & 3) << 6) | (((lane >> 4) & 1) << 5) | (((lane >> 5) & 1) << 8); }
constexpr int v_rd_off(int d0, int ks, int half) { return d0 * 512 + ks * 4096 + half * 2048; }
__device__ __forceinline__ int crow(int r, int hi) { return (r & 3) + 8 * (r >> 2) + 4 * hi; }
__device__ __forceinline__ void mask_tile(f32x16& p0, f32x16& p1, int dq, unsigned W) {
    const float NEG = -__builtin_inff();
#pragma unroll
    for (int r = 0; r < 16; ++r) {
        const int c = (r & 3) + 8 * (r >> 2);
        if ((unsigned)(dq - c) >= W) p0[r] = NEG;
        if ((unsigned)(dq - c - 32) >= W) p1[r] = NEG;
    }
}
__device__ __forceinline__ void softmax_tile(f32x16& p0, f32x16& p1, float& m_reg, float& l_reg, float& alpha, h16x8& pa0, h16x8& pa1, h16x8& pa2, h16x8& pa3) {
    float pmax = p0[0];
#pragma unroll
    for (int r = 1; r < 16; ++r) pmax = fmaxf(pmax, p0[r]);
#pragma unroll
    for (int r = 0; r < 16; ++r) pmax = fmaxf(pmax, p1[r]);
    { auto rr = __builtin_amdgcn_permlane32_swap(__float_as_uint(pmax), __float_as_uint(pmax), false, false);
      pmax = fmaxf(__uint_as_float(rr[0]), __uint_as_float(rr[1])); }
    float mn;
    if (__all((pmax - m_reg) <= THR2)) { mn = m_reg; alpha = 1.f; }
    else { mn = fmaxf(m_reg, pmax); alpha = __builtin_amdgcn_exp2f(m_reg - mn); m_reg = mn; }
#pragma unroll
    for (int r = 0; r < 16; ++r) { p0[r] = __builtin_amdgcn_exp2f(p0[r] - mn); p1[r] = __builtin_amdgcn_exp2f(p1[r] - mn); }
    float ps = 0;
#pragma unroll
    for (int r = 0; r < 16; ++r) ps += p0[r];
#pragma unroll
    for (int r = 0; r < 16; ++r) ps += p1[r];
    { auto rr = __builtin_amdgcn_permlane32_swap(__float_as_uint(ps), __float_as_uint(ps), false, false);
      ps = __uint_as_float(rr[0]) + __uint_as_float(rr[1]); }
    l_reg = l_reg * alpha + ps;
#define PK4(P, B_, OUT) do { unsigned a0 = pkh(P[B_+0], P[B_+1]), a1 = pkh(P[B_+2], P[B_+3]);                          \
        unsigned b0 = pkh(P[B_+4], P[B_+5]), b1 = pkh(P[B_+6], P[B_+7]);                                             \
        auto r0 = __builtin_amdgcn_permlane32_swap(a0, b0, false, false); auto r1 = __builtin_amdgcn_permlane32_swap(a1, b1, false, false); \
        u32x4 w = {r0[0], r1[0], r0[1], r1[1]}; OUT = __builtin_bit_cast(h16x8, w); } while (0)
    PK4(p0, 0, pa0); PK4(p0, 8, pa1); PK4(p1, 0, pa2); PK4(p1, 8, pa3);
#undef PK4
}
struct AUnit {
    const char* Q; const char* QR;
    const char* K; const char* V;
    const char* KR;
    char* O;
    float* LSE;
    unsigned qs, kvs, krs, os, ls;
    int P0, jlo, jhi; unsigned W;
};
template <bool MLA>
__device__ __forceinline__ void attn_unit(LAS unsigned char* lds, const AUnit& u) {
    const int tid = threadIdx.x, wid = __builtin_amdgcn_readfirstlane(tid >> 6), lane = tid & 63, r32 = lane & 31, hi = lane >> 5;
    LAS unsigned char* V_lds = lds + OFF_V; LAS unsigned char* K_lds = lds + OFF_K; LAS unsigned char* R_lds = lds + OFF_KR;
    LAS float* wsf = (LAS float*)(lds + OFF_WS) + wid * 64;
    LAS unsigned char* QRl = lds + OFF_QR + wid * 4096 + lane * 16;
    const int qlo = u.P0 + wid * 32, qm = qlo + r32 - 4 * hi;
    unsigned ko[2], vo[2], kro = 0u;
#pragma unroll
    for (int i = 0; i < 2; ++i) { const int p = (wid * 2 + i) * 64 + lane;
        { const int row = p >> 4, pc = p & 15; ko[i] = (unsigned)row * u.kvs + (unsigned)((pc ^ (row & 7)) << 4); }
        { const int cc = (p & 3) | (((p >> 5) & 3) << 2), kk = ((p >> 2) & 7) | ((p >> 7) << 3), k = (kk & ~0xC) | ((kk & 4) << 1) | ((kk & 8) >> 1);
          vo[i] = (unsigned)k * u.kvs + (unsigned)cc * 16u; } }
    if constexpr (MLA) { const int p = wid * 64 + lane, row = p >> 3, pc = p & 7; kro = (unsigned)row * u.krs + (unsigned)((pc ^ (row & 7)) << 4); }
#define ST_ISSUE(t, bf) do { const size_t tb_ = (size_t)(t) * KVBLK * u.kvs; const char* Kt_ = u.K + tb_; const char* Vt_ = u.V + tb_; \
        _Pragma("unroll") for (int i_ = 0; i_ < 2; ++i_) { \
            __builtin_amdgcn_global_load_lds((const unsigned*)(Kt_ + ko[i_]), (LAS unsigned*)(K_lds + (bf) * SHM_K + (wid * 2 + i_) * 1024), 16, 0, 0); \
            __builtin_amdgcn_global_load_lds((const unsigned*)(Vt_ + vo[i_]), (LAS unsigned*)(V_lds + (bf) * SHM_V + (wid * 2 + i_) * 1024), 16, 0, 0); } \
        if constexpr (MLA) __builtin_amdgcn_global_load_lds((const unsigned*)(u.KR + (size_t)(t) * KVBLK * u.krs + kro), (LAS unsigned*)(R_lds + (bf) * SHM_KR + wid * 1024), 16, 0, 0); } while (0)
    __syncthreads();
    ST_ISSUE(u.jlo, 0);
    h16x8 qr[8];
    { const unsigned qo = (unsigned)(wid * 32 + r32) * u.qs + (unsigned)hi * 16u;
#pragma unroll
      for (int d0 = 0; d0 < 8; ++d0) qr[d0] = *(const h16x8*)(u.Q + d0 * 32 + qo);
      if constexpr (MLA) {
#pragma unroll
        for (int d0 = 0; d0 < 4; ++d0) *(LAS h16x8*)(QRl + d0 * 1024) = *(const h16x8*)(u.QR + d0 * 32 + qo); } }
    float m_reg = -1e30f, l_reg = 0.f; f32x16 o[4];
#pragma unroll
    for (int d = 0; d < 4; ++d)
#pragma unroll
        for (int r = 0; r < 16; ++r) o[d][r] = 0.f;
    const int vb0 = (int)(uintptr_t)V_lds + v_rd_base(lane);
    for (int t = u.jlo; t < u.jhi; ++t) {
        const int bf = (t - u.jlo) & 1;
        asm volatile("s_waitcnt vmcnt(0)" ::: "memory");
        __syncthreads();
        if (t + 1 < u.jhi) ST_ISSUE(t + 1, bf ^ 1);
        const int kb = t * KVBLK;
        const bool act = (kb <= qlo + 31) && ((long)kb + KVBLK - 1 >= (long)qlo - (long)(u.W - 1));
        if (act) {
            f32x16 p0, p1;
#pragma unroll
            for (int r = 0; r < 16; ++r) { p0[r] = 0.f; p1[r] = 0.f; }
            {   const LAS unsigned char* kbp[4];
#pragma unroll
                for (int dd = 0; dd < 4; ++dd) kbp[dd] = K_lds + bf * SHM_K + KSWZ(r32, (dd * 16 + hi * 8) * 2);
#pragma unroll
                for (int d0 = 0; d0 < 8; ++d0) { const LAS unsigned char* a = kbp[d0 & 3] + (d0 >> 2) * 128;
                    const h16x8 b0 = *(const LAS h16x8*)a, b1 = *(const LAS h16x8*)(a + 32 * 256);
                    p0 = __builtin_amdgcn_mfma_f32_32x32x16_f16(b0, qr[d0], p0, 0, 0, 0);
                    p1 = __builtin_amdgcn_mfma_f32_32x32x16_f16(b1, qr[d0], p1, 0, 0, 0); }
                if constexpr (MLA) {
#pragma unroll
                    for (int d0 = 0; d0 < 4; ++d0) { const LAS unsigned char* a = R_lds + bf * SHM_KR + RSWZ(r32, (d0 * 16 + hi * 8) * 2);
                        const h16x8 b0 = *(const LAS h16x8*)a, b1 = *(const LAS h16x8*)(a + 32 * 128); const h16x8 qf = *(const LAS h16x8*)(QRl + d0 * 1024);
                        p0 = __builtin_amdgcn_mfma_f32_32x32x16_f16(b0, qf, p0, 0, 0, 0);
                        p1 = __builtin_amdgcn_mfma_f32_32x32x16_f16(b1, qf, p1, 0, 0, 0); }
                }
            }
            if (kb + KVBLK - 1 > qlo || (long)kb <= (long)qlo + 31 - (long)u.W) mask_tile(p0, p1, qm - kb, u.W);
            float alpha; h16x8 pa0, pa1, pa2, pa3;
            softmax_tile(p0, p1, m_reg, l_reg, alpha, pa0, pa1, pa2, pa3);
            if (__any(alpha < 1.f)) {
                if (hi == 0) wsf[r32] = alpha;
                LDS_WAIT();
#pragma unroll
                for (int r = 0; r < 16; ++r) { const float a_ = wsf[crow(r, hi)];
#pragma unroll
                    for (int d = 0; d < 4; ++d) o[d][r] *= a_; }
            }
#define TRRD(dst, off) asm volatile("ds_read_b64_tr_b16 %0, %1 offset:%2" : "=&v"(dst) : "v"(vb0), "i"(off) : "memory")
#define PV_D0(VB, d0) do { s16x4 l0, l1, l2, l3, h0, h1, h2, h3; constexpr int b_ = (VB) * SHM_V + v_rd_off(d0, 0, 0); \
        TRRD(l0, b_); TRRD(h0, b_ + 2048); TRRD(l1, b_ + 4096); TRRD(h1, b_ + 6144); TRRD(l2, b_ + 8192); TRRD(h2, b_ + 10240); TRRD(l3, b_ + 12288); TRRD(h3, b_ + 14336); \
        asm volatile("s_waitcnt lgkmcnt(0)" ::: "memory"); SBAR(); \
        o[d0] = __builtin_amdgcn_mfma_f32_32x32x16_f16(pa0, __builtin_bit_cast(h16x8, (short __attribute__((ext_vector_type(8)))){l0[0], l0[1], l0[2], l0[3], h0[0], h0[1], h0[2], h0[3]}), o[d0], 0, 0, 0); \
        o[d0] = __builtin_amdgcn_mfma_f32_32x32x16_f16(pa1, __builtin_bit_cast(h16x8, (short __attribute__((ext_vector_type(8)))){l1[0], l1[1], l1[2], l1[3], h1[0], h1[1], h1[2], h1[3]}), o[d0], 0, 0, 0); \
        o[d0] = __builtin_amdgcn_mfma_f32_32x32x16_f16(pa2, __builtin_bit_cast(h16x8, (short __attribute__((ext_vector_type(8)))){l2[0], l2[1], l2[2], l2[3], h2[0], h2[1], h2[2], h2[3]}), o[d0], 0, 0, 0); \
        o[d0] = __builtin_amdgcn_mfma_f32_32x32x16_f16(pa3, __builtin_bit_cast(h16x8, (short __attribute__((ext_vector_type(8)))){l3[0], l3[1], l3[2], l3[3], h3[0], h3[1], h3[2], h3[3]}), o[d0], 0, 0, 0); } while (0)
            if (bf == 0) { PV_D0(0, 0); PV_D0(0, 1); PV_D0(0, 2); PV_D0(0, 3); }
            else { PV_D0(1, 0); PV_D0(1, 1); PV_D0(1, 2); PV_D0(1, 3); }
#undef PV_D0
#undef TRRD
        }
    }
#undef ST_ISSUE
    if (hi == 0) wsf[32 + r32] = l_reg;
    LDS_WAIT();
    if (u.LSE && hi == 0) u.LSE[(unsigned)(wid * 32 + r32) * u.ls] = m_reg + __builtin_amdgcn_logf(l_reg);
    char* Ow = u.O + (size_t)(wid * 32) * u.os;
    unsigned loff = (unsigned)(4 * hi) * u.os + (unsigned)r32 * 2u;
    asm volatile("" : "+v"(loff));
#pragma unroll
    for (int r = 0; r < 16; ++r) { const int orow = crow(r, hi); const float rl = __builtin_amdgcn_rcpf(wsf[32 + orow]);
        char* rowp = Ow + (size_t)((r & 3) + 8 * (r >> 2)) * u.os;
#pragma unroll
        for (int d0 = 0; d0 < 4; ++d0) { const float v = o[d0][r] * rl; const float vn_ = __shfl_xor(v, 1);
            if ((r32 & 1) == 0) *(unsigned*)(rowp + d0 * 64 + loff) = pkh(v, vn_); } }
}
}

template <class RowOf>
__device__ __forceinline__ void cvt_item(const float* W, int K, int N, h16* WT, LAS float* scr, int item, int lane, const float* kscale, RowOf row_of) {
    const int nblk = N >> 6, kb = item / nblk, nb = item - kb * nblk, k0 = kb * 64, n0 = nb * 64;
    f32x4 v[16];
#pragma unroll
    for (int i = 0; i < 16; ++i) { const int kk = 4 * i + (lane >> 4); v[i] = *(const GAS f32x4*)(W + (size_t)(k0 + kk) * N + n0 + (lane & 15) * 4); }
#pragma unroll
    for (int i = 0; i < 16; ++i) { const int kk = 4 * i + (lane >> 4); f32x4 t = v[i]; if (kscale) t *= kscale[k0 + kk];
        LAS float* s = scr + kk * 65 + (lane & 15) * 4; s[0] = t[0]; s[1] = t[1]; s[2] = t[2]; s[3] = t[3]; }
    LDS_WAIT(); asm volatile("" ::: "memory");
    const int c = lane & 7;
#pragma unroll
    for (int j = 0; j < 8; ++j) { const int n = (lane >> 3) + 8 * j; const LAS float* s = scr + (8 * c) * 65 + n;
        u32x4 o; o.x = pkh(s[0 * 65], s[1 * 65]); o.y = pkh(s[2 * 65], s[3 * 65]); o.z = pkh(s[4 * 65], s[5 * 65]); o.w = pkh(s[6 * 65], s[7 * 65]);
        *(GAS u32x4*)(WT + (size_t)row_of(n0 + n) * K + k0 + 8 * c) = o; }
    LDS_WAIT(); asm volatile("" ::: "memory");
}
__device__ __forceinline__ int rope_perm(int i, int half) { return i < half ? 2 * i : 2 * (i - half) + 1; }
__device__ __forceinline__ int row_in(int c) {
    if (c < 1024) return c;
    if (c < 1088) return 1024 + rope_perm(c - 1024, 32);
    if (c < 5696) { const int dc = c - 1088, part = dc / 1536, dim = dc & 127;
        return 1280 + ((part < 2 && dim < 32) ? (dc - dim + rope_perm(dim, 16)) : dc); }
    return 5888 + (c - 5696);
}
__device__ __forceinline__ int row_qup(int c) { const int h = c / 192, j = c - h * 192; return j < 128 ? h * 128 + j : 1024 + h * 64 + rope_perm(j - 128, 32); }
__device__ __forceinline__ int row_gu(int n, int up) { return (n >> 7) * 256 + up * 128 + (n & 127); }
__device__ __forceinline__ void sincos_d(float angf, float& s, float& c) {
    const double a = (double)angf; const double k = __builtin_rint(a * 0.63661977236758134308);
    const double r = (a - k * 1.57079632679489655800) - k * 6.12323399573676603587e-17; const double r2 = r * r;
    double sp = -7.6471637318198164759e-13; sp = sp * r2 + 1.6059043836821614599e-10; sp = sp * r2 - 2.5052108385441718775e-08; sp = sp * r2 + 2.7557319223985890653e-06;
    sp = sp * r2 - 1.9841269841269841270e-04; sp = sp * r2 + 8.3333333333333333333e-03; sp = sp * r2 - 1.6666666666666666667e-01; const double sn = r + r * r2 * sp;
    double cp = 4.7794773323873852974e-14; cp = cp * r2 - 1.1470745597729724714e-11; cp = cp * r2 + 2.0876756987868098979e-09; cp = cp * r2 - 2.7557319223985890653e-07;
    cp = cp * r2 + 2.4801587301587301587e-05; cp = cp * r2 - 1.3888888888888888889e-03; cp = cp * r2 + 4.1666666666666666667e-02; cp = cp * r2 - 0.5; const double cn = 1.0 + r2 * cp;
    const int q = ((int)k) & 3;
    const double ss = (q == 0) ? sn : (q == 1) ? cn : (q == 2) ? -sn : -cn;
    const double cc = (q == 0) ? cn : (q == 1) ? -sn : (q == 2) ? -cn : sn;
    s = (float)ss; c = (float)cc;
}
__device__ __forceinline__ void p0_prologue(const Frame& F, const Args& a) {
    {
        LAS float* sc = (LAS float*)F.lds; LAS float* part = (LAS float*)(F.lds + 32768);
        float* mod = wsp<float>(F, WS_MOD);
        for (int i = F.tid; i < 4 * DM; i += NTHR) { const float v = a.c[i]; sc[i] = v / (1.0f + __expf(-v)); }
        __syncthreads();
        for (int un = F.vcu; un < 384; un += F.G) {
            const int j0 = un * 32, col4 = F.tid & 7, kg = F.tid >> 3;
            f32x4 ac[4];
#pragma unroll
            for (int b = 0; b < 4; ++b) ac[b] = (f32x4){0.f, 0.f, 0.f, 0.f};
#pragma unroll 8
            for (int i = 0; i < 32; ++i) { const int k = kg + 64 * i; const f32x4 w = *(const GAS f32x4*)(a.w_ada + (size_t)k * 12288 + j0 + col4 * 4);
#pragma unroll
                for (int b = 0; b < 4; ++b) ac[b] += w * sc[b * DM + k]; }
#pragma unroll
            for (int b = 0; b < 4; ++b) *(LAS f32x4*)(part + (kg * 4 + b) * 32 + col4 * 4) = ac[b];
            __syncthreads();
            if (F.tid < 128) { const int b = F.tid >> 5, col = F.tid & 31; float s = 0.f;
                for (int g = 0; g < 64; ++g) s += part[(g * 4 + b) * 32 + col];
                mod[b * 12288 + j0 + col] = s + a.b_ada[j0 + col]; }
            __syncthreads();
        }
    }
    const int gw = F.vcu * NWAVES + F.wave, NGW = F.G * NWAVES, gt = F.vcu * NTHR + F.tid, NGT = F.G * NTHR;
    {
        float* cosd = wsp<float>(F, WS_COSD); float* sind = wsp<float>(F, WS_SIND); float* cosm = wsp<float>(F, WS_COSM); float* sinm = wsp<float>(F, WS_SINM);
        for (int i = gt; i < NTOK * 48; i += NGT) { const int t = i / 48, j = i - t * 48; const float p = (float)a.pos[t];
            float s, c;
            if (j < 16) { sincos_d(p * a.invf_d[j], s, c); cosd[t * 16 + j] = c; sind[t * 16 + j] = s; }
            else { sincos_d(p * a.invf_m[j - 16], s, c); cosm[t * 32 + j - 16] = c; sinm[t * 32 + j - 16] = s; } }
    }
    { u32x4* z = (u32x4*)(wsp<h16>(F, W_IN) + (size_t)1088 * DM); for (int i = gt; i < 192 * DM / 8; i += NGT) z[i] = (u32x4){0u, 0u, 0u, 0u}; }
    {
        __syncthreads();
        LAS float* scr = (LAS float*)(F.lds + F.wave * 16640);
        constexpr int I_IN = 32 * 153, I_QUP = 8 * 24, I_KVUP = 8 * 32, I_MO = 16 * 32, I_DO = 8 * 32, I_OUT = 32 * 32, I_R = 32, I_SH = 256, I_EX = 256;
        constexpr int NSMALL = I_IN + I_QUP + I_KVUP + I_MO + I_DO + I_OUT + I_R + 3 * I_SH;
        constexpr int NITEMS = NSMALL + 3 * 64 * I_EX;
        for (int it = gw; it < NITEMS; it += NGW) {
            int r = it;
            if (r < I_IN) { cvt_item(a.w_in, DM, 9792, wsp<h16>(F, W_IN), scr, r, F.lane, nullptr, [](int n) { return row_in(n); }); continue; } r -= I_IN;
            if (r < I_QUP) { cvt_item(a.w_q_up, 512, 1536, wsp<h16>(F, W_QUP), scr, r, F.lane, a.q_a_norm_g, [](int n) { return row_qup(n); }); continue; } r -= I_QUP;
            if (r < I_KVUP) { cvt_item(a.w_kv_up, 512, 2048, wsp<h16>(F, W_KVUP), scr, r, F.lane, a.kv_a_norm_g, [](int n) { return n; }); continue; } r -= I_KVUP;
            if (r < I_MO) { cvt_item(a.w_mla_o, 1024, 2048, wsp<h16>(F, W_MO), scr, r, F.lane, nullptr, [](int n) { return n; }); continue; } r -= I_MO;
            if (r < I_DO) { cvt_item(a.w_dil_o, 512, 2048, wsp<h16>(F, W_DO), scr, r, F.lane, nullptr, [](int n) { return n; }); continue; } r -= I_DO;
            if (r < I_OUT) { cvt_item(a.w_out, DM, DM, wsp<h16>(F, W_OUT), scr, r, F.lane, nullptr, [](int n) { return n; }); continue; } r -= I_OUT;
            if (r < I_R) { cvt_item(a.w_router, DM, 64, wsp<h16>(F, W_R), scr, r, F.lane, nullptr, [](int n) { return n; }); continue; } r -= I_R;
            if (r < I_SH) { cvt_item(a.w_sh_gate, DM, 512, wsp<h16>(F, W_GU) + (size_t)64 * 1024 * 2048, scr, r, F.lane, nullptr, [](int n) { return row_gu(n, 0); }); continue; } r -= I_SH;
            if (r < I_SH) { cvt_item(a.w_sh_up, DM, 512, wsp<h16>(F, W_GU) + (size_t)64 * 1024 * 2048, scr, r, F.lane, nullptr, [](int n) { return row_gu(n, 1); }); continue; } r -= I_SH;
            if (r < I_SH) { cvt_item(a.w_sh_down, 512, DM, wsp<h16>(F, W_DN) + (size_t)64 * 2048 * 512, scr, r, F.lane, nullptr, [](int n) { return n; }); continue; } r -= I_SH;
            const int mat = r / (64 * I_EX), rr = r - mat * (64 * I_EX), e = rr / I_EX, ii = rr - e * I_EX;
            if (mat == 0) cvt_item(a.w_exp_gate + (size_t)e * DM * 512, DM, 512, wsp<h16>(F, W_GU) + (size_t)e * 1024 * 2048, scr, ii, F.lane, nullptr, [](int n) { return row_gu(n, 0); });
            else if (mat == 1) cvt_item(a.w_exp_up + (size_t)e * DM * 512, DM, 512, wsp<h16>(F, W_GU) + (size_t)e * 1024 * 2048, scr, ii, F.lane, nullptr, [](int n) { return row_gu(n, 1); });
            else cvt_item(a.w_exp_down + (size_t)e * 512 * DM, 512, DM, wsp<h16>(F, W_DN) + (size_t)e * 2048 * 512, scr, ii, F.lane, nullptr, [](int n) { return n; });
        }
        __syncthreads();
    }
}

__device__ __forceinline__ void p1_h1(const Frame& F, const Args& a) {
    const int gw = F.vcu * NWAVES + F.wave, NGW = F.G * NWAVES;
    const float* mod = wsp<float>(F, WS_MOD); h16* h1 = wsp<h16>(F, A_H1);
    for (int t = gw; t < NTOK; t += NGW) {
        const int b = t >> 12; const GAS f32x4* xr = (const GAS f32x4*)(a.x + (size_t)t * DM) + F.lane;
        f32x4 v[8]; float ss = 0.f;
#pragma unroll
        for (int j = 0; j < 8; ++j) { v[j] = xr[64 * j]; ss += (v[j][0] * v[j][0] + v[j][1] * v[j][1]) + (v[j][2] * v[j][2] + v[j][3] * v[j][3]); }
        const float rstd = 1.0f / sqrtf(wave_sum(ss) * (1.0f / DM) + EPS);
#pragma unroll
        for (int j = 0; j < 8; ++j) { const int c = 4 * F.lane + 256 * j;
            const f32x4 g = *(const f32x4*)(a.attn_pre_g + c), sc = *(const f32x4*)(mod + b * 12288 + 2048 + c), sh = *(const f32x4*)(mod + b * 12288 + c);
            const f32x4 h = v[j] * rstd * g * (sc + 1.0f) + sh;
            u32x2 w; w.x = pkh(h[0], h[1]); w.y = pkh(h[2], h[3]);
            *(GAS u32x2*)(h1 + (size_t)t * DM + c) = w; }
    }
}

__device__ __forceinline__ void p4_attention(const Frame& F) {
    const char* qm = (const char*)wsp<h16>(F, A_QM); const char* kv = (const char*)wsp<h16>(F, A_KV); const char* kr = (const char*)wsp<h16>(F, A_KR);
    const char* dil = (const char*)wsp<h16>(F, A_DIL); char* omla = (char*)wsp<h16>(F, A_OMLA); char* od = (char*)wsp<h16>(F, A_OD); float* lse = wsp<float>(F, WS_LSE);
    for (int it = F.vcu; it < 256; it += F.G) {
        const int bh = it >> 3, x = it & 7, b = bh >> 3, h = bh & 7;
#pragma unroll 1
        for (int half = 0; half < 2; ++half) {
            const int qb = half ? 15 - x : x; const size_t tok0 = (size_t)b * SEQ;
            att::AUnit u;
            u.Q = qm + (tok0 + qb * 256) * 3072 + h * 256; u.qs = 3072; u.QR = qm + (tok0 + qb * 256) * 3072 + 2048 + h * 128;
            u.K = kv + tok0 * 4096 + h * 512; u.kvs = 4096; u.V = u.K + 256; u.KR = kr + tok0 * 128; u.krs = 128;
            u.O = omla + (tok0 + qb * 256) * 2048 + h * 256; u.os = 2048; u.LSE = nullptr; u.ls = 0;
            u.P0 = qb * 256; u.jlo = 0; u.jhi = qb * 4 + 4; u.W = 0x40000000u;
            att::attn_unit<true>(F.lds, u);
        }
    }
    for (int un = F.vcu; un < 768; un += F.G) {
        const int b = un / 192, rem = un - b * 192, head = rem >> 4, sub = rem & 15, g = head >> 2;
        const int d = (g == 0) ? 1 : (g == 1) ? 4 : 16; const int r = sub % d, jb = sub / d;
        const size_t tok0 = (size_t)b * SEQ + r; const unsigned rs = (unsigned)d * 9216u;
        att::AUnit u;
        u.Q = dil + (tok0 + (size_t)d * 256 * jb) * 9216 + head * 256; u.qs = rs; u.QR = nullptr;
        u.K = dil + tok0 * 9216 + 3072 + head * 256; u.kvs = rs; u.V = dil + tok0 * 9216 + 6144 + head * 256; u.KR = nullptr; u.krs = 0;
        u.O = od + (tok0 + (size_t)d * 256 * jb) * 3072 + head * 256; u.os = (unsigned)d * 3072u;
        u.LSE = lse + (tok0 + (size_t)d * 256 * jb) * 12 + head; u.ls = (unsigned)d * 12u;
        u.P0 = jb * 256; u.jlo = jb == 0 ? 0 : jb * 4 - 2; u.jhi = jb * 4 + 4; u.W = 129u;
        att::attn_unit<false>(F.lds, u);
    }
    __syncthreads();
}
__device__ __forceinline__ void p5_combine(const Frame& F) {
    const int gw = F.vcu * NWAVES + F.wave, NGW = F.G * NWAVES;
    const h16* od = wsp<h16>(F, A_OD); const float* lse = wsp<float>(F, WS_LSE); h16* odil = wsp<h16>(F, A_ODIL);
    for (int t = gw; t < NTOK; t += NGW) {
        const int hs = F.lane >> 4, dc = (F.lane & 15) * 8;
        const float l0 = lse[(size_t)t * 12 + hs], l1 = lse[(size_t)t * 12 + 4 + hs], l2 = lse[(size_t)t * 12 + 8 + hs];
        const float mx = fmaxf(l0, fmaxf(l1, l2));
        float w0 = __builtin_amdgcn_exp2f(l0 - mx), w1 = __builtin_amdgcn_exp2f(l1 - mx), w2 = __builtin_amdgcn_exp2f(l2 - mx);
        const float inv = 1.0f / (w0 + w1 + w2); w0 *= inv; w1 *= inv; w2 *= inv;
        f32x4 a0, a1, b0, b1, c0, c1;
        unpk8(*(const GAS u32x4*)(od + (size_t)t * 1536 + hs * 128 + dc), a0, a1);
        unpk8(*(const GAS u32x4*)(od + (size_t)t * 1536 + 512 + hs * 128 + dc), b0, b1);
        unpk8(*(const GAS u32x4*)(od + (size_t)t * 1536 + 1024 + hs * 128 + dc), c0, c1);
        const f32x4 r0 = a0 * w0 + b0 * w1 + c0 * w2, r1 = a1 * w0 + b1 * w1 + c1 * w2;
        *(GAS u32x4*)(odil + (size_t)t * 512 + hs * 128 + dc) = pk8(r0, r1);
    }
}

__device__ __forceinline__ void p8_router(const Frame& F, const Args& a) {
    constexpr int HP = 4128;
    LAS unsigned char* h2l = F.lds; LAS float* lg = (LAS float*)(F.lds + 32 * HP);
    const float* mod = wsp<float>(F, WS_MOD); const h16* yat = wsp<h16>(F, A_YAT); h16* h2 = wsp<h16>(F, A_H2); const h16* wr_t = wsp<h16>(F, W_R);
    unsigned* cnt = wsp<unsigned>(F, WS_CTL) + CW_CNT; unsigned* list = wsp<unsigned>(F, WS_LIST); unsigned* tokpos = wsp<unsigned>(F, WS_TOKPOS); float* tokw = wsp<float>(F, WS_TOKW);
    const int fr = F.lane & 15, fq = F.lane >> 4;
    for (int tb = F.vcu; tb < NTOK / 32; tb += F.G) {
        __syncthreads();
#pragma unroll 1
        for (int q = 0; q < 4; ++q) {
            const int tl = F.wave * 4 + q, t = tb * 32 + tl, b = t >> 12;
            f32x4 y[8]; float ss = 0.f;
#pragma unroll
            for (int j = 0; j < 8; ++j) { const h16x4 hv = *(const GAS h16x4*)(yat + (size_t)t * DM + 4 * F.lane + 256 * j);
                y[j] = (f32x4){(float)hv[0], (float)hv[1], (float)hv[2], (float)hv[3]}; ss += (y[j][0] * y[j][0] + y[j][1] * y[j][1]) + (y[j][2] * y[j][2] + y[j][3] * y[j][3]); }
            const float rstd1 = 1.0f / sqrtf(wave_sum(ss) * (1.0f / DM) + EPS);
            float ss2 = 0.f;
#pragma unroll
            for (int j = 0; j < 8; ++j) { const int c = 4 * F.lane + 256 * j;
                const f32x4 xv = *(const GAS f32x4*)(a.x + (size_t)t * DM + c), g = *(const f32x4*)(a.attn_post_g + c), ga = *(const f32x4*)(mod + b * 12288 + 2 * 2048 + c);
                const f32x4 xm = xv + ga * (y[j] * rstd1 * g);
                *(GAS f32x4*)(a.out + (size_t)t * DM + c) = xm; y[j] = xm;
                ss2 += (xm[0] * xm[0] + xm[1] * xm[1]) + (xm[2] * xm[2] + xm[3] * xm[3]); }
            const float rstd2 = 1.0f / sqrtf(wave_sum(ss2) * (1.0f / DM) + EPS);
#pragma unroll
            for (int j = 0; j < 8; ++j) { const int c = 4 * F.lane + 256 * j;
                const f32x4 g = *(const f32x4*)(a.ffn_pre_g + c), sc = *(const f32x4*)(mod + b * 12288 + 4 * 2048 + c), sh = *(const f32x4*)(mod + b * 12288 + 3 * 2048 + c);
                const f32x4 h = y[j] * rstd2 * g * (sc + 1.0f) + sh;
                u32x2 w; w.x = pkh(h[0], h[1]); w.y = pkh(h[2], h[3]);
                *(GAS u32x2*)(h2 + (size_t)t * DM + c) = w;
                *(LAS u32x2*)(h2l + tl * HP + c * 2) = w; }
        }
        __syncthreads();
        {
            const int rt = F.wave >> 2, et = F.wave & 3; f32x4 acc = (f32x4){0.f, 0.f, 0.f, 0.f};
            const LAS unsigned char* ap = h2l + (rt * 16 + fr) * HP + fq * 16; const h16* bp = wr_t + (size_t)(et * 16 + fr) * DM + fq * 8;
#pragma unroll 8
            for (int kk = 0; kk < 64; ++kk) { const h16x8 av = *(const LAS h16x8*)(ap + kk * 64); const h16x8 bv = *(const GAS h16x8*)(bp + kk * 32);
                acc = __builtin_amdgcn_mfma_f32_16x16x32_f16(av, bv, acc, 0, 0, 0); }
#pragma unroll
            for (int j = 0; j < 4; ++j) lg[(rt * 16 + 4 * fq + j) * 64 + et * 16 + fr] = acc[j];
        }
        __syncthreads();
#pragma unroll 1
        for (int q = 0; q < 4; ++q) {
            const int tl = F.wave * 4 + q, t = tb * 32 + tl, e = F.lane;
            const float score = 1.0f / (1.0f + expf(-lg[tl * 64 + e])); const float biased = score + a.router_bias[e];
            float m1 = biased;
            m1 = fmaxf(m1, __shfl_xor(m1, 1)); m1 = fmaxf(m1, __shfl_xor(m1, 2)); m1 = fmaxf(m1, __shfl_xor(m1, 4));
            const unsigned long long bal = __ballot(biased == m1); const unsigned gb = (unsigned)(bal >> (e & 56)) & 0xFFu; const int first = __builtin_ctz(gb);
            float v2 = ((e & 7) == first) ? -__builtin_inff() : biased;
            v2 = fmaxf(v2, __shfl_xor(v2, 1)); v2 = fmaxf(v2, __shfl_xor(v2, 2)); v2 = fmaxf(v2, __shfl_xor(v2, 4));
            const float gs = m1 + v2; const int g = e >> 3; int grank = 0;
#pragma unroll
            for (int g2 = 0; g2 < 8; ++g2) { const float s2 = __shfl(gs, g2 * 8); grank += (s2 > gs || (s2 == gs && g2 < g)) ? 1 : 0; }
            const float sel = grank < 4 ? biased : -__builtin_inff(); int rank = 0;
#pragma unroll 16
            for (int e2 = 0; e2 < 64; ++e2) { const float s2 = __shfl(sel, e2); rank += (s2 > sel || (s2 == sel && e2 < e)) ? 1 : 0; }
            const bool chosen = rank < TOPK;
            const float wsum = wave_sum(chosen ? score : 0.f);
            if (chosen) { const float w = score / (wsum + 1e-20f) * 2.5f;
                const unsigned slot = __hip_atomic_fetch_add(cnt + e, 1u, __ATOMIC_RELAXED, __HIP_MEMORY_SCOPE_AGENT);
                list[(size_t)e * LISTCAP + slot] = (unsigned)t; tokpos[(size_t)t * 6 + rank] = ((unsigned)e << 20) | slot; tokw[(size_t)t * 6 + rank] = w; }
        }
    }
}

__device__ __forceinline__ void p11_final(const Frame& F, const Args& a) {
    const int gw = F.vcu * NWAVES + F.wave, NGW = F.G * NWAVES;
    const LAS int* tstart = (const LAS int*)(F.lds + LDS_TAB);
    const float* mod = wsp<float>(F, WS_MOD); const h16* ys = wsp<h16>(F, A_YS); const unsigned* tokpos = wsp<unsigned>(F, WS_TOKPOS); const float* tokw = wsp<float>(F, WS_TOKW);
    for (int t = gw; t < NTOK; t += NGW) {
        const int b = t >> 12;
        unsigned prow = 0; float w = 0.f;
        if (F.lane < 6) { const unsigned p = tokpos[(size_t)t * 6 + F.lane]; prow = (unsigned)tstart[p >> 20] * 256u + (p & 0xFFFFFu); w = tokw[(size_t)t * 6 + F.lane]; }
        if (F.lane == 6) { prow = (unsigned)tstart[64] * 256u + (unsigned)t; w = 1.0f; }
        f32x4 acc[8];
#pragma unroll
        for (int j = 0; j < 8; ++j) acc[j] = (f32x4){0.f, 0.f, 0.f, 0.f};
#pragma unroll
        for (int k = 0; k < 7; ++k) { const unsigned pr = __shfl(prow, k); const float wk = __shfl(w, k);
#pragma unroll
            for (int j = 0; j < 4; ++j) { f32x4 v0, v1; unpk8(*(const GAS u32x4*)(ys + (size_t)pr * DM + 8 * F.lane + 512 * j), v0, v1); acc[2 * j] += v0 * wk; acc[2 * j + 1] += v1 * wk; } }
        float ss = 0.f;
#pragma unroll
        for (int j = 0; j < 8; ++j) ss += (acc[j][0] * acc[j][0] + acc[j][1] * acc[j][1]) + (acc[j][2] * acc[j][2] + acc[j][3] * acc[j][3]);
        const float rstd = 1.0f / sqrtf(wave_sum(ss) * (1.0f / DM) + EPS);
#pragma unroll
        for (int j = 0; j < 8; ++j) { const int c = 8 * F.lane + 512 * (j >> 1) + 4 * (j & 1);
            const f32x4 xm = *(const GAS f32x4*)(a.out + (size_t)t * DM + c), g = *(const f32x4*)(a.ffn_post_g + c), gf = *(const f32x4*)(mod + b * 12288 + 5 * 2048 + c);
            *(GAS f32x4*)(a.out + (size_t)t * DM + c) = xm + gf * (acc[j] * rstd * g); }
    }
}

constexpr int NPHASE = 12;
__global__ void __launch_bounds__(NTHR, 2) mk_fwd(Args args) {
    extern __shared__ __attribute__((aligned(16))) unsigned char lds_raw[];
    Frame F;
    F.lds = (LAS unsigned char*)lds_raw;
    F.tid = threadIdx.x; F.lane = F.tid & 63; F.wave = __builtin_amdgcn_readfirstlane(F.tid >> 6);
    F.G = gridDim.x; { const int bx = blockIdx.x; F.vcu = (F.G % 8 == 0) ? (bx % 8) * (F.G / 8) + bx / 8 : bx; }
    F.ws = args.ws;
    unsigned* ctl = (unsigned*)(args.ws + WS_CTL);
    const int lo = args.ph_lo, hi = args.ph_hi;
    if (F.tid < 16) ((LAS unsigned*)(F.lds + LDS_MISC))[F.tid] = 0u;
    __syncthreads();
    XcdBarrier bar; bar.bar = ctl + CW_BAR; bar.x = 0; bar.st = nullptr;
    if (hi - lo > 1) bar = xcd_barrier_post(ctl + CW_BAR, (volatile LAS unsigned*)(F.lds + LDS_MISC));
#ifndef MK_ONLY
#define MK_ONLY -1
#endif
#define IN(k) ((MK_ONLY < 0 || (k) == MK_ONLY) && lo <= (k) && (k) < hi)
#define SEAM(k) do { if (IN(k) && IN((k) + 1)) xcd_barrier(bar); } while (0)

    if (IN(0)) { p0_prologue(F, args); } SEAM(0);
    if (IN(1)) { p1_h1(F, args); } SEAM(1);
    if (IN(2)) {
        pg8::StaticOrder S; S.init(wsp<h16>(F, A_H1), DM, wsp<h16>(F, W_IN), DM, NPROJ, F.G, (int)blockIdx.x);
        EpiIn E{wsp<h16>(F, A_QA), wsp<h16>(F, A_KR), wsp<h16>(F, A_DIL), wsp<h16>(F, A_GATE), wsp<float>(F, WS_ROWSQ), wsp<float>(F, WS_COSD), wsp<float>(F, WS_SIND), wsp<float>(F, WS_COSM), wsp<float>(F, WS_SINM)};
        pg8::gemm_phase<EpiIn, pg8::StaticOrder, false>(F.lds, DM, DM, S, E);
    } SEAM(2);
    if (IN(3)) {
        UpOrder S{(const char*)wsp<h16>(F, A_QA), (const char*)wsp<h16>(F, W_QUP), (const char*)wsp<h16>(F, W_KVUP), F.G, F.vcu};
        EpiUp E{wsp<h16>(F, A_QM), wsp<h16>(F, A_KV), wsp<float>(F, WS_ROWSQ), wsp<float>(F, WS_COSM), wsp<float>(F, WS_SINM)};
        pg8::gemm_phase<EpiUp, UpOrder, false>(F.lds, 512, 1024, S, E);
    } SEAM(3);
    if (IN(4)) { p4_attention(F); } SEAM(4);
    if (IN(5)) {
        pg8::StaticOrder S; S.init(wsp<h16>(F, A_OMLA), 1024, wsp<h16>(F, W_MO), 1024, DM, F.G, (int)blockIdx.x);
        EpiOut<1> E{wsp<h16>(F, A_M1), DM, wsp<h16>(F, A_GATE), 4096, nullptr};
        pg8::gemm_phase<EpiOut<1>, pg8::StaticOrder, false>(F.lds, 1024, 1024, S, E);
        p5_combine(F);
    } SEAM(5);
    if (IN(6)) {
        pg8::StaticOrder S; S.init(wsp<h16>(F, A_ODIL), 512, wsp<h16>(F, W_DO), 512, DM, F.G, (int)blockIdx.x);
        EpiOut<2> E{wsp<h16>(F, A_MRG), DM, wsp<h16>(F, A_GATE) + 2048, 4096, wsp<h16>(F, A_M1)};
        pg8::gemm_phase<EpiOut<2>, pg8::StaticOrder, false>(F.lds, 512, 512, S, E);
    } SEAM(6);
    if (IN(7)) {
        pg8::StaticOrder S; S.init(wsp<h16>(F, A_MRG), DM, wsp<h16>(F, W_OUT), DM, DM, F.G, (int)blockIdx.x);
        EpiOut<0> E{wsp<h16>(F, A_YAT), DM, nullptr, 0, nullptr};
        pg8::gemm_phase<EpiOut<0>, pg8::StaticOrder, false>(F.lds, DM, DM, S, E);
    } SEAM(7);
    if (IN(8)) { p8_router(F, args); } SEAM(8);
    if (IN(9)) {
        moe_tables(F, ctl + CW_CNT);
        MoeOrder<4, true> S{(const LAS int*)(F.lds + LDS_TAB), (const LAS int*)(F.lds + LDS_TAB + 512), (const LAS int*)(F.lds + LDS_TAB + 1024),
                            (const char*)wsp<h16>(F, A_H2), (const char*)wsp<h16>(F, W_GU), wsp<unsigned>(F, WS_LIST), F.G, F.vcu};
        EpiSwiglu E{wsp<h16>(F, A_ACT)};
        pg8::gemm_phase<EpiSwiglu, MoeOrder<4, true>, true>(F.lds, DM, DM, S, E);
    } SEAM(9);
    if (IN(10)) {
        moe_tables(F, ctl + CW_CNT);
        MoeOrder<8, false> S{(const LAS int*)(F.lds + LDS_TAB), (const LAS int*)(F.lds + LDS_TAB + 512), (const LAS int*)(F.lds + LDS_TAB + 1024),
                             (const char*)wsp<h16>(F, A_ACT), (const char*)wsp<h16>(F, W_DN), wsp<unsigned>(F, WS_LIST), F.G, F.vcu};
        EpiOut<0> E{wsp<h16>(F, A_YS), DM, nullptr, 0, nullptr};
        pg8::gemm_phase<EpiOut<0>, MoeOrder<8, false>, false>(F.lds, 512, 512, S, E);
    } SEAM(10);
    if (IN(11)) { moe_tables(F, ctl + CW_CNT); p11_final(F, args); }
#undef IN
#undef SEAM
}

#if MK_DIAG
constexpr size_t WS_SAVE = 15 * MiB;
__device__ __forceinline__ unsigned hsh(unsigned a) { a ^= a >> 16; a *= 0x7feb352dU; a ^= a >> 15; a *= 0x846ca68bU; a ^= a >> 16; return a; }
__device__ __forceinline__ void dg_put(unsigned* ctl, int slot, float got, float want, float atol) {
    float e = fabsf(got - want) / (fabsf(want) + atol); if (!(e < 1e30f)) e = 1e30f;
    atomicMax(ctl + CW_DIAG + slot, __float_as_uint(e));
}
__device__ __forceinline__ float dg_dot(const h16* arow, const float* W, int K, int ldw, int col) { float s = 0.f; for (int k = 0; k < K; ++k) s += (float)arow[k] * W[(size_t)k * ldw + col]; return s; }
__device__ __forceinline__ void dg_cs(float ang, float& c, float& s_) { const double a = (double)ang; const double tw = 6.283185307179586476925; const double r = a - tw * floor(a / tw); c = cosf((float)r); s_ = sinf((float)r); }
__device__ __forceinline__ int dg_tstart(const unsigned* cnt, int e) { int s = 0; for (int j = 0; j < e; ++j) s += ((j < 64 ? (int)cnt[j] : NTOK) + 255) >> 8; return s; }
__global__ void __launch_bounds__(256) diag_check(Args a, int phase) {
    unsigned char* ws = a.ws; unsigned* ctl = (unsigned*)(ws + WS_CTL);
    const int gid = blockIdx.x * 256 + threadIdx.x; const unsigned h0 = hsh(gid * 7919u + phase * 104729u + 12345u), h1v = hsh(h0 + 1u), h2v = hsh(h0 + 2u);
    const float* mod = (const float*)(ws + WS_MOD);
    __shared__ float red[256 * 6]; __shared__ float sc64[64]; __shared__ float bs64[64];
    if (phase == 0) {
        if (gid < 512) { const int b = h0 & 3, j = h1v % 12288; float s = 0.f; for (int k = 0; k < DM; ++k) { const float v = a.c[b * DM + k]; s += v / (1.f + expf(-v)) * a.w_ada[(size_t)k * 12288 + j]; }
            dg_put(ctl, 0, mod[b * 12288 + j], s + a.b_ada[j], 0.02f); }
        else if (gid < 4096) { const int which = h0 % 9; const int e = h1v & 63; float got, want;
            if (which == 0) { const int k = h2v % DM, n = hsh(h2v) % 9792; got = (float)((const h16*)(ws + W_IN))[(size_t)row_in(n) * DM + k]; want = a.w_in[(size_t)k * 9792 + n]; }
            else if (which == 1) { const int k = h2v % 512, n = hsh(h2v) % 1536; got = (float)((const h16*)(ws + W_QUP))[(size_t)row_qup(n) * 512 + k]; want = a.w_q_up[(size_t)k * 1536 + n] * a.q_a_norm_g[k]; }
            else if (which == 2) { const int k = h2v % 512, n = hsh(h2v) % 2048; got = (float)((const h16*)(ws + W_KVUP))[(size_t)n * 512 + k]; want = a.w_kv_up[(size_t)k * 2048 + n] * a.kv_a_norm_g[k]; }
            else if (which == 3) { const int k = h2v % 1024, n = hsh(h2v) % 2048; got = (float)((const h16*)(ws + W_MO))[(size_t)n * 1024 + k]; want = a.w_mla_o[(size_t)k * 2048 + n]; }
            else if (which == 4) { const int k = h2v % 512, n = hsh(h2v) % 2048; got = (float)((const h16*)(ws + W_DO))[(size_t)n * 512 + k]; want = a.w_dil_o[(size_t)k * 2048 + n]; }
            else if (which == 5) { const int k = h2v % DM, n = hsh(h2v) % 2048; got = (float)((const h16*)(ws + W_OUT))[(size_t)n * DM + k]; want = a.w_out[(size_t)k * DM + n]; }
            else if (which == 6) { const int k = h2v % DM, n = hsh(h2v) % 64; got = (float)((const h16*)(ws + W_R))[(size_t)n * DM + k]; want = a.w_router[(size_t)k * 64 + n]; }
            else if (which == 7) { const int k = h2v % DM, n = hsh(h2v) % 512, up = (h2v >> 20) & 1; const int ee = (h1v % 65);
                got = (float)((const h16*)(ws + W_GU))[((size_t)ee * 1024 + (n >> 7) * 256 + up * 128 + (n & 127)) * DM + k];
                const float* src = ee < 64 ? (up ? a.w_exp_up : a.w_exp_gate) + (size_t)ee * DM * 512 : (up ? a.w_sh_up : a.w_sh_gate); want = src[(size_t)k * 512 + n]; }
            else { const int k = h2v % 512, n = hsh(h2v) % DM; const int ee = (h1v % 65);
                got = (float)((const h16*)(ws + W_DN))[((size_t)ee * 2048 + n) * 512 + k]; const float* src = ee < 64 ? a.w_exp_down + (size_t)ee * 512 * DM : a.w_sh_down; want = src[(size_t)k * DM + n]; }
            (void)e; dg_put(ctl, 0, got, want, 1e-3f); }
        else if (gid < 8192) { const int t = h0 % NTOK, j = h1v % 48; const float pf = (float)a.pos[t]; float c, s_;
            if (j < 16) { dg_cs(pf * a.invf_d[j], c, s_); dg_put(ctl, 0, ((const float*)(ws + WS_COSD))[t * 16 + j], c, 0.05f); dg_put(ctl, 0, ((const float*)(ws + WS_SIND))[t * 16 + j], s_, 0.05f); }
            else { dg_cs(pf * a.invf_m[j - 16], c, s_); dg_put(ctl, 0, ((const float*)(ws + WS_COSM))[t * 32 + j - 16], c, 0.05f); dg_put(ctl, 0, ((const float*)(ws + WS_SINM))[t * 32 + j - 16], s_, 0.05f); } }
    } else if (phase == 1) {
        if (gid < 2048) { const int t = h0 % NTOK, c = h1v % DM, b = t >> 12; float ss = 0.f; for (int k = 0; k < DM; ++k) { const float v = a.x[(size_t)t * DM + k]; ss += v * v; }
            const float rstd = 1.f / sqrtf(ss / DM + EPS); const float want = a.x[(size_t)t * DM + c] * rstd * a.attn_pre_g[c] * (1.f + mod[b * 12288 + 2048 + c]) + mod[b * 12288 + c];
            dg_put(ctl, 1, (float)((const h16*)(ws + A_H1))[(size_t)t * DM + c], want, 0.05f); }
    } else if (phase == 2) {
        const h16* h1 = (const h16*)(ws + A_H1);
        if (gid < 4096) { const int t = h0 % NTOK; int c = h1v % 9792; const h16* ar = h1 + (size_t)t * DM; const float pf = (float)a.pos[t]; float got, want;
            if (c < 1024) { want = dg_dot(ar, a.w_in, DM, 9792, c); got = (float)((const h16*)(ws + A_QA))[(size_t)t * 1024 + c]; }
            else if (c < 1088) { const int i = (c - 1024) & 31, second = (c - 1024) >> 5; const float t1 = dg_dot(ar, a.w_in, DM, 9792, 1024 + i), t2 = dg_dot(ar, a.w_in, DM, 9792, 1024 + 32 + i);
                float cs, sn; dg_cs(pf * a.invf_m[i], cs, sn); want = second ? t2 * cs + t1 * sn : t1 * cs - t2 * sn; got = (float)((const h16*)(ws + A_KR))[(size_t)t * 64 + 2 * i + second]; }
            else if (c < 5696) { const int dc = c - 1088, part = dc / 1536, hd = (dc % 1536) >> 7, dim = dc & 127;
                if (part < 2 && dim < 32) { const int i = dim & 15, second = dim >> 4; const int cb = c - dim; const float t1 = dg_dot(ar, a.w_in, DM, 9792, cb + i), t2 = dg_dot(ar, a.w_in, DM, 9792, cb + 16 + i);
                    float cs, sn; dg_cs(pf * a.invf_d[i], cs, sn); want = second ? t2 * cs + t1 * sn : t1 * cs - t2 * sn; if (part == 0) want *= QS_D;
                    got = (float)((const h16*)(ws + A_DIL))[(size_t)t * 4608 + part * 1536 + hd * 128 + 2 * i + second]; }
                else { want = dg_dot(ar, a.w_in, DM, 9792, c); if (part == 0) want *= QS_D; got = (float)((const h16*)(ws + A_DIL))[(size_t)t * 4608 + dc]; } }
            else { want = 1.f / (1.f + expf(-dg_dot(ar, a.w_in, DM, 9792, c))); got = (float)((const h16*)(ws + A_GATE))[(size_t)t * 4096 + (c - 5696)]; }
            dg_put(ctl, 2, got, want, 0.05f); }
        else if (gid < 4608) { const int t = h0 % NTOK, which = h1v & 1; const h16* qa = (const h16*)(ws + A_QA) + (size_t)t * 1024 + which * 512; float ss = 0.f; for (int k = 0; k < 512; ++k) ss += (float)qa[k] * (float)qa[k];
            const float* rq = (const float*)(ws + WS_ROWSQ) + (size_t)t * 16 + which * 8; float g = 0.f; for (int k = 0; k < 8; ++k) g += rq[k]; dg_put(ctl, 2, g, ss, 1.0f); }
    } else if (phase == 3) {
        if (gid < 4096) { const int t = h0 % NTOK, which = h1v & 1; const h16* qa = (const h16*)(ws + A_QA) + (size_t)t * 1024 + which * 512; const float pf = (float)a.pos[t];
            float ss = 0.f; for (int k = 0; k < 512; ++k) ss += (float)qa[k] * (float)qa[k]; const float rstd = 1.f / sqrtf(ss / 512.f + EPS); float got, want;
            if (which == 0) { const int cq = h2v % 1536, hd = cq / 192, j = cq % 192;
                if (j < 128) { float s_ = 0.f; for (int k = 0; k < 512; ++k) s_ += (float)qa[k] * rstd * a.q_a_norm_g[k] * a.w_q_up[(size_t)k * 1536 + cq]; want = s_ * QS_M; got = (float)((const h16*)(ws + A_QM))[(size_t)t * 1536 + hd * 128 + j]; }
                else { const int i = (j - 128) & 31, second = (j - 128) >> 5; float t1 = 0.f, t2 = 0.f;
                    for (int k = 0; k < 512; ++k) { const float nv = (float)qa[k] * rstd * a.q_a_norm_g[k]; t1 += nv * a.w_q_up[(size_t)k * 1536 + hd * 192 + 128 + i]; t2 += nv * a.w_q_up[(size_t)k * 1536 + hd * 192 + 160 + i]; }
                    float cs, sn; dg_cs(pf * a.invf_m[i], cs, sn); want = (second ? t2 * cs + t1 * sn : t1 * cs - t2 * sn) * QS_M; got = (float)((const h16*)(ws + A_QM))[(size_t)t * 1536 + 1024 + hd * 64 + 2 * i + second]; } }
            else { const int c = h2v % 2048; float s_ = 0.f; for (int k = 0; k < 512; ++k) s_ += (float)qa[k] * rstd * a.kv_a_norm_g[k] * a.w_kv_up[(size_t)k * 2048 + c]; want = s_; got = (float)((const h16*)(ws + A_KV))[(size_t)t * 2048 + c]; }
            dg_put(ctl, 3, got, want, 0.05f); }
    } else if (phase == 4) {
        const unsigned hb = hsh(blockIdx.x * 2654435761u + 777u); const int t = hb % NTOK, b = t >> 12, sp = t & 4095; const int tid = threadIdx.x;
        float m = -1e30f, l = 0.f, o0 = 0.f, o1 = 0.f, o2 = 0.f, o3 = 0.f; const int dsel = (hb >> 16) & 31;
        if (blockIdx.x < 96) { const int hd = (hb >> 21) & 7; const h16* q = (const h16*)(ws + A_QM) + (size_t)t * 1536;
            for (int kp = tid; kp <= sp; kp += 256) { const size_t tk = (size_t)b * SEQ + kp; const h16* kk = (const h16*)(ws + A_KV) + tk * 2048 + hd * 256; const h16* kr = (const h16*)(ws + A_KR) + tk * 64;
                float s_ = 0.f; for (int d = 0; d < 128; ++d) s_ += (float)q[hd * 128 + d] * (float)kk[d]; for (int d = 0; d < 64; ++d) s_ += (float)q[1024 + hd * 64 + d] * (float)kr[d];
                const float mn = fmaxf(m, s_), al = exp2f(m - mn), pp = exp2f(s_ - mn); l = l * al + pp; o0 = o0 * al + pp * (float)kk[128 + dsel]; o1 = o1 * al + pp * (float)kk[128 + dsel + 32]; o2 = o2 * al + pp * (float)kk[128 + dsel + 64]; o3 = o3 * al + pp * (float)kk[128 + dsel + 96]; m = mn; }
        } else { const int head = (hb >> 21) % 12, g = head >> 2, dd = g == 0 ? 1 : g == 1 ? 4 : 16; const h16* q = (const h16*)(ws + A_DIL) + (size_t)t * 4608 + head * 128;
            for (int j = tid; j <= 128; j += 256) { const int kp = sp - dd * j; if (kp < 0) continue; const size_t tk = (size_t)b * SEQ + kp; const h16* kk = (const h16*)(ws + A_DIL) + tk * 4608 + 1536 + head * 128; const h16* vv = (const h16*)(ws + A_DIL) + tk * 4608 + 3072 + head * 128;
                float s_ = 0.f; for (int d = 0; d < 128; ++d) s_ += (float)q[d] * (float)kk[d];
                const float mn = fmaxf(m, s_), al = exp2f(m - mn), pp = exp2f(s_ - mn); l = l * al + pp; o0 = o0 * al + pp * (float)vv[dsel]; o1 = o1 * al + pp * (float)vv[dsel + 32]; o2 = o2 * al + pp * (float)vv[dsel + 64]; o3 = o3 * al + pp * (float)vv[dsel + 96]; m = mn; } }
        red[tid * 6 + 0] = m; red[tid * 6 + 1] = l; red[tid * 6 + 2] = o0; red[tid * 6 + 3] = o1; red[tid * 6 + 4] = o2; red[tid * 6 + 5] = o3; __syncthreads();
        if (tid == 0) { float M = -1e30f; for (int i = 0; i < 256; ++i) M = fmaxf(M, red[i * 6]); float L = 0.f, O0 = 0.f, O1 = 0.f, O2 = 0.f, O3 = 0.f;
            for (int i = 0; i < 256; ++i) { const float w = exp2f(red[i * 6] - M); L += red[i * 6 + 1] * w; O0 += red[i * 6 + 2] * w; O1 += red[i * 6 + 3] * w; O2 += red[i * 6 + 4] * w; O3 += red[i * 6 + 5] * w; }
            if (blockIdx.x < 96) { const int hd = (hb >> 21) & 7; const h16* og = (const h16*)(ws + A_OMLA) + (size_t)t * 1024 + hd * 128;
                dg_put(ctl, 4, (float)og[dsel], O0 / L, 0.02f); dg_put(ctl, 4, (float)og[dsel + 32], O1 / L, 0.02f); dg_put(ctl, 4, (float)og[dsel + 64], O2 / L, 0.02f); dg_put(ctl, 4, (float)og[dsel + 96], O3 / L, 0.02f); }
            else { const int head = (hb >> 21) % 12; const h16* og = (const h16*)(ws + A_OD) + (size_t)t * 1536 + head * 128;
                dg_put(ctl, 5, (float)og[dsel], O0 / L, 0.02f); dg_put(ctl, 5, (float)og[dsel + 32], O1 / L, 0.02f); dg_put(ctl, 5, (float)og[dsel + 64], O2 / L, 0.02f); dg_put(ctl, 5, (float)og[dsel + 96], O3 / L, 0.02f);
                dg_put(ctl, 5, ((const float*)(ws + WS_LSE))[(size_t)t * 12 + head], M + log2f(L), 0.5f); } }
    } else if (phase == 5) {
        if (gid < 2048) { const int t = h0 % NTOK, n = h1v % DM; const float want = dg_dot((const h16*)(ws + A_OMLA) + (size_t)t * 1024, a.w_mla_o, 1024, DM, n) * (float)((const h16*)(ws + A_GATE))[(size_t)t * 4096 + n];
            dg_put(ctl, 6, (float)((const h16*)(ws + A_M1))[(size_t)t * DM + n], want, 0.05f); }
        else if (gid < 4096) { const int t = h0 % NTOK, hs = h1v & 3, d = h2v & 127; const float* ls = (const float*)(ws + WS_LSE) + (size_t)t * 12; const h16* od = (const h16*)(ws + A_OD) + (size_t)t * 1536;
            const float mx = fmaxf(ls[hs], fmaxf(ls[4 + hs], ls[8 + hs])); const float w0 = exp2f(ls[hs] - mx), w1 = exp2f(ls[4 + hs] - mx), w2 = exp2f(ls[8 + hs] - mx);
            const float want = (w0 * (float)od[hs * 128 + d] + w1 * (float)od[512 + hs * 128 + d] + w2 * (float)od[1024 + hs * 128 + d]) / (w0 + w1 + w2);
            dg_put(ctl, 7, (float)((const h16*)(ws + A_ODIL))[(size_t)t * 512 + hs * 128 + d], want, 0.02f); }
    } else if (phase == 6) {
        if (gid < 2048) { const int t = h0 % NTOK, n = h1v % DM; const float want = (float)((const h16*)(ws + A_M1))[(size_t)t * DM + n] + dg_dot((const h16*)(ws + A_ODIL) + (size_t)t * 512, a.w_dil_o, 512, DM, n) * (float)((const h16*)(ws + A_GATE))[(size_t)t * 4096 + 2048 + n];
            dg_put(ctl, 8, (float)((const h16*)(ws + A_MRG))[(size_t)t * DM + n], want, 0.05f); }
    } else if (phase == 7) {
        if (gid < 2048) { const int t = h0 % NTOK, n = h1v % DM; const float want = dg_dot((const h16*)(ws + A_MRG) + (size_t)t * DM, a.w_out, DM, DM, n);
            dg_put(ctl, 9, (float)((const h16*)(ws + A_YAT))[(size_t)t * DM + n], want, 0.05f); }
    } else if (phase == 8) {
        if (gid < 1024) { const int t = h0 % NTOK, c = h1v % DM, b = t >> 12; const h16* y = (const h16*)(ws + A_YAT) + (size_t)t * DM; float ss = 0.f; for (int k = 0; k < DM; ++k) ss += (float)y[k] * (float)y[k];
            const float r1 = 1.f / sqrtf(ss / DM + EPS); float ss2 = 0.f, xc = 0.f;
            for (int k = 0; k < DM; ++k) { const float xm = a.x[(size_t)t * DM + k] + mod[b * 12288 + 4096 + k] * ((float)y[k] * r1 * a.attn_post_g[k]); ss2 += xm * xm; if (k == c) xc = xm; }
            const float r2 = 1.f / sqrtf(ss2 / DM + EPS);
            dg_put(ctl, 10, a.out[(size_t)t * DM + c], xc, 0.05f);
            dg_put(ctl, 10, (float)((const h16*)(ws + A_H2))[(size_t)t * DM + c], xc * r2 * a.ffn_pre_g[c] * (1.f + mod[b * 12288 + 4 * 2048 + c]) + mod[b * 12288 + 3 * 2048 + c], 0.05f); }
        if (blockIdx.x >= 8 && blockIdx.x < 72) {
            const unsigned hb = hsh(blockIdx.x * 2654435761u + 99u); const int t = hb % NTOK; const int tid = threadIdx.x;
            if (tid < 64) { const float lgt = dg_dot((const h16*)(ws + A_H2) + (size_t)t * DM, a.w_router, DM, 64, tid); const float sc = 1.f / (1.f + expf(-lgt)); sc64[tid] = sc; bs64[tid] = sc + a.router_bias[tid]; }
            __syncthreads();
            if (tid == 0) { unsigned gsel = 0u; float bad = 0.f;
                for (int r = 0; r < 4; ++r) { int best = -1; float bv = -1e30f; for (int g = 0; g < 8; ++g) { if (gsel >> g & 1u) continue; float m1 = -1e30f, m2 = -1e30f; for (int j = 0; j < 8; ++j) { const float v = bs64[g * 8 + j]; if (v > m1) { m2 = m1; m1 = v; } else if (v > m2) m2 = v; } if (m1 + m2 > bv) { bv = m1 + m2; best = g; } } gsel |= 1u << best; }
                unsigned long long esel = 0ull; float wsum = 0.f;
                for (int r = 0; r < 6; ++r) { int best = -1; float bv = -1e30f; for (int e = 0; e < 64; ++e) { if (!(gsel >> (e >> 3) & 1u) || (esel >> e & 1ull)) continue; if (bs64[e] > bv) { bv = bs64[e]; best = e; } } esel |= 1ull << best; wsum += sc64[best];
                    const unsigned pk = ((const unsigned*)(ws + WS_TOKPOS))[(size_t)t * 6 + r]; const int ge = pk >> 20, slot = pk & 0xFFFFF; if (ge != best) bad += 1.f; else if (((const unsigned*)(ws + WS_LIST))[(size_t)ge * LISTCAP + slot] != (unsigned)t) bad += 1.f; }
                for (int r = 0; r < 6; ++r) { const unsigned pk = ((const unsigned*)(ws + WS_TOKPOS))[(size_t)t * 6 + r]; const int ge = pk >> 20; const float w = ((const float*)(ws + WS_TOKW))[(size_t)t * 6 + r]; if (fabsf(w - sc64[ge] / (wsum + 1e-20f) * 2.5f) > 0.01f) bad += 1.f; }
                atomicAdd((float*)(ctl + CW_DIAG + 11), bad / (64.f * 12.f)); }
        }
        if (gid == 0) { unsigned tot = 0; for (int e = 0; e < 64; ++e) tot += ctl[CW_CNT + e]; dg_put(ctl, 10, (float)tot, (float)(NTOK * 6), 1.0f); }
    } else if (phase == 9 || phase == 10) {
        const unsigned* cnt = ctl + CW_CNT;
        if (gid < 2048) { const int t = h0 % NTOK, k = h1v % 7; int e, slot; if (k == 6) { e = 64; slot = t; } else { const unsigned pk = ((const unsigned*)(ws + WS_TOKPOS))[(size_t)t * 6 + k]; e = pk >> 20; slot = pk & 0xFFFFF; }
            const size_t prow = (size_t)dg_tstart(cnt, e) * 256 + slot;
            if (phase == 9) { const int n = h2v % 512; const float* wg = e < 64 ? a.w_exp_gate + (size_t)e * DM * 512 : a.w_sh_gate; const float* wu = e < 64 ? a.w_exp_up + (size_t)e * DM * 512 : a.w_sh_up;
                const h16* hr = (const h16*)(ws + A_H2) + (size_t)t * DM; const float g = dg_dot(hr, wg, DM, 512, n), u = dg_dot(hr, wu, DM, 512, n);
                dg_put(ctl, 12, (float)((const h16*)(ws + A_ACT))[prow * 512 + n], g / (1.f + expf(-g)) * u, 0.05f); }
            else { const int n = h2v % DM; const float* wd = e < 64 ? a.w_exp_down + (size_t)e * 512 * DM : a.w_sh_down;
                dg_put(ctl, 13, (float)((const h16*)(ws + A_YS))[prow * DM + n], dg_dot((const h16*)(ws + A_ACT) + prow * 512, wd, 512, DM, n), 0.05f); } }
    } else if (phase == 100) {
        const int si = blockIdx.x; if (si < 64) { const int t = hsh(si * 31337u + 5u) % NTOK; float* sv = (float*)(ws + WS_SAVE) + (size_t)si * DM; for (int c = threadIdx.x; c < DM; c += 256) sv[c] = a.out[(size_t)t * DM + c]; }
    } else if (phase == 11) {
        const int si = blockIdx.x; if (si < 64) { const int t = hsh(si * 31337u + 5u) % NTOK, b = t >> 12; const unsigned* cnt = ctl + CW_CNT; const float* sv = (const float*)(ws + WS_SAVE) + (size_t)si * DM; const int tid = threadIdx.x;
            float vals[8]; float ss = 0.f;
#pragma unroll
            for (int q = 0; q < 8; ++q) { const int c = tid + 256 * q; float s_ = (float)((const h16*)(ws + A_YS))[((size_t)dg_tstart(cnt, 64) * 256 + t) * DM + c];
                for (int k = 0; k < 6; ++k) { const unsigned pk = ((const unsigned*)(ws + WS_TOKPOS))[(size_t)t * 6 + k]; const int e = pk >> 20, slot = pk & 0xFFFFF;
                    s_ += ((const float*)(ws + WS_TOKW))[(size_t)t * 6 + k] * (float)((const h16*)(ws + A_YS))[((size_t)dg_tstart(cnt, e) * 256 + slot) * DM + c]; }
                vals[q] = s_; ss += s_ * s_; }
            red[tid] = ss; __syncthreads(); if (tid == 0) { float tot = 0.f; for (int i = 0; i < 256; ++i) tot += red[i]; red[256] = tot; } __syncthreads();
            const float rstd = 1.f / sqrtf(red[256] / DM + EPS);
#pragma unroll
            for (int q = 0; q < 8; ++q) { const int c = tid + 256 * q; dg_put(ctl, 14, a.out[(size_t)t * DM + c], sv[c] + mod[b * 12288 + 5 * 2048 + c] * (vals[q] * rstd * a.ffn_post_g[c]), 0.05f); } }
    }
}
__global__ void __launch_bounds__(256) diag_final(Args a) {
    unsigned* ctl = (unsigned*)(a.ws + WS_CTL); int code = 0;
    for (int sl = 14; sl >= 0; --sl) { const float e = __uint_as_float(ctl[CW_DIAG + sl]); const float thr = (sl == 11) ? 0.08f : 0.03f; if (!(e <= thr)) code = sl + 1; }
    if (code == 0) return;
    const float f = 1.0f + 0.5f * (float)code;
    for (size_t i = (size_t)blockIdx.x * 256 + threadIdx.x; i < (size_t)NTOK * DM; i += (size_t)gridDim.x * 256) a.out[i] = a.x[i] * f;
}
#endif

extern "C" void kernel_launch(void* const* d_in, const int* in_sizes, int n_in, void* d_out, int out_size, void* d_ws, size_t ws_size, hipStream_t stream) {
    static int grid = 0;
    if (grid == 0) {
        if (n_in != 25 || in_sizes[0] != NTOK * DM || out_size != NTOK * DM || ws_size < WS_END) {
            fprintf(stderr, "kernel_launch: unexpected shapes / workspace (n_in %d, ws %zu, need %zu); nothing launched\n", n_in, ws_size, (size_t)WS_END); grid = -1; return; }
        int dev = 0, cus = 0, per_cu = 0;
        if (hipGetDevice(&dev) != hipSuccess || hipDeviceGetAttribute(&cus, hipDeviceAttributeMultiprocessorCount, dev) != hipSuccess) { grid = -1; return; }
        if (hipFuncSetAttribute((const void*)mk_fwd, hipFuncAttributeMaxDynamicSharedMemorySize, LDS_BYTES) != hipSuccess) { fprintf(stderr, "kernel_launch: hipFuncSetAttribute failed\n"); grid = -1; return; }
        if (hipOccupancyMaxActiveBlocksPerMultiprocessor(&per_cu, (const void*)mk_fwd, NTHR, LDS_BYTES) != hipSuccess || per_cu < 1)
            fprintf(stderr, "kernel_launch: note: occupancy query reports %d workgroups per CU\n", per_cu);
        (void)hipGetLastError();
        grid = cus;
    }
    if (grid < 0) return;
    if (hipMemsetAsync((char*)d_ws + WS_CTL, 0, CTL_ZERO_BYTES, stream) != hipSuccess) return;
    Args a{};
    a.x = (const float*)d_in[0]; a.c = (const float*)d_in[1]; a.pos = (const int*)d_in[2]; a.w_ada = (const float*)d_in[3]; a.b_ada = (const float*)d_in[4];
    a.attn_pre_g = (const float*)d_in[5]; a.w_in = (const float*)d_in[6]; a.q_a_norm_g = (const float*)d_in[7]; a.w_q_up = (const float*)d_in[8];
    a.kv_a_norm_g = (const float*)d_in[9]; a.w_kv_up = (const float*)d_in[10]; a.w_mla_o = (const float*)d_in[11]; a.w_dil_o = (const float*)d_in[12];
    a.w_out = (const float*)d_in[13]; a.attn_post_g = (const float*)d_in[14]; a.ffn_pre_g = (const float*)d_in[15]; a.w_router = (const float*)d_in[16];
    a.router_bias = (const float*)d_in[17]; a.w_exp_gate = (const float*)d_in[18]; a.w_exp_up = (const float*)d_in[19]; a.w_exp_down = (const float*)d_in[20];
    a.w_sh_gate = (const float*)d_in[21]; a.w_sh_up = (const float*)d_in[22]; a.w_sh_down = (const float*)d_in[23]; a.ffn_post_g = (const float*)d_in[24];
    a.out = (float*)d_out; a.ws = (unsigned char*)d_ws;
    for (int i = 0; i < 16; ++i) a.invf_d[i] = 1.0f / powf(500000.0f, (float)(2 * i) / 32.0f);
    for (int i = 0; i < 32; ++i) a.invf_m[i] = 1.0f / powf(500000.0f, (float)(2 * i) / 64.0f);
#if MK_LAUNCHES == 1
    a.ph_lo = 0; a.ph_hi = NPHASE;
    hipLaunchKernelGGL(mk_fwd, dim3(grid), dim3(NTHR), LDS_BYTES, stream, a);
#else
#ifndef MK_STOP
#define MK_STOP NPHASE
#endif
    for (int p = 0; p < MK_STOP; ++p) { a.ph_lo = p; a.ph_hi = p + 1;
#if MK_DIAG
        if (p == 11) hipLaunchKernelGGL(diag_check, dim3(256), dim3(256), 0, stream, a, 100);
#endif
        hipLaunchKernelGGL(mk_fwd, dim3(grid), dim3(NTHR), LDS_BYTES, stream, a);
#if MK_DIAG
        hipLaunchKernelGGL(diag_check, dim3(256), dim3(256), 0, stream, a, p);
#endif
    }
#if MK_DIAG
    hipLaunchKernelGGL(diag_final, dim3(1024), dim3(256), 0, stream, a);
#endif
#endif
}
```

```cpp
#include <hip/hip_runtime.h>
#include <cstdio>
#include <cstdint>
#include <cmath>

#ifndef MK_LAUNCHES
#define MK_LAUNCHES 1
#endif
#ifndef MK_DIAG
#define MK_DIAG 0
#endif

#define GAS __attribute__((address_space(1)))
#define LAS __attribute__((address_space(3)))
typedef _Float16 h16;
typedef _Float16 h16x8 __attribute__((ext_vector_type(8)));
typedef _Float16 h16x4 __attribute__((ext_vector_type(4)));
typedef _Float16 h16x2 __attribute__((ext_vector_type(2)));
typedef short s16x4 __attribute__((ext_vector_type(4)));
typedef float f32x4 __attribute__((ext_vector_type(4)));
typedef float f32x2 __attribute__((ext_vector_type(2)));
typedef float f32x16 __attribute__((ext_vector_type(16)));
typedef unsigned u32x4 __attribute__((ext_vector_type(4)));
typedef unsigned u32x2 __attribute__((ext_vector_type(2)));

constexpr int NB = 4, SEQ = 4096, NTOK = NB * SEQ, DM = 2048;
constexpr int NPROJ = 9984;
constexpr int NEXP = 64, TOPK = 6, EDIM = 512;
constexpr int LISTCAP = 16384;
constexpr int MAXTILES = 512;
constexpr float EPS = 1e-6f;
constexpr float LOG2E = 1.4426950408889634f;
constexpr float QS_M = 0.07216878364870322f * LOG2E;
constexpr float QS_D = 0.08838834764831845f * LOG2E;

constexpr size_t MiB = 1u << 20;
constexpr size_t WS_CTL = 0, CTL_ZERO_BYTES = 1 * MiB;
constexpr size_t WS_ROWSQ = 1 * MiB;
constexpr size_t WS_MOD = 2 * MiB;
constexpr size_t WS_COSD = 3 * MiB, WS_SIND = 4 * MiB;
constexpr size_t WS_COSM = 5 * MiB, WS_SINM = 7 * MiB;
constexpr size_t WS_LSE = 9 * MiB;
constexpr size_t WS_TOKPOS = 10 * MiB;
constexpr size_t WS_TOKW = 10 * MiB + 512 * 1024;
constexpr size_t WS_LIST = 11 * MiB;
constexpr size_t WS_W = 16 * MiB;
constexpr size_t W_IN = WS_W;
constexpr size_t W_QUP = W_IN + 39 * MiB;
constexpr size_t W_KVUP = W_QUP + 3 * MiB / 2;
constexpr size_t W_MO = W_KVUP + 2 * MiB;
constexpr size_t W_DO = W_MO + 4 * MiB;
constexpr size_t W_OUT = W_DO + 2 * MiB;
constexpr size_t W_R = W_OUT + 8 * MiB;
constexpr size_t W_GU = W_R + MiB / 4;
constexpr size_t W_DN = W_GU + 260 * MiB;
constexpr size_t WS_AR = W_DN + 130 * MiB;
static_assert(WS_AR == (16 + 447) * MiB - MiB / 4, "weights");
constexpr size_t AR = ((WS_AR + MiB - 1) / MiB) * MiB;
constexpr size_t A_YS = AR + 0 * MiB;
constexpr size_t A_ACT = AR + 512 * MiB;
constexpr size_t A_H2 = AR + 0 * MiB;
constexpr size_t A_YAT = AR + 64 * MiB;
constexpr size_t A_MRG = AR + 128 * MiB;
constexpr size_t A_GATE = AR + 192 * MiB;
constexpr size_t A_M1 = AR + 320 * MiB;
constexpr size_t A_ODIL = AR + 384 * MiB;
constexpr size_t A_OMLA = AR + 400 * MiB;
constexpr size_t A_OD = AR + 432 * MiB;
constexpr size_t A_DIL = AR + 0 * MiB;
constexpr size_t A_QM = AR + 144 * MiB;
constexpr size_t A_KV = AR + 480 * MiB;
constexpr size_t A_KR = AR + 544 * MiB;
constexpr size_t A_QA = AR + 546 * MiB;
constexpr size_t A_H1 = AR + 480 * MiB;
constexpr size_t WS_END = AR + 640 * MiB;

constexpr int CW_BAR = 0;
constexpr int CW_CNT = 16384;
constexpr int CW_DIAG = 32768;

constexpr int LDS_BYTES = 147456;
constexpr int LDS_TAB = 131072;
constexpr int LDS_MISC = LDS_BYTES - 64;
constexpr int NWAVES = 8, NTHR = 512;

#define LDS_WAIT() asm volatile("s_waitcnt lgkmcnt(0)" ::: "memory")
#define VM_WAIT() asm volatile("s_waitcnt vmcnt(0)" ::: "memory")

__device__ __forceinline__ unsigned pkh(float a, float b) { h16x2 r; r.x = (h16)a; r.y = (h16)b; return __builtin_bit_cast(unsigned, r); }
__device__ __forceinline__ u32x4 pk8(f32x4 a, f32x4 b) { u32x4 w; w.x = pkh(a[0], a[1]); w.y = pkh(a[2], a[3]); w.z = pkh(b[0], b[1]); w.w = pkh(b[2], b[3]); return w; }
__device__ __forceinline__ float wave_sum(float v) {
#pragma unroll
    for (int o = 1; o < 64; o <<= 1) v += __shfl_xor(v, o);
    return v;
}
__device__ __forceinline__ float sigmoidf_(float x) { return 1.0f / (1.0f + __expf(-x)); }

#define XB_TMO      128
#define XB_XCNT(j)  (256  + 64 * (j))
#define XB_XSUB(j)  (1280 + 64 * (j))
#define XB_XGEN(j)  (2304 + 64 * (j))
#define XB_TOP      3328
#define XB_TOPGEN   3392
#define XCD_BAR_WORDS 3456
#define XB_SPIN_CAP (1u << 18)
__device__ __forceinline__ unsigned xb_ld(unsigned* p)              { return __hip_atomic_load(p, __ATOMIC_RELAXED, __HIP_MEMORY_SCOPE_AGENT); }
__device__ __forceinline__ unsigned xb_add(unsigned* p, unsigned v) { return __hip_atomic_fetch_add(p, v, __ATOMIC_RELAXED, __HIP_MEMORY_SCOPE_AGENT); }
__device__ __forceinline__ unsigned xb_xcc_id() { return (unsigned)__builtin_amdgcn_s_getreg((3 << 11) | 20) & 0xFu; }
#define XB_SPIN(cond, bar) do { unsigned _sp = 0; while (cond) { __builtin_amdgcn_s_sleep(1); \
    if ((++_sp & 255u) == 0u) { if (xb_ld(&(bar)[XB_TMO])) break; if (_sp > XB_SPIN_CAP) { atomicAdd(&(bar)[XB_TMO], 1u); break; } } } } while (0)
struct XcdBarrier { unsigned* bar; unsigned x; volatile LAS unsigned* st; };
__device__ __forceinline__ XcdBarrier xcd_barrier_post(unsigned* bar, volatile LAS unsigned* st) {
    XcdBarrier b; b.bar = bar; b.x = xb_xcc_id(); b.st = st;
    if (threadIdx.x == 0) (void)xb_add(&bar[XB_XCNT(b.x)], 1u);
    return b;
}
__device__ __forceinline__ void xcd_barrier_complete(unsigned* bar, unsigned x, unsigned& nloc, unsigned& nx) {
    const unsigned G = gridDim.x * gridDim.y * gridDim.z;
    unsigned sum, cnt, mine, sp = 0u;
    for (;;) {
        sum = 0u; cnt = 0u; mine = 0u;
#pragma unroll
        for (unsigned j = 0; j < 16; ++j) { const unsigned c = xb_ld(&bar[XB_XCNT(j)]); sum += c; cnt += (c > 0u) ? 1u : 0u; mine = (j == x) ? c : mine; }
        if (sum == G) break;
        __builtin_amdgcn_s_sleep(1);
        if ((++sp & 255u) == 0u) { if (xb_ld(&bar[XB_TMO])) break; if (sp > XB_SPIN_CAP) { atomicAdd(&bar[XB_TMO], 1u); break; } }
    }
    nloc = mine > 0u ? mine : 1u; nx = cnt > 0u ? cnt : 1u;
}
__device__ __forceinline__ void xcd_barrier(const XcdBarrier& b) {
    asm volatile("s_waitcnt vmcnt(0)" ::: "memory");
    __syncthreads();
    if (threadIdx.x == 0) {
        unsigned* bar = b.bar;
        __builtin_amdgcn_s_waitcnt(0);
        unsigned nloc = b.st[0], nx = b.st[1];
        if (nloc == 0u) { xcd_barrier_complete(bar, b.x, nloc, nx); b.st[0] = nloc; b.st[1] = nx; }
        const unsigned old = xb_add(&bar[XB_XSUB(b.x)], 1u);
        const unsigned gen = old / nloc;
        if (old + 1u == (gen + 1u) * nloc) {
            __builtin_amdgcn_fence(__ATOMIC_RELEASE, "agent");
            asm volatile("s_waitcnt vmcnt(0)" ::: "memory");
            const unsigned og = xb_add(&bar[XB_TOP], 1u);
            const unsigned tg = og / nx;
            if (og + 1u == (tg + 1u) * nx) xb_add(&bar[XB_TOPGEN], 1u);
            else XB_SPIN(xb_ld(&bar[XB_TOPGEN]) == tg, bar);
            __builtin_amdgcn_fence(__ATOMIC_ACQUIRE, "agent");
            xb_add(&bar[XB_XGEN(b.x)], 1u);
            asm volatile("s_waitcnt vmcnt(0)" ::: "memory");
        } else {
            XB_SPIN(xb_ld(&bar[XB_XGEN(b.x)]) == gen, bar);
            __builtin_amdgcn_fence(__ATOMIC_ACQUIRE, "agent");
            asm volatile("s_waitcnt vmcnt(0)" ::: "memory");
        }
    }
    __syncthreads();
}

struct Args {
    const float* x; const float* c; const int* pos; const float* w_ada; const float* b_ada; const float* attn_pre_g; const float* w_in;
    const float* q_a_norm_g; const float* w_q_up; const float* kv_a_norm_g; const float* w_kv_up; const float* w_mla_o; const float* w_dil_o;
    const float* w_out; const float* attn_post_g; const float* ffn_pre_g; const float* w_router; const float* router_bias;
    const float* w_exp_gate; const float* w_exp_up; const float* w_exp_down; const float* w_sh_gate; const float* w_sh_up; const float* w_sh_down;
    const float* ffn_post_g;
    float* out; unsigned char* ws;
    float invf_d[16]; float invf_m[32];
    int ph_lo, ph_hi;
};

struct Frame {
    LAS unsigned char* lds;
    int tid, lane, wave, vcu, G;
    unsigned char* ws;
};
template <class T> __device__ __forceinline__ T* wsp(const Frame& F, size_t off) { return (T*)(F.ws + off); }

namespace pg8 {
constexpr int BM = 256, BK = 64, HALF = 128, HTB = HALF * BK * 2, STAGE_BYTES = 8 * HTB;
__device__ __forceinline__ int lds_byte(int r, int c) { const int st = (r >> 4) * 2 + (c >> 5), rr = r & 15, cc = c & 31, ob = rr * 64 + cc * 2; return st * 1024 + (ob ^ (((ob >> 9) & 1) << 5)); }
__device__ __forceinline__ void stage_rc(int b, int& R, int& C) { const int st = b / 1024, sb = b % 1024, swz = sb ^ (((sb >> 9) & 1) << 5); R = (st >> 1) * 16 + swz / 64; C = (st & 1) * 32 + (swz % 64) / 2; }
__device__ __forceinline__ int perm32(int rho) { const int n = rho >> 4, i = rho & 15; return 8 * (i >> 2) + 4 * n + (i & 3); }

struct Unit { const char* A; const char* B; int pm, pn, e, slot0, cnt, tag; };
typedef f32x4 Acc[2][2][4][2];

template <class Epi, class Sched, bool GATHER>
__device__ __forceinline__ void gemm_phase(LAS unsigned char* lds, const int K, const int lda, const Sched& S, const Epi& E) {
    const int tid = threadIdx.x, wid = __builtin_amdgcn_readfirstlane(tid >> 6), lane = tid & 63, wr = wid >> 2, wc = wid & 3, fr = lane & 15, fq = lane >> 4;
    const int nt = K / BK;
    int sR[2], sC[2];
    unsigned voffB[2], va[2][2], vn[2][2];
#pragma unroll
    for (int i = 0; i < 2; ++i) { int R, C; stage_rc(tid * 16 + i * 8192, R, C); sR[i] = R; sC[i] = C; const int Rb = (R & ~31) + perm32(R & 31);
        voffB[i] = (unsigned)(Rb * K + C) * 2u;
        va[0][i] = (unsigned)(R * lda + C) * 2u; va[1][i] = (unsigned)((R + HALF) * lda + C) * 2u; vn[0][i] = va[0][i]; vn[1][i] = va[1][i]; }
    const size_t kstep = (size_t)(BK * 2);
    const size_t hstepB = (size_t)HALF * K * 2;
    const unsigned ldsw = (unsigned)wid * 1024u;
    const int aoff = lds_byte(wr * 64 + fr, fq * 8), boff = lds_byte(wc * 32 + fr, fq * 8);
#define PG8_SA(b, h) (((b) * 2 + (h)) * HTB)
#define PG8_SB(b, h) ((4 + (b) * 2 + (h)) * HTB)
#define PG8_STAGE(bufoff, gbase, voff) do { _Pragma("unroll") for (int _i = 0; _i < 2; ++_i) \
        __builtin_amdgcn_global_load_lds((const unsigned*)((const char*)(gbase) + (voff)[_i]), (LAS unsigned*)(lds + (bufoff) + ldsw + _i * 8192), 16, 0, 0); } while (0)
#define PG8_LDA(dst, b, h) do { _Pragma("unroll") for (int m = 0; m < 4; ++m) _Pragma("unroll") for (int k = 0; k < 2; ++k) dst[m][k] = *(const LAS h16x8*)(lds + PG8_SA(b, h) + aoff + m * 2048 + k * 1024); } while (0)
#define PG8_LDB(dst, b, h) do { _Pragma("unroll") for (int n = 0; n < 2; ++n) _Pragma("unroll") for (int k = 0; k < 2; ++k) dst[n][k] = *(const LAS h16x8*)(lds + PG8_SB(b, h) + boff + n * 2048 + k * 1024); } while (0)
#define PG8_MMA(ai, bj, At, Bt) do { __builtin_amdgcn_s_setprio(1); _Pragma("unroll") for (int m = 0; m < 4; ++m) _Pragma("unroll") for (int n = 0; n < 2; ++n) _Pragma("unroll") for (int k = 0; k < 2; ++k) \
        acc[ai][bj][m][n] = __builtin_amdgcn_mfma_f32_16x16x32_f16(Bt[n][k], At[m][k], acc[ai][bj][m][n], 0, 0, 0); __builtin_amdgcn_s_setprio(0); } while (0)
#define PG8_WAIT_V(n) asm volatile("s_waitcnt vmcnt(" #n ")" ::: "memory")
#define PG8_WAIT_L(n) asm volatile("s_waitcnt lgkmcnt(" #n ")" ::: "memory")
#define PG8_BAR __builtin_amdgcn_s_barrier()
#define PG8_SCHED __builtin_amdgcn_sched_barrier(0)
    Unit cur, nxt; int ui = 0;
    if (!S.next(0, cur)) return;
    Acc acc;
#pragma unroll
    for (int a = 0; a < 2; ++a)
#pragma unroll
        for (int b = 0; b < 2; ++b)
#pragma unroll
            for (int m = 0; m < 4; ++m)
#pragma unroll
                for (int n = 0; n < 2; ++n) acc[a][b][m][n] = (f32x4){0.f, 0.f, 0.f, 0.f};
    h16x8 At[4][2], B0[2][2], B1[2][2];
    const char* cA = cur.A; const char* cB = cur.B;
    if constexpr (GATHER) {
#pragma unroll
        for (int h = 0; h < 2; ++h)
#pragma unroll
            for (int i = 0; i < 2; ++i) va[h][i] = S.voff(cur, h * HALF + sR[i], sC[i]);
    }
    PG8_STAGE(PG8_SB(0, 0), cB, voffB); PG8_STAGE(PG8_SB(0, 1), cB + hstepB, voffB); PG8_STAGE(PG8_SA(0, 0), cA, va[0]); PG8_STAGE(PG8_SA(0, 1), cA, va[1]);
    if (wr == 1) PG8_BAR;
    PG8_WAIT_V(2); PG8_BAR;
    PG8_STAGE(PG8_SB(1, 0), cB + kstep, voffB); PG8_STAGE(PG8_SA(1, 0), cA + kstep, va[0]); PG8_STAGE(PG8_SB(1, 1), cB + hstepB + kstep, voffB);
    PG8_WAIT_V(6); PG8_BAR;
    for (;;) {
        const bool has_next = S.next(ui + 1, nxt);
        const char* nA = has_next ? nxt.A : cA; const char* nB = has_next ? nxt.B : cB;
        if constexpr (GATHER) {
            if (has_next) {
#pragma unroll
                for (int h = 0; h < 2; ++h)
#pragma unroll
                    for (int i = 0; i < 2; ++i) vn[h][i] = S.voff(nxt, h * HALF + sR[i], sC[i]);
            } else {
#pragma unroll
                for (int h = 0; h < 2; ++h)
#pragma unroll
                    for (int i = 0; i < 2; ++i) vn[h][i] = va[h][i];
            }
        }
        for (int t = 0; t < nt; t += 2) {
            const bool last = (t == nt - 2);
            const char* a1 = cA + (size_t)(t + 1) * kstep;
            const char* a2 = last ? nA : cA + (size_t)(t + 2) * kstep; const char* b2 = last ? nB : cB + (size_t)(t + 2) * kstep;
            const char* a3 = a2 + kstep; const char* b3 = b2 + kstep;
            unsigned v2[2][2];
#pragma unroll
            for (int h = 0; h < 2; ++h)
#pragma unroll
                for (int i = 0; i < 2; ++i) v2[h][i] = (GATHER && last) ? vn[h][i] : va[h][i];
            PG8_LDB(B0, 0, 0); PG8_LDB(B1, 0, 1); PG8_SCHED; PG8_LDA(At, 0, 0); PG8_STAGE(PG8_SA(1, 1), a1, va[1]);
            PG8_WAIT_V(8); PG8_WAIT_L(0); PG8_BAR; PG8_MMA(0, 0, At, B0); PG8_MMA(0, 1, At, B1); PG8_BAR; PG8_SCHED;
            PG8_LDA(At, 0, 1); PG8_STAGE(PG8_SB(0, 0), b2, voffB); PG8_STAGE(PG8_SB(0, 1), b2 + hstepB, voffB); PG8_STAGE(PG8_SA(0, 0), a2, v2[0]);
            PG8_WAIT_V(8); PG8_WAIT_L(0); PG8_BAR; PG8_MMA(1, 0, At, B0); PG8_MMA(1, 1, At, B1); PG8_BAR; PG8_SCHED;
            PG8_LDB(B0, 1, 0); PG8_LDB(B1, 1, 1); PG8_SCHED; PG8_LDA(At, 1, 0); PG8_STAGE(PG8_SA(0, 1), a2, v2[1]);
            PG8_WAIT_V(8); PG8_WAIT_L(0); PG8_BAR; PG8_MMA(0, 0, At, B0); PG8_MMA(0, 1, At, B1); PG8_BAR; PG8_SCHED;
            PG8_LDA(At, 1, 1); PG8_STAGE(PG8_SB(1, 0), b3, voffB); PG8_STAGE(PG8_SB(1, 1), b3 + hstepB, voffB); PG8_STAGE(PG8_SA(1, 0), a3, v2[0]);
            PG8_WAIT_V(8); PG8_WAIT_L(0); PG8_BAR; PG8_MMA(1, 0, At, B0); PG8_MMA(1, 1, At, B1); PG8_BAR; PG8_SCHED;
        }
        if (wr == 0) PG8_BAR;
        E(acc, cur, wr, wc, fr, fq);
        if (!has_next) break;
#pragma unroll
        for (int a = 0; a < 2; ++a)
#pragma unroll
            for (int b = 0; b < 2; ++b)
#pragma unroll
                for (int m = 0; m < 4; ++m)
#pragma unroll
                    for (int n = 0; n < 2; ++n) acc[a][b][m][n] = (f32x4){0.f, 0.f, 0.f, 0.f};
        cur = nxt; cA = nA; cB = nB; ++ui;
        if constexpr (GATHER) {
#pragma unroll
            for (int h = 0; h < 2; ++h)
#pragma unroll
                for (int i = 0; i < 2; ++i) va[h][i] = vn[h][i];
        }
        if (wr == 1) PG8_BAR;
    }
    PG8_WAIT_V(0);
    PG8_BAR;
#undef PG8_SA
#undef PG8_SB
#undef PG8_STAGE
#undef PG8_LDA
#undef PG8_LDB
#undef PG8_MMA
#undef PG8_WAIT_V
#undef PG8_WAIT_L
#undef PG8_BAR
#undef PG8_SCHED
}

struct StaticOrder {
    const char* A; const char* B; size_t a_tile, b_tile;
    int nM, nN, nwg, G, c;
    __device__ __forceinline__ void init(const void* A_, int lda, const void* B_, int K, int N, int G_, int c_) {
        A = (const char*)A_; B = (const char*)B_; a_tile = (size_t)256 * lda * 2; b_tile = (size_t)256 * K * 2; nM = NTOK / BM; nN = N / BM; nwg = nM * nN; G = G_; c = c_; }
    __device__ __forceinline__ bool next(int i, Unit& u) const {
        const long L = (long)i * G + c; if (L >= nwg) return false;
        int wgid = (int)L; { const int q = nwg / 8, r = nwg % 8, xcd = wgid % 8, off = wgid / 8; wgid = (xcd < r ? xcd * (q + 1) : r * (q + 1) + (xcd - r) * q) + off; }
        const int nig = 8 * nN, gid = wgid / nig, fm = gid * 8, gsz = (nM - fm) < 8 ? (nM - fm) : 8;
        u.pm = fm + ((wgid % nig) % gsz); u.pn = (wgid % nig) / gsz; u.e = 0; u.slot0 = 0; u.cnt = 0; u.tag = 0;
        u.A = A + (size_t)u.pm * a_tile; u.B = B + (size_t)u.pn * b_tile; return true;
    }
    __device__ __forceinline__ unsigned voff(const Unit&, int, int) const { return 0u; }
};
}
using pg8::Unit; using pg8::Acc;

#define ACC8(acc, ai, bj, m, v0, v1) const f32x4 v0 = acc[ai][bj][m][0], v1 = acc[ai][bj][m][1]
#define EPI_ROWS(u, wr, fr) const int row0 = (u).pm * 256 + (wr) * 64 + (fr)
__device__ __forceinline__ void rope8(f32x4& v0, f32x4& v1, const f32x4 cs, const f32x4 sn) {
    const float a0 = v0[0] * cs[0] - v0[1] * sn[0], b0 = v0[1] * cs[0] + v0[0] * sn[0];
    const float a1 = v0[2] * cs[1] - v0[3] * sn[1], b1 = v0[3] * cs[1] + v0[2] * sn[1];
    const float a2 = v1[0] * cs[2] - v1[1] * sn[2], b2 = v1[1] * cs[2] + v1[0] * sn[2];
    const float a3 = v1[2] * cs[3] - v1[3] * sn[3], b3 = v1[3] * cs[3] + v1[2] * sn[3];
    v0 = (f32x4){a0, b0, a1, b1}; v1 = (f32x4){a2, b2, a3, b3};
}
struct EpiIn {
    h16* qa; h16* krope; h16* dil; h16* gates; float* rowsq; const float* cosd; const float* sind; const float* cosm; const float* sinm;
    __device__ __forceinline__ void operator()(const Acc& acc, const Unit& u, int wr, int wc, int fr, int fq) const {
        asm volatile("" : "+v"(fr), "+v"(fq));
        EPI_ROWS(u, wr, fr); const int pn = u.pn, colin = wc * 32 + 8 * fq;
        if (pn < 4) {
#pragma unroll
            for (int ai = 0; ai < 2; ++ai)
#pragma unroll
                for (int m = 0; m < 4; ++m) { const int row = row0 + ai * 128 + m * 16; float ss = 0.f;
#pragma unroll
                    for (int bj = 0; bj < 2; ++bj) { ACC8(acc, ai, bj, m, v0, v1);
                        ss += (v0[0] * v0[0] + v0[1] * v0[1]) + (v0[2] * v0[2] + v0[3] * v0[3]) + (v1[0] * v1[0] + v1[1] * v1[1]) + (v1[2] * v1[2] + v1[3] * v1[3]);
                        *(u32x4*)(qa + (size_t)row * 1024 + pn * 256 + bj * 128 + colin) = pk8(v0, v1); }
                    ss += __shfl_xor(ss, 16); ss += __shfl_xor(ss, 32);
                    if (fq == 0) rowsq[(size_t)row * 16 + pn * 4 + wc] = ss; }
        } else if (pn == 4) {
            if (wc < 2) {
#pragma unroll
                for (int ai = 0; ai < 2; ++ai)
#pragma unroll
                    for (int m = 0; m < 4; ++m) { const int row = row0 + ai * 128 + m * 16; f32x4 v0 = acc[ai][0][m][0], v1 = acc[ai][0][m][1];
                        const f32x4 cs = *(const f32x4*)(cosm + (size_t)row * 32 + 16 * wc + 4 * fq), sn = *(const f32x4*)(sinm + (size_t)row * 32 + 16 * wc + 4 * fq);
                        rope8(v0, v1, cs, sn);
                        *(u32x4*)(krope + (size_t)row * 64 + colin) = pk8(v0, v1); }
            }
        } else if (pn < 23) {
            const int part = (pn - 5) / 6;
#pragma unroll
            for (int ai = 0; ai < 2; ++ai)
#pragma unroll
                for (int m = 0; m < 4; ++m) { const int row = row0 + ai * 128 + m * 16;
                    f32x4 cs = (f32x4){1.f, 1.f, 1.f, 1.f}, sn = (f32x4){0.f, 0.f, 0.f, 0.f};
                    if (part < 2 && wc == 0) { cs = *(const f32x4*)(cosd + (size_t)row * 16 + 4 * fq); sn = *(const f32x4*)(sind + (size_t)row * 16 + 4 * fq); }
#pragma unroll
                    for (int bj = 0; bj < 2; ++bj) { f32x4 v0 = acc[ai][bj][m][0], v1 = acc[ai][bj][m][1];
                        if (part < 2 && wc == 0) rope8(v0, v1, cs, sn);
                        if (part == 0) { v0 *= QS_D; v1 *= QS_D; }
                        *(u32x4*)(dil + (size_t)row * 4608 + (pn - 5) * 256 + bj * 128 + colin) = pk8(v0, v1); } }
        } else {
#pragma unroll
            for (int ai = 0; ai < 2; ++ai)
#pragma unroll
                for (int m = 0; m < 4; ++m) { const int row = row0 + ai * 128 + m * 16;
#pragma unroll
                    for (int bj = 0; bj < 2; ++bj) { f32x4 v0 = acc[ai][bj][m][0], v1 = acc[ai][bj][m][1];
#pragma unroll
                        for (int j = 0; j < 4; ++j) { v0[j] = sigmoidf_(v0[j]); v1[j] = sigmoidf_(v1[j]); }
                        *(u32x4*)(gates + (size_t)row * 4096 + (pn - 23) * 256 + bj * 128 + colin) = pk8(v0, v1); } }
        }
    }
};
struct EpiUp {
    h16* qm; h16* kv; const float* rowsq; const float* cosm; const float* sinm;
    __device__ __forceinline__ void operator()(const Acc& acc, const Unit& u, int wr, int wc, int fr, int fq) const {
        asm volatile("" : "+v"(fr), "+v"(fq));
        EPI_ROWS(u, wr, fr); const int pn = u.pn, colin = wc * 32 + 8 * fq;
#pragma unroll
        for (int ai = 0; ai < 2; ++ai)
#pragma unroll
            for (int m = 0; m < 4; ++m) { const int row = row0 + ai * 128 + m * 16;
                const f32x4 s0 = *(const f32x4*)(rowsq + (size_t)row * 16 + u.tag * 8), s1 = *(const f32x4*)(rowsq + (size_t)row * 16 + u.tag * 8 + 4);
                const float ss = ((s0[0] + s0[1]) + (s0[2] + s0[3])) + ((s1[0] + s1[1]) + (s1[2] + s1[3]));
                float rs = __builtin_amdgcn_rsqf(ss * (1.0f / 512.0f) + EPS);
                if (u.tag == 0) {
                    rs *= QS_M;
                    f32x4 cs, sn;
                    if (pn >= 4) { cs = *(const f32x4*)(cosm + (size_t)row * 32 + 16 * (wc & 1) + 4 * fq); sn = *(const f32x4*)(sinm + (size_t)row * 32 + 16 * (wc & 1) + 4 * fq); }
#pragma unroll
                    for (int bj = 0; bj < 2; ++bj) { f32x4 v0 = acc[ai][bj][m][0] * rs, v1 = acc[ai][bj][m][1] * rs;
                        if (pn >= 4) rope8(v0, v1, cs, sn);
                        *(u32x4*)(qm + (size_t)row * 1536 + pn * 256 + bj * 128 + colin) = pk8(v0, v1); }
                } else {
#pragma unroll
                    for (int bj = 0; bj < 2; ++bj) { const f32x4 v0 = acc[ai][bj][m][0] * rs, v1 = acc[ai][bj][m][1] * rs;
                        *(u32x4*)(kv + (size_t)row * 2048 + pn * 256 + bj * 128 + colin) = pk8(v0, v1); }
                }
            }
    }
};
__device__ __forceinline__ void unpk8(const u32x4 w, f32x4& a, f32x4& b) {
    const h16x8 h = __builtin_bit_cast(h16x8, w);
    a = (f32x4){(float)h[0], (float)h[1], (float)h[2], (float)h[3]}; b = (f32x4){(float)h[4], (float)h[5], (float)h[6], (float)h[7]};
}
template <int MODE> struct EpiOut {
    h16* out; int ldc; const h16* gate; int ldg; const h16* add;
    __device__ __forceinline__ void operator()(const Acc& acc, const Unit& u, int wr, int wc, int fr, int fq) const {
        asm volatile("" : "+v"(fr), "+v"(fq));
        EPI_ROWS(u, wr, fr); const int col0 = u.pn * 256 + wc * 32 + 8 * fq;
#pragma unroll
        for (int ai = 0; ai < 2; ++ai)
#pragma unroll
            for (int m = 0; m < 4; ++m) { const int row = row0 + ai * 128 + m * 16;
#pragma unroll
                for (int bj = 0; bj < 2; ++bj) { f32x4 v0 = acc[ai][bj][m][0], v1 = acc[ai][bj][m][1];
                    if (MODE >= 1) { f32x4 g0, g1; unpk8(*(const u32x4*)(gate + (size_t)row * ldg + col0 + bj * 128), g0, g1); v0 *= g0; v1 *= g1; }
                    if (MODE == 2) { f32x4 a0, a1; unpk8(*(const u32x4*)(add + (size_t)row * ldc + col0 + bj * 128), a0, a1); v0 += a0; v1 += a1; }
                    *(u32x4*)(out + (size_t)row * ldc + col0 + bj * 128) = pk8(v0, v1); } }
    }
};
struct EpiSwiglu {
    h16* act;
    __device__ __forceinline__ void operator()(const Acc& acc, const Unit& u, int wr, int wc, int fr, int fq) const {
        asm volatile("" : "+v"(fr), "+v"(fq));
        EPI_ROWS(u, wr, fr); const int col0 = u.pn * 128 + wc * 32 + 8 * fq;
#pragma unroll
        for (int ai = 0; ai < 2; ++ai)
#pragma unroll
            for (int m = 0; m < 4; ++m) { const int row = row0 + ai * 128 + m * 16;
                f32x4 g0 = acc[ai][0][m][0], g1 = acc[ai][0][m][1]; const f32x4 u0 = acc[ai][1][m][0], u1 = acc[ai][1][m][1];
#pragma unroll
                for (int j = 0; j < 4; ++j) { g0[j] = g0[j] * sigmoidf_(g0[j]) * u0[j]; g1[j] = g1[j] * sigmoidf_(g1[j]) * u1[j]; }
                *(u32x4*)(act + (size_t)row * 512 + col0) = pk8(g0, g1); }
    }
};

struct UpOrder {
    const char* qa; const char* wq; const char* wkv; int G, c;
    __device__ __forceinline__ bool next(int i, Unit& u) const {
        const int L = i * G + c; if (L >= 896) return false;
        u.e = 0; u.slot0 = 0; u.cnt = 0;
        if (L < 384) { u.pm = L / 6; u.pn = L % 6; u.tag = 0; u.A = qa + (size_t)u.pm * 256 * 2048; u.B = wq + (size_t)u.pn * 256 * 1024; }
        else { const int l = L - 384; u.pm = l >> 3; u.pn = l & 7; u.tag = 1; u.A = qa + (size_t)u.pm * 256 * 2048 + 1024; u.B = wkv + (size_t)u.pn * 256 * 1024; }
        return true;
    }
    __device__ __forceinline__ unsigned voff(const Unit&, int, int) const { return 0u; }
};
__device__ __forceinline__ void moe_tables(const Frame& F, const unsigned* cnt) {
    LAS int* tstart = (LAS int*)(F.lds + LDS_TAB); LAS int* cnts = (LAS int*)(F.lds + LDS_TAB + 512); LAS int* tmap = (LAS int*)(F.lds + LDS_TAB + 1024);
    __syncthreads();
    if (F.tid < 65) cnts[F.tid] = F.tid < 64 ? (int)__hip_atomic_load(cnt + 64 * F.tid, __ATOMIC_RELAXED, __HIP_MEMORY_SCOPE_AGENT) : NTOK;
    __syncthreads();
    if (F.tid == 0) { int s = 0; for (int e = 0; e < 65; ++e) { tstart[e] = s; s += (cnts[e] + 255) >> 8; } tstart[65] = s; }
    __syncthreads();
    { int e = 0; for (int j = 1; j < 65; ++j) e += (tstart[j] <= F.tid) ? 1 : 0; tmap[F.tid] = (F.tid < tstart[65]) ? e : 255; }
    __syncthreads();
}
template <int NPN, bool GU> struct MoeOrder {
    const LAS int* tstart; const LAS int* cnts; const LAS int* tmap; const char* A; const char* W; const unsigned* list; int G, c;
    __device__ __forceinline__ bool next(int i, Unit& u) const {
        const int L = i * G + c; const int mt = L / NPN; const int T = __builtin_amdgcn_readfirstlane(tstart[65]);
        if (mt >= T) return false;
        const int e = __builtin_amdgcn_readfirstlane(tmap[mt]);
        u.pm = mt; u.pn = L % NPN; u.e = e; u.slot0 = (mt - __builtin_amdgcn_readfirstlane(tstart[e])) * 256; u.cnt = __builtin_amdgcn_readfirstlane(cnts[e]); u.tag = 0;
        if (GU) { u.A = A; u.B = W + (size_t)e * (1024 * 2048 * 2) + (size_t)u.pn * (256 * 2048 * 2); }
        else { u.A = A + (size_t)mt * (256 * 512 * 2); u.B = W + (size_t)e * (2048 * 512 * 2) + (size_t)u.pn * (256 * 512 * 2); }
        return true;
    }
    __device__ __forceinline__ unsigned voff(const Unit& u, int row, int col) const {
        const int slot = u.slot0 + row; unsigned tok;
        if (u.e == 64) tok = (unsigned)slot; else tok = slot < u.cnt ? list[(size_t)u.e * LISTCAP + slot] : 0u;
        return tok * 4096u + (unsigned)col * 2u;
    }
};

namespace att {
constexpr int KVBLK = 64, SHM_K = 16384, SHM_V = 16384, SHM_KR = 8192;
constexpr int OFF_V = 0, OFF_K = 2 * SHM_V, OFF_KR = OFF_K + 2 * SHM_K, OFF_WS = OFF_KR + 2 * SHM_KR, OFF_QR = OFF_WS + 2048;
constexpr float THR2 = 11.5f;
#define KSWZ(row, colB) ((row) * 256 + ((colB) ^ (((row) & 7) << 4)))
#define RSWZ(row, colB) ((row) * 128 + ((colB) ^ (((row) & 7) << 4)))
#define SBAR() __builtin_amdgcn_sched_barrier(0)
__device__ __forceinline__ int v_st(int k, int c) { const int kk = (k & ~0xC) | ((k & 4) << 1) | ((k & 8) >> 1); return ((kk >> 3) * 4 + (c >> 5)) * 512 + ((kk & 7) * 32 + (c & 31)) * 2; }
__device__ __forceinline__ int v_rd_base(int lane) { return ((lane & 3) << 3) | (((lane >> 2) & 3) << 6) | (((lane >> 4) & 1) << 5) | (((lane >> 5) & 1) << 8); }
constexpr int v_rd_off(int d0, int ks, int half) { return d0 * 512 + ks * 4096 + half * 2048; }
__device__ __forceinline__ int crow(int r, int hi) { return (r & 3) + 8 * (r >> 2) + 4 * hi; }
__device__ __forceinline__ void mask_tile(f32x16& p0, f32x16& p1, int dq, unsigned W) {
    const float NEG = -__builtin_inff();
#pragma unroll
    for (int r = 0; r < 16; ++r) {
        const int c = (r & 3) + 8 * (r >> 2);
        if ((unsigned)(dq - c) >= W) p0[r] = NEG;
        if ((unsigned)(dq - c - 32) >= W) p1[r] = NEG;
    }
}
__device__ __forceinline__ void softmax_tile(f32x16& p0, f32x16& p1, float& m_reg, float& l_reg, float& alpha, h16x8& pa0, h16x8& pa1, h16x8& pa2, h16x8& pa3) {
    float pmax = p0[0];
#pragma unroll
    for (int r = 1; r < 16; ++r) pmax = fmaxf(pmax, p0[r]);
#pragma unroll
    for (int r = 0; r < 16; ++r) pmax = fmaxf(pmax, p1[r]);
    { auto rr = __builtin_amdgcn_permlane32_swap(__float_as_uint(pmax), __float_as_uint(pmax), false, false);
      pmax = fmaxf(__uint_as_float(rr[0]), __uint_as_float(rr[1])); }
    float mn;
    if (__all((pmax - m_reg) <= THR2)) { mn = m_reg; alpha = 1.f; }
    else { mn = fmaxf(m_reg, pmax); alpha = __builtin_amdgcn_exp2f(m_reg - mn); m_reg = mn; }
#pragma unroll
    for (int r = 0; r < 16; ++r) { p0[r] = __builtin_amdgcn_exp2f(p0[r] - mn); p1[r] = __builtin_amdgcn_exp2f(p1[r] - mn); }
    float ps = 0;
#pragma unroll
    for (int r = 0; r < 16; ++r) ps += p0[r];
#pragma unroll
    for (int r = 0; r < 16; ++r) ps += p1[r];
    { auto rr = __builtin_amdgcn_permlane32_swap(__float_as_uint(ps), __float_as_uint(ps), false, false);
      ps = __uint_as_float(rr[0]) + __uint_as_float(rr[1]); }
    l_reg = l_reg * alpha + ps;
#define PK4(P, B_, OUT) do { unsigned a0 = pkh(P[B_+0], P[B_+1]), a1 = pkh(P[B_+2], P[B_+3]);                          \
        unsigned b0 = pkh(P[B_+4], P[B_+5]), b1 = pkh(P[B_+6], P[B_+7]);                                             \
        auto r0 = __builtin_amdgcn_permlane32_swap(a0, b0, false, false); auto r1 = __builtin_amdgcn_permlane32_swap(a1, b1, false, false); \
        u32x4 w = {r0[0], r1[0], r0[1], r1[1]}; OUT = __builtin_bit_cast(h16x8, w); } while (0)
    PK4(p0, 0, pa0); PK4(p0, 8, pa1); PK4(p1, 0, pa2); PK4(p1, 8, pa3);
#undef PK4
}
struct AUnit {
    const char* Q; const char* QR;
    const char* K; const char* V;
    const char* KR;
    char* O;
    float* LSE;
    unsigned qs, kvs, krs, os, ls;
    int P0, jlo, jhi; unsigned W;
};
template <bool MLA>
__device__ __forceinline__ void attn_unit(LAS unsigned char* lds, const AUnit& u) {
    const int tid = threadIdx.x, wid = __builtin_amdgcn_readfirstlane(tid >> 6), lane = tid & 63, r32 = lane & 31, hi = lane >> 5;
    LAS unsigned char* V_lds = lds + OFF_V; LAS unsigned char* K_lds = lds + OFF_K; LAS unsigned char* R_lds = lds + OFF_KR;
    LAS float* wsf = (LAS float*)(lds + OFF_WS) + wid * 64;
    LAS unsigned char* QRl = lds + OFF_QR + wid * 4096 + lane * 16;
    const int qlo = u.P0 + wid * 32, qm = qlo + r32 - 4 * hi;
    unsigned ko[2], vo[2], kro = 0u;
#pragma unroll
    for (int i = 0; i < 2; ++i) { const int p = (wid * 2 + i) * 64 + lane;
        { const int row = p >> 4, pc = p & 15; ko[i] = (unsigned)row * u.kvs + (unsigned)((pc ^ (row & 7)) << 4); }
        { const int cc = (p & 3) | (((p >> 5) & 3) << 2), kk = ((p >> 2) & 7) | ((p >> 7) << 3), k = (kk & ~0xC) | ((kk & 4) << 1) | ((kk & 8) >> 1);
          vo[i] = (unsigned)k * u.kvs + (unsigned)cc * 16u; } }
    if constexpr (MLA) { const int p = wid * 64 + lane, row = p >> 3, pc = p & 7; kro = (unsigned)row * u.krs + (unsigned)((pc ^ (row & 7)) << 4); }
#define ST_ISSUE(t, bf) do { const size_t tb_ = (size_t)(t) * KVBLK * u.kvs; const char* Kt_ = u.K + tb_; const char* Vt_ = u.V + tb_; \
        _Pragma("unroll") for (int i_ = 0; i_ < 2; ++i_) { \
            __builtin_amdgcn_global_load_lds((const unsigned*)(Kt_ + ko[i_]), (LAS unsigned*)(K_lds + (bf) * SHM_K + (wid * 2 + i_) * 1024), 16, 0, 0); \
            __builtin_amdgcn_global_load_lds((const unsigned*)(Vt_ + vo[i_]), (LAS unsigned*)(V_lds + (bf) * SHM_V + (wid * 2 + i_) * 1024), 16, 0, 0); } \
        if constexpr (MLA) __builtin_amdgcn_global_load_lds((const unsigned*)(u.KR + (size_t)(t) * KVBLK * u.krs + kro), (LAS unsigned*)(R_lds + (bf) * SHM_KR + wid * 1024), 16, 0, 0); } while (0)
    __syncthreads();
    ST_ISSUE(u.jlo, 0);
    h16x8 qr[8];
    { const unsigned qo = (unsigned)(wid * 32 + r32) * u.qs + (unsigned)hi * 16u;
#pragma unroll
      for (int d0 = 0; d0 < 8; ++d0) qr[d0] = *(const h16x8*)(u.Q + d0 * 32 + qo);
      if constexpr (MLA) {
#pragma unroll
        for (int d0 = 0; d0 < 4; ++d0) *(LAS h16x8*)(QRl + d0 * 1024) = *(const h16x8*)(u.QR + d0 * 32 + qo); } }
    float m_reg = -1e30f, l_reg = 0.f; f32x16 o[4];
#pragma unroll
    for (int d = 0; d < 4; ++d)
#pragma unroll
        for (int r = 0; r < 16; ++r) o[d][r] = 0.f;
    const int vb0 = (int)(uintptr_t)V_lds + v_rd_base(lane);
    for (int t = u.jlo; t < u.jhi; ++t) {
        const int bf = (t - u.jlo) & 1;
        asm volatile("s_waitcnt vmcnt(0)" ::: "memory");
        __syncthreads();
        if (t + 1 < u.jhi) ST_ISSUE(t + 1, bf ^ 1);
        const int kb = t * KVBLK;
        const bool act = (kb <= qlo + 31) && ((long)kb + KVBLK - 1 >= (long)qlo - (long)(u.W - 1));
        if (act) {
            f32x16 p0, p1;
#pragma unroll
            for (int r = 0; r < 16; ++r) { p0[r] = 0.f; p1[r] = 0.f; }
            {   const LAS unsigned char* kbp[4];
#pragma unroll
                for (int dd = 0; dd < 4; ++dd) kbp[dd] = K_lds + bf * SHM_K + KSWZ(r32, (dd * 16 + hi * 8) * 2);
#pragma unroll
                for (int d0 = 0; d0 < 8; ++d0) { const LAS unsigned char* a = kbp[d0 & 3] + (d0 >> 2) * 128;
                    const h16x8 b0 = *(const LAS h16x8*)a, b1 = *(const LAS h16x8*)(a + 32 * 256);
                    p0 = __builtin_amdgcn_mfma_f32_32x32x16_f16(b0, qr[d0], p0, 0, 0, 0);
                    p1 = __builtin_amdgcn_mfma_f32_32x32x16_f16(b1, qr[d0], p1, 0, 0, 0); }
                if constexpr (MLA) {
#pragma unroll
                    for (int d0 = 0; d0 < 4; ++d0) { const LAS unsigned char* a = R_lds + bf * SHM_KR + RSWZ(r32, (d0 * 16 + hi * 8) * 2);
                        const h16x8 b0 = *(const LAS h16x8*)a, b1 = *(const LAS h16x8*)(a + 32 * 128); const h16x8 qf = *(const LAS h16x8*)(QRl + d0 * 1024);
                        p0 = __builtin_amdgcn_mfma_f32_32x32x16_f16(b0, qf, p0, 0, 0, 0);
                        p1 = __builtin_amdgcn_mfma_f32_32x32x16_f16(b1, qf, p1, 0, 0, 0); }
                }
            }
            if (kb + KVBLK - 1 > qlo || (long)kb <= (long)qlo + 31 - (long)u.W) mask_tile(p0, p1, qm - kb, u.W);
            float alpha; h16x8 pa0, pa1, pa2, pa3;
            softmax_tile(p0, p1, m_reg, l_reg, alpha, pa0, pa1, pa2, pa3);
            if (__any(alpha < 1.f)) {
                if (hi == 0) wsf[r32] = alpha;
                LDS_WAIT();
#pragma unroll
                for (int r = 0; r < 16; ++r) { const float a_ = wsf[crow(r, hi)];
#pragma unroll
                    for (int d = 0; d < 4; ++d) o[d][r] *= a_; }
            }
#define TRRD(dst, off) asm volatile("ds_read_b64_tr_b16 %0, %1 offset:%2" : "=&v"(dst) : "v"(vb0), "i"(off) : "memory")
#define PV_D0(VB, d0) do { s16x4 l0, l1, l2, l3, h0, h1, h2, h3; constexpr int b_ = (VB) * SHM_V + v_rd_off(d0, 0, 0); \
        TRRD(l0, b_); TRRD(h0, b_ + 2048); TRRD(l1, b_ + 4096); TRRD(h1, b_ + 6144); TRRD(l2, b_ + 8192); TRRD(h2, b_ + 10240); TRRD(l3, b_ + 12288); TRRD(h3, b_ + 14336); \
        asm volatile("s_waitcnt lgkmcnt(0)" ::: "memory"); SBAR(); \
        o[d0] = __builtin_amdgcn_mfma_f32_32x32x16_f16(pa0, __builtin_bit_cast(h16x8, (short __attribute__((ext_vector_type(8)))){l0[0], l0[1], l0[2], l0[3], h0[0], h0[1], h0[2], h0[3]}), o[d0], 0, 0, 0); \
        o[d0] = __builtin_amdgcn_mfma_f32_32x32x16_f16(pa1, __builtin_bit_cast(h16x8, (short __attribute__((ext_vector_type(8)))){l1[0], l1[1], l1[2], l1[3], h1[0], h1[1], h1[2], h1[3]}), o[d0], 0, 0, 0); \
        o[d0] = __builtin_amdgcn_mfma_f32_32x32x16_f16(pa2, __builtin_bit_cast(h16x8, (short __attribute__((ext_vector_type(8)))){l2[0], l2[1], l2[2], l2[3], h2[0], h2[1], h2[2], h2[3]}), o[d0], 0, 0, 0); \
        o[d0] = __builtin_amdgcn_mfma_f32_32x32x16_f16(pa3, __builtin_bit_cast(h16x8, (short __attribute__((ext_vector_type(8)))){l3[0], l3[1], l3[2], l3[3], h3[0], h3[1], h3[2], h3[3]}), o[d0], 0, 0, 0); } while (0)
            if (bf == 0) { PV_D0(0, 0); PV_D0(0, 1); PV_D0(0, 2); PV_D0(0, 3); }
            else { PV_D0(1, 0); PV_D0(1, 1); PV_D0(1, 2); PV_D0(1, 3); }
#undef PV_D0
#undef TRRD
        }
    }
#undef ST_ISSUE
    if (hi == 0) wsf[32 + r32] = l_reg;
    LDS_WAIT();
    if (u.LSE && hi == 0) u.LSE[(unsigned)(wid * 32 + r32) * u.ls] = m_reg + __builtin_amdgcn_logf(l_reg);
    char* Ow = u.O + (size_t)(wid * 32) * u.os;
    unsigned loff = (unsigned)(4 * hi) * u.os + (unsigned)r32 * 2u;
    asm volatile("" : "+v"(loff));
#pragma unroll
    for (int r = 0; r < 16; ++r) { const int orow = crow(r, hi); const float rl = __builtin_amdgcn_rcpf(wsf[32 + orow]);
        char* rowp = Ow + (size_t)((r & 3) + 8 * (r >> 2)) * u.os;
#pragma unroll
        for (int d0 = 0; d0 < 4; ++d0) { const float v = o[d0][r] * rl; const float vn_ = __shfl_xor(v, 1);
            if ((r32 & 1) == 0) *(unsigned*)(rowp + d0 * 64 + loff) = pkh(v, vn_); } }
}
}

template <class RowOf>
__device__ __forceinline__ void cvt_item(const float* W, int K, int N, h16* WT, LAS float* scr, int item, int lane, const float* kscale, RowOf row_of) {
    const int nblk = N >> 6, kb = item / nblk, nb = item - kb * nblk, k0 = kb * 64, n0 = nb * 64;
    f32x4 v[16];
#pragma unroll
    for (int i = 0; i < 16; ++i) { const int kk = 4 * i + (lane >> 4); v[i] = *(const GAS f32x4*)(W + (size_t)(k0 + kk) * N + n0 + (lane & 15) * 4); }
#pragma unroll
    for (int i = 0; i < 16; ++i) { const int kk = 4 * i + (lane >> 4); f32x4 t = v[i]; if (kscale) t *= kscale[k0 + kk];
        LAS float* s = scr + kk * 65 + (lane & 15) * 4; s[0] = t[0]; s[1] = t[1]; s[2] = t[2]; s[3] = t[3]; }
    LDS_WAIT(); asm volatile("" ::: "memory");
    const int c = lane & 7;
#pragma unroll
    for (int j = 0; j < 8; ++j) { const int n = (lane >> 3) + 8 * j; const LAS float* s = scr + (8 * c) * 65 + n;
        u32x4 o; o.x = pkh(s[0 * 65], s[1 * 65]); o.y = pkh(s[2 * 65], s[3 * 65]); o.z = pkh(s[4 * 65], s[5 * 65]); o.w = pkh(s[6 * 65], s[7 * 65]);
        *(GAS u32x4*)(WT + (size_t)row_of(n0 + n) * K + k0 + 8 * c) = o; }
    LDS_WAIT(); asm volatile("" ::: "memory");
}
__device__ __forceinline__ int rope_perm(int i, int half) { return i < half ? 2 * i : 2 * (i - half) + 1; }
__device__ __forceinline__ int row_in(int c) {
    if (c < 1024) return c;
    if (c < 1088) return 1024 + rope_perm(c - 1024, 32);
    if (c < 5696) { const int dc = c - 1088, part = dc / 1536, dim = dc & 127;
        return 1280 + ((part < 2 && dim < 32) ? (dc - dim + rope_perm(dim, 16)) : dc); }
    return 5888 + (c - 5696);
}
__device__ __forceinline__ int row_qup(int c) { const int h = c / 192, j = c - h * 192; return j < 128 ? h * 128 + j : 1024 + h * 64 + rope_perm(j - 128, 32); }
__device__ __forceinline__ int row_gu(int n, int up) { return (n >> 7) * 256 + up * 128 + (n & 127); }
__device__ __forceinline__ void sincos_d(float angf, float& s, float& c) {
    const double a = (double)angf; const double k = __builtin_rint(a * 0.63661977236758134308);
    const double r = (a - k * 1.57079632679489655800) - k * 6.12323399573676603587e-17; const double r2 = r * r;
    double sp = -7.6471637318198164759e-13; sp = sp * r2 + 1.6059043836821614599e-10; sp = sp * r2 - 2.5052108385441718775e-08; sp = sp * r2 + 2.7557319223985890653e-06;
    sp = sp * r2 - 1.9841269841269841270e-04; sp = sp * r2 + 8.3333333333333333333e-03; sp = sp * r2 - 1.6666666666666666667e-01; const double sn = r + r * r2 * sp;
    double cp = 4.7794773323873852974e-14; cp = cp * r2 - 1.1470745597729724714e-11; cp = cp * r2 + 2.0876756987868098979e-09; cp = cp * r2 - 2.7557319223985890653e-07;
    cp = cp * r2 + 2.4801587301587301587e-05; cp = cp * r2 - 1.3888888888888888889e-03; cp = cp * r2 + 4.1666666666666666667e-02; cp = cp * r2 - 0.5; const double cn = 1.0 + r2 * cp;
    const int q = ((int)k) & 3;
    const double ss = (q == 0) ? sn : (q == 1) ? cn : (q == 2) ? -sn : -cn;
    const double cc = (q == 0) ? cn : (q == 1) ? -sn : (q == 2) ? -cn : sn;
    s = (float)ss; c = (float)cc;
}
__device__ __forceinline__ void p0_prologue(const Frame& F, const Args& a) {
    {
        LAS float* sc = (LAS float*)F.lds; LAS float* part = (LAS float*)(F.lds + 32768);
        float* mod = wsp<float>(F, WS_MOD);
        for (int i = F.tid; i < 4 * DM; i += NTHR) { const float v = a.c[i]; sc[i] = v / (1.0f + __expf(-v)); }
        __syncthreads();
        for (int un = F.vcu; un < 384; un += F.G) {
            const int j0 = un * 32, col4 = F.tid & 7, kg = F.tid >> 3;
            f32x4 ac[4];
#pragma unroll
            for (int b = 0; b < 4; ++b) ac[b] = (f32x4){0.f, 0.f, 0.f, 0.f};
#pragma unroll 8
            for (int i = 0; i < 32; ++i) { const int k = kg + 64 * i; const f32x4 w = *(const GAS f32x4*)(a.w_ada + (size_t)k * 12288 + j0 + col4 * 4);
#pragma unroll
                for (int b = 0; b < 4; ++b) ac[b] += w * sc[b * DM + k]; }
#pragma unroll
            for (int b = 0; b < 4; ++b) *(LAS f32x4*)(part + (kg * 4 + b) * 32 + col4 * 4) = ac[b];
            __syncthreads();
            if (F.tid < 128) { const int b = F.tid >> 5, col = F.tid & 31; float s = 0.f;
                for (int g = 0; g < 64; ++g) s += part[(g * 4 + b) * 32 + col];
                mod[b * 12288 + j0 + col] = s + a.b_ada[j0 + col]; }
            __syncthreads();
        }
    }
    const int gw = F.vcu * NWAVES + F.wave, NGW = F.G * NWAVES, gt = F.vcu * NTHR + F.tid, NGT = F.G * NTHR;
    {
        float* cosd = wsp<float>(F, WS_COSD); float* sind = wsp<float>(F, WS_SIND); float* cosm = wsp<float>(F, WS_COSM); float* sinm = wsp<float>(F, WS_SINM);
        for (int i = gt; i < NTOK * 48; i += NGT) { const int t = i / 48, j = i - t * 48; const float p = (float)a.pos[t];
            float s, c;
            if (j < 16) { sincos_d(p * a.invf_d[j], s, c); cosd[t * 16 + j] = c; sind[t * 16 + j] = s; }
            else { sincos_d(p * a.invf_m[j - 16], s, c); cosm[t * 32 + j - 16] = c; sinm[t * 32 + j - 16] = s; } }
    }
    { u32x4* z = (u32x4*)(wsp<h16>(F, W_IN) + (size_t)1088 * DM); for (int i = gt; i < 192 * DM / 8; i += NGT) z[i] = (u32x4){0u, 0u, 0u, 0u}; }
    {
        __syncthreads();
        LAS float* scr = (LAS float*)(F.lds + F.wave * 16640);
        constexpr int I_IN = 32 * 153, I_QUP = 8 * 24, I_KVUP = 8 * 32, I_MO = 16 * 32, I_DO = 8 * 32, I_OUT = 32 * 32, I_R = 32, I_SH = 256, I_EX = 256;
        constexpr int NSMALL = I_IN + I_QUP + I_KVUP + I_MO + I_DO + I_OUT + I_R + 3 * I_SH;
        constexpr int NITEMS = NSMALL + 3 * 64 * I_EX;
        for (int it = gw; it < NITEMS; it += NGW) {
            int r = it;
            if (r < I_IN) { cvt_item(a.w_in, DM, 9792, wsp<h16>(F, W_IN), scr, r, F.lane, nullptr, [](int n) { return row_in(n); }); continue; } r -= I_IN;
            if (r < I_QUP) { cvt_item(a.w_q_up, 512, 1536, wsp<h16>(F, W_QUP), scr, r, F.lane, a.q_a_norm_g, [](int n) { return row_qup(n); }); continue; } r -= I_QUP;
            if (r < I_KVUP) { cvt_item(a.w_kv_up, 512, 2048, wsp<h16>(F, W_KVUP), scr, r, F.lane, a.kv_a_norm_g, [](int n) { return n; }); continue; } r -= I_KVUP;
            if (r < I_MO) { cvt_item(a.w_mla_o, 1024, 2048, wsp<h16>(F, W_MO), scr, r, F.lane, nullptr, [](int n) { return n; }); continue; } r -= I_MO;
            if (r < I_DO) { cvt_item(a.w_dil_o, 512, 2048, wsp<h16>(F, W_DO), scr, r, F.lane, nullptr, [](int n) { return n; }); continue; } r -= I_DO;
            if (r < I_OUT) { cvt_item(a.w_out, DM, DM, wsp<h16>(F, W_OUT), scr, r, F.lane, nullptr, [](int n) { return n; }); continue; } r -= I_OUT;
            if (r < I_R) { cvt_item(a.w_router, DM, 64, wsp<h16>(F, W_R), scr, r, F.lane, nullptr, [](int n) { return n; }); continue; } r -= I_R;
            if (r < I_SH) { cvt_item(a.w_sh_gate, DM, 512, wsp<h16>(F, W_GU) + (size_t)64 * 1024 * 2048, scr, r, F.lane, nullptr, [](int n) { return row_gu(n, 0); }); continue; } r -= I_SH;
            if (r < I_SH) { cvt_item(a.w_sh_up, DM, 512, wsp<h16>(F, W_GU) + (size_t)64 * 1024 * 2048, scr, r, F.lane, nullptr, [](int n) { return row_gu(n, 1); }); continue; } r -= I_SH;
            if (r < I_SH) { cvt_item(a.w_sh_down, 512, DM, wsp<h16>(F, W_DN) + (size_t)64 * 2048 * 512, scr, r, F.lane, nullptr, [](int n) { return n; }); continue; } r -= I_SH;
            const int mat = r / (64 * I_EX), rr = r - mat * (64 * I_EX), e = rr / I_EX, ii = rr - e * I_EX;
            if (mat == 0) cvt_item(a.w_exp_gate + (size_t)e * DM * 512, DM, 512, wsp<h16>(F, W_GU) + (size_t)e * 1024 * 2048, scr, ii, F.lane, nullptr, [](int n) { return row_gu(n, 0); });
            else if (mat == 1) cvt_item(a.w_exp_up + (size_t)e * DM * 512, DM, 512, wsp<h16>(F, W_GU) + (size_t)e * 1024 * 2048, scr, ii, F.lane, nullptr, [](int n) { return row_gu(n, 1); });
            else cvt_item(a.w_exp_down + (size_t)e * 512 * DM, 512, DM, wsp<h16>(F, W_DN) + (size_t)e * 2048 * 512, scr, ii, F.lane, nullptr, [](int n) { return n; });
        }
        __syncthreads();
    }
}

__device__ __forceinline__ void p1_h1(const Frame& F, const Args& a) {
    const int gw = F.vcu * NWAVES + F.wave, NGW = F.G * NWAVES;
    const float* mod = wsp<float>(F, WS_MOD); h16* h1 = wsp<h16>(F, A_H1);
    for (int t = gw; t < NTOK; t += NGW) {
        const int b = t >> 12; const GAS f32x4* xr = (const GAS f32x4*)(a.x + (size_t)t * DM) + F.lane;
        f32x4 v[8]; float ss = 0.f;
#pragma unroll
        for (int j = 0; j < 8; ++j) { v[j] = xr[64 * j]; ss += (v[j][0] * v[j][0] + v[j][1] * v[j][1]) + (v[j][2] * v[j][2] + v[j][3] * v[j][3]); }
        const float rstd = 1.0f / sqrtf(wave_sum(ss) * (1.0f / DM) + EPS);
#pragma unroll
        for (int j = 0; j < 8; ++j) { const int c = 4 * F.lane + 256 * j;
            const f32x4 g = *(const f32x4*)(a.attn_pre_g + c), sc = *(const f32x4*)(mod + b * 12288 + 2048 + c), sh = *(const f32x4*)(mod + b * 12288 + c);
            const f32x4 h = v[j] * rstd * g * (sc + 1.0f) + sh;
            u32x2 w; w.x = pkh(h[0], h[1]); w.y = pkh(h[2], h[3]);
            *(GAS u32x2*)(h1 + (size_t)t * DM + c) = w; }
    }
}

__device__ __forceinline__ void p4_attention(const Frame& F) {
    const char* qm = (const char*)wsp<h16>(F, A_QM); const char* kv = (const char*)wsp<h16>(F, A_KV); const char* kr = (const char*)wsp<h16>(F, A_KR);
    const char* dil = (const char*)wsp<h16>(F, A_DIL); char* omla = (char*)wsp<h16>(F, A_OMLA); char* od = (char*)wsp<h16>(F, A_OD); float* lse = wsp<float>(F, WS_LSE);
    for (int it = F.vcu; it < 256; it += F.G) {
        const int bh = it >> 3, x = it & 7, b = bh >> 3, h = bh & 7;
#pragma unroll 1
        for (int half = 0; half < 2; ++half) {
            const int qb = half ? 15 - x : x; const size_t tok0 = (size_t)b * SEQ;
            att::AUnit u;
            u.Q = qm + (tok0 + qb * 256) * 3072 + h * 256; u.qs = 3072; u.QR = qm + (tok0 + qb * 256) * 3072 + 2048 + h * 128;
            u.K = kv + tok0 * 4096 + h * 512; u.kvs = 4096; u.V = u.K + 256; u.KR = kr + tok0 * 128; u.krs = 128;
            u.O = omla + (tok0 + qb * 256) * 2048 + h * 256; u.os = 2048; u.LSE = nullptr; u.ls = 0;
            u.P0 = qb * 256; u.jlo = 0; u.jhi = qb * 4 + 4; u.W = 0x40000000u;
            att::attn_unit<true>(F.lds, u);
        }
    }
    for (int un = F.vcu; un < 768; un += F.G) {
        const int b = un / 192, rem = un - b * 192, head = rem >> 4, sub = rem & 15, g = head >> 2;
        const int d = (g == 0) ? 1 : (g == 1) ? 4 : 16; const int r = sub % d, jb = sub / d;
        const size_t tok0 = (size_t)b * SEQ + r; const unsigned rs = (unsigned)d * 9216u;
        att::AUnit u;
        u.Q = dil + (tok0 + (size_t)d * 256 * jb) * 9216 + head * 256; u.qs = rs; u.QR = nullptr;
        u.K = dil + tok0 * 9216 + 3072 + head * 256; u.kvs = rs; u.V = dil + tok0 * 9216 + 6144 + head * 256; u.KR = nullptr; u.krs = 0;
        u.O = od + (tok0 + (size_t)d * 256 * jb) * 3072 + head * 256; u.os = (unsigned)d * 3072u;
        u.LSE = lse + (tok0 + (size_t)d * 256 * jb) * 12 + head; u.ls = (unsigned)d * 12u;
        u.P0 = jb * 256; u.jlo = jb == 0 ? 0 : jb * 4 - 2; u.jhi = jb * 4 + 4; u.W = 129u;
        att::attn_unit<false>(F.lds, u);
    }
    __syncthreads();
}
__device__ __forceinline__ void p5_combine(const Frame& F) {
    const int gw = F.vcu * NWAVES + F.wave, NGW = F.G * NWAVES;
    const h16* od = wsp<h16>(F, A_OD); const float* lse = wsp<float>(F, WS_LSE); h16* odil = wsp<h16>(F, A_ODIL);
    for (int t = gw; t < NTOK; t += NGW) {
        const int hs = F.lane >> 4, dc = (F.lane & 15) * 8;
        const float l0 = lse[(size_t)t * 12 + hs], l1 = lse[(size_t)t * 12 + 4 + hs], l2 = lse[(size_t)t * 12 + 8 + hs];
        const float mx = fmaxf(l0, fmaxf(l1, l2));
        float w0 = __builtin_amdgcn_exp2f(l0 - mx), w1 = __builtin_amdgcn_exp2f(l1 - mx), w2 = __builtin_amdgcn_exp2f(l2 - mx);
        const float inv = 1.0f / (w0 + w1 + w2); w0 *= inv; w1 *= inv; w2 *= inv;
        f32x4 a0, a1, b0, b1, c0, c1;
        unpk8(*(const GAS u32x4*)(od + (size_t)t * 1536 + hs * 128 + dc), a0, a1);
        unpk8(*(const GAS u32x4*)(od + (size_t)t * 1536 + 512 + hs * 128 + dc), b0, b1);
        unpk8(*(const GAS u32x4*)(od + (size_t)t * 1536 + 1024 + hs * 128 + dc), c0, c1);
        const f32x4 r0 = a0 * w0 + b0 * w1 + c0 * w2, r1 = a1 * w0 + b1 * w1 + c1 * w2;
        *(GAS u32x4*)(odil + (size_t)t * 512 + hs * 128 + dc) = pk8(r0, r1);
    }
}

__device__ __forceinline__ void p8_router(const Frame& F, const Args& a) {
    constexpr int HP = 4128;
    LAS unsigned char* h2l = F.lds; LAS float* lg = (LAS float*)(F.lds + 32 * HP);
    LAS unsigned* lcnt = (LAS unsigned*)(F.lds + 32 * HP + 8192); LAS unsigned* lbase = lcnt + 64; LAS unsigned* rec = lbase + 64; LAS float* recw = (LAS float*)(rec + 192);
    if (F.tid < 64) lcnt[F.tid] = 0u;
    const float* mod = wsp<float>(F, WS_MOD); const h16* yat = wsp<h16>(F, A_YAT); h16* h2 = wsp<h16>(F, A_H2); const h16* wr_t = wsp<h16>(F, W_R);
    unsigned* cnt = wsp<unsigned>(F, WS_CTL) + CW_CNT; unsigned* list = wsp<unsigned>(F, WS_LIST); unsigned* tokpos = wsp<unsigned>(F, WS_TOKPOS); float* tokw = wsp<float>(F, WS_TOKW);
    const int fr = F.lane & 15, fq = F.lane >> 4;
    for (int tb = F.vcu; tb < NTOK / 32; tb += F.G) {
        __syncthreads();
#pragma unroll 1
        for (int q = 0; q < 4; ++q) {
            const int tl = F.wave * 4 + q, t = tb * 32 + tl, b = t >> 12;
            f32x4 y[8]; float ss = 0.f;
#pragma unroll
            for (int j = 0; j < 8; ++j) { const h16x4 hv = *(const GAS h16x4*)(yat + (size_t)t * DM + 4 * F.lane + 256 * j);
                y[j] = (f32x4){(float)hv[0], (float)hv[1], (float)hv[2], (float)hv[3]}; ss += (y[j][0] * y[j][0] + y[j][1] * y[j][1]) + (y[j][2] * y[j][2] + y[j][3] * y[j][3]); }
            const float rstd1 = 1.0f / sqrtf(wave_sum(ss) * (1.0f / DM) + EPS);
            float ss2 = 0.f;
#pragma unroll
            for (int j = 0; j < 8; ++j) { const int c = 4 * F.lane + 256 * j;
                const f32x4 xv = *(const GAS f32x4*)(a.x + (size_t)t * DM + c), g = *(const f32x4*)(a.attn_post_g + c), ga = *(const f32x4*)(mod + b * 12288 + 2 * 2048 + c);
                const f32x4 xm = xv + ga * (y[j] * rstd1 * g);
                *(GAS f32x4*)(a.out + (size_t)t * DM + c) = xm; y[j] = xm;
                ss2 += (xm[0] * xm[0] + xm[1] * xm[1]) + (xm[2] * xm[2] + xm[3] * xm[3]); }
            const float rstd2 = 1.0f / sqrtf(wave_sum(ss2) * (1.0f / DM) + EPS);
#pragma unroll
            for (int j = 0; j < 8; ++j) { const int c = 4 * F.lane + 256 * j;
                const f32x4 g = *(const f32x4*)(a.ffn_pre_g + c), sc = *(const f32x4*)(mod + b * 12288 + 4 * 2048 + c), sh = *(const f32x4*)(mod + b * 12288 + 3 * 2048 + c);
                const f32x4 h = y[j] * rstd2 * g * (sc + 1.0f) + sh;
                u32x2 w; w.x = pkh(h[0], h[1]); w.y = pkh(h[2], h[3]);
                *(GAS u32x2*)(h2 + (size_t)t * DM + c) = w;
                *(LAS u32x2*)(h2l + tl * HP + c * 2) = w; }
        }
        __syncthreads();
        {
            const int rt = F.wave >> 2, et = F.wave & 3; f32x4 acc = (f32x4){0.f, 0.f, 0.f, 0.f};
            const LAS unsigned char* ap = h2l + (rt * 16 + fr) * HP + fq * 16; const h16* bp = wr_t + (size_t)(et * 16 + fr) * DM + fq * 8;
#pragma unroll 8
            for (int kk = 0; kk < 64; ++kk) { const h16x8 av = *(const LAS h16x8*)(ap + kk * 64); const h16x8 bv = *(const GAS h16x8*)(bp + kk * 32);
                acc = __builtin_amdgcn_mfma_f32_16x16x32_f16(av, bv, acc, 0, 0, 0); }
#pragma unroll
            for (int j = 0; j < 4; ++j) lg[(rt * 16 + 4 * fq + j) * 64 + et * 16 + fr] = acc[j];
        }
        __syncthreads();
#pragma unroll 1
        for (int q = 0; q < 4; ++q) {
            const int tl = F.wave * 4 + q, e = F.lane;
            const float score = 1.0f / (1.0f + expf(-lg[tl * 64 + e])); const float biased = score + a.router_bias[e];
            float m1 = biased;
            m1 = fmaxf(m1, __shfl_xor(m1, 1)); m1 = fmaxf(m1, __shfl_xor(m1, 2)); m1 = fmaxf(m1, __shfl_xor(m1, 4));
            const unsigned long long bal = __ballot(biased == m1); const unsigned gb = (unsigned)(bal >> (e & 56)) & 0xFFu; const int first = __builtin_ctz(gb);
            float v2 = ((e & 7) == first) ? -__builtin_inff() : biased;
            v2 = fmaxf(v2, __shfl_xor(v2, 1)); v2 = fmaxf(v2, __shfl_xor(v2, 2)); v2 = fmaxf(v2, __shfl_xor(v2, 4));
            const float gs = m1 + v2; const int g = e >> 3; int grank = 0;
#pragma unroll
            for (int g2 = 0; g2 < 8; ++g2) { const float s2 = __shfl(gs, g2 * 8); grank += (s2 > gs || (s2 == gs && g2 < g)) ? 1 : 0; }
            const float sel = grank < 4 ? biased : -__builtin_inff(); int rank = 0;
#pragma unroll 16
            for (int e2 = 0; e2 < 64; ++e2) { const float s2 = __shfl(sel, e2); rank += (s2 > sel || (s2 == sel && e2 < e)) ? 1 : 0; }
            const bool chosen = rank < TOPK;
            const float wsum = wave_sum(chosen ? score : 0.f);
            if (chosen) { const float w = score / (wsum + 1e-20f) * 2.5f;
                const unsigned sl = __hip_atomic_fetch_add(lcnt + e, 1u, __ATOMIC_RELAXED, __HIP_MEMORY_SCOPE_WORKGROUP);
                rec[tl * 6 + rank] = ((unsigned)e << 20) | sl; recw[tl * 6 + rank] = w; }
        }
        __syncthreads();
        if (F.tid < 64) { const unsigned n = lcnt[F.tid]; lbase[F.tid] = n ? __hip_atomic_fetch_add(cnt + 64 * F.tid, n, __ATOMIC_RELAXED, __HIP_MEMORY_SCOPE_AGENT) : 0u; lcnt[F.tid] = 0u; }
        __syncthreads();
        if (F.tid < 192) { const int tl = F.tid / 6, r = F.tid - tl * 6, t = tb * 32 + tl; const unsigned rc = rec[F.tid]; const unsigned e = rc >> 20, slot = lbase[e] + (rc & 0xFFFFFu);
            list[(size_t)e * LISTCAP + slot] = (unsigned)t; tokpos[(size_t)t * 6 + r] = (e << 20) | slot; tokw[(size_t)t * 6 + r] = recw[F.tid]; }
    }
}

__device__ __forceinline__ void p11_final(const Frame& F, const Args& a) {
    const int gw = F.vcu * NWAVES + F.wave, NGW = F.G * NWAVES;
    const LAS int* tstart = (const LAS int*)(F.lds + LDS_TAB);
    const float* mod = wsp<float>(F, WS_MOD); const h16* ys = wsp<h16>(F, A_YS); const unsigned* tokpos = wsp<unsigned>(F, WS_TOKPOS); const float* tokw = wsp<float>(F, WS_TOKW);
    for (int t = gw; t < NTOK; t += NGW) {
        const int b = t >> 12;
        unsigned prow = 0; float w = 0.f;
        if (F.lane < 6) { const unsigned p = tokpos[(size_t)t * 6 + F.lane]; prow = (unsigned)tstart[p >> 20] * 256u + (p & 0xFFFFFu); w = tokw[(size_t)t * 6 + F.lane]; }
        if (F.lane == 6) { prow = (unsigned)tstart[64] * 256u + (unsigned)t; w = 1.0f; }
        f32x4 acc[8];
#pragma unroll
        for (int j = 0; j < 8; ++j) acc[j] = (f32x4){0.f, 0.f, 0.f, 0.f};
#pragma unroll
        for (int k = 0; k < 7; ++k) { const unsigned pr = __shfl(prow, k); const float wk = __shfl(w, k);
#pragma unroll
            for (int j = 0; j < 4; ++j) { f32x4 v0, v1; unpk8(*(const GAS u32x4*)(ys + (size_t)pr * DM + 8 * F.lane + 512 * j), v0, v1); acc[2 * j] += v0 * wk; acc[2 * j + 1] += v1 * wk; } }
        float ss = 0.f;
#pragma unroll
        for (int j = 0; j < 8; ++j) ss += (acc[j][0] * acc[j][0] + acc[j][1] * acc[j][1]) + (acc[j][2] * acc[j][2] + acc[j][3] * acc[j][3]);
        const float rstd = 1.0f / sqrtf(wave_sum(ss) * (1.0f / DM) + EPS);
#pragma unroll
        for (int j = 0; j < 8; ++j) { const int c = 8 * F.lane + 512 * (j >> 1) + 4 * (j & 1);
            const f32x4 xm = *(const GAS f32x4*)(a.out + (size_t)t * DM + c), g = *(const f32x4*)(a.ffn_post_g + c), gf = *(const f32x4*)(mod + b * 12288 + 5 * 2048 + c);
            *(GAS f32x4*)(a.out + (size_t)t * DM + c) = xm + gf * (acc[j] * rstd * g); }
    }
}

constexpr int NPHASE = 12;
__global__ void __launch_bounds__(NTHR, 2) mk_fwd(Args args) {
    extern __shared__ __attribute__((aligned(16))) unsigned char lds_raw[];
    Frame F;
    F.lds = (LAS unsigned char*)lds_raw;
    F.tid = threadIdx.x; F.lane = F.tid & 63; F.wave = __builtin_amdgcn_readfirstlane(F.tid >> 6);
    F.G = gridDim.x; { const int bx = blockIdx.x; F.vcu = (F.G % 8 == 0) ? (bx % 8) * (F.G / 8) + bx / 8 : bx; }
    F.ws = args.ws;
    unsigned* ctl = (unsigned*)(args.ws + WS_CTL);
    const int lo = args.ph_lo, hi = args.ph_hi;
    if (F.tid < 16) ((LAS unsigned*)(F.lds + LDS_MISC))[F.tid] = 0u;
    __syncthreads();
    XcdBarrier bar; bar.bar = ctl + CW_BAR; bar.x = 0; bar.st = nullptr;
    if (hi - lo > 1) bar = xcd_barrier_post(ctl + CW_BAR, (volatile LAS unsigned*)(F.lds + LDS_MISC));
#ifndef MK_ONLY
#define MK_ONLY -1
#endif
#define IN(k) ((MK_ONLY < 0 || (k) == MK_ONLY) && lo <= (k) && (k) < hi)
#define SEAM(k) do { if (IN(k) && IN((k) + 1)) xcd_barrier(bar); } while (0)
#ifndef MK_REP
#define MK_REP -1
#endif
#define REPS(k) _Pragma("unroll") for (int rep_ = 0; rep_ < ((k) == MK_REP ? 2 : 1); ++rep_)

    if (IN(0)) REPS(0) { p0_prologue(F, args); } SEAM(0);
    if (IN(1)) REPS(1) { p1_h1(F, args); } SEAM(1);
    if (IN(2)) REPS(2) {
        pg8::StaticOrder S; S.init(wsp<h16>(F, A_H1), DM, wsp<h16>(F, W_IN), DM, NPROJ, F.G, (int)blockIdx.x);
        EpiIn E{wsp<h16>(F, A_QA), wsp<h16>(F, A_KR), wsp<h16>(F, A_DIL), wsp<h16>(F, A_GATE), wsp<float>(F, WS_ROWSQ), wsp<float>(F, WS_COSD), wsp<float>(F, WS_SIND), wsp<float>(F, WS_COSM), wsp<float>(F, WS_SINM)};
        pg8::gemm_phase<EpiIn, pg8::StaticOrder, false>(F.lds, DM, DM, S, E);
    } SEAM(2);
    if (IN(3)) REPS(3) {
        UpOrder S{(const char*)wsp<h16>(F, A_QA), (const char*)wsp<h16>(F, W_QUP), (const char*)wsp<h16>(F, W_KVUP), F.G, F.vcu};
        EpiUp E{wsp<h16>(F, A_QM), wsp<h16>(F, A_KV), wsp<float>(F, WS_ROWSQ), wsp<float>(F, WS_COSM), wsp<float>(F, WS_SINM)};
        pg8::gemm_phase<EpiUp, UpOrder, false>(F.lds, 512, 1024, S, E);
    } SEAM(3);
    if (IN(4)) REPS(4) { p4_attention(F); } SEAM(4);
    if (IN(5)) REPS(5) {
        pg8::StaticOrder S; S.init(wsp<h16>(F, A_OMLA), 1024, wsp<h16>(F, W_MO), 1024, DM, F.G, (int)blockIdx.x);
        EpiOut<1> E{wsp<h16>(F, A_M1), DM, wsp<h16>(F, A_GATE), 4096, nullptr};
        pg8::gemm_phase<EpiOut<1>, pg8::StaticOrder, false>(F.lds, 1024, 1024, S, E);
        p5_combine(F);
    } SEAM(5);
    if (IN(6)) REPS(6) {
        pg8::StaticOrder S; S.init(wsp<h16>(F, A_ODIL), 512, wsp<h16>(F, W_DO), 512, DM, F.G, (int)blockIdx.x);
        EpiOut<2> E{wsp<h16>(F, A_MRG), DM, wsp<h16>(F, A_GATE) + 2048, 4096, wsp<h16>(F, A_M1)};
        pg8::gemm_phase<EpiOut<2>, pg8::StaticOrder, false>(F.lds, 512, 512, S, E);
    } SEAM(6);
    if (IN(7)) REPS(7) {
        pg8::StaticOrder S; S.init(wsp<h16>(F, A_MRG), DM, wsp<h16>(F, W_OUT), DM, DM, F.G, (int)blockIdx.x);
        EpiOut<0> E{wsp<h16>(F, A_YAT), DM, nullptr, 0, nullptr};
        pg8::gemm_phase<EpiOut<0>, pg8::StaticOrder, false>(F.lds, DM, DM, S, E);
    } SEAM(7);
    if (IN(8)) REPS(8) { p8_router(F, args); } SEAM(8);
    if (IN(9)) REPS(9) {
        moe_tables(F, ctl + CW_CNT);
        MoeOrder<4, true> S{(const LAS int*)(F.lds + LDS_TAB), (const LAS int*)(F.lds + LDS_TAB + 512), (const LAS int*)(F.lds + LDS_TAB + 1024),
                            (const char*)wsp<h16>(F, A_H2), (const char*)wsp<h16>(F, W_GU), wsp<unsigned>(F, WS_LIST), F.G, F.vcu};
        EpiSwiglu E{wsp<h16>(F, A_ACT)};
        pg8::gemm_phase<EpiSwiglu, MoeOrder<4, true>, true>(F.lds, DM, DM, S, E);
    } SEAM(9);
    if (IN(10)) REPS(10) {
        moe_tables(F, ctl + CW_CNT);
        MoeOrder<8, false> S{(const LAS int*)(F.lds + LDS_TAB), (const LAS int*)(F.lds + LDS_TAB + 512), (const LAS int*)(F.lds + LDS_TAB + 1024),
                             (const char*)wsp<h16>(F, A_ACT), (const char*)wsp<h16>(F, W_DN), wsp<unsigned>(F, WS_LIST), F.G, F.vcu};
        EpiOut<0> E{wsp<h16>(F, A_YS), DM, nullptr, 0, nullptr};
        pg8::gemm_phase<EpiOut<0>, MoeOrder<8, false>, false>(F.lds, 512, 512, S, E);
    } SEAM(10);
    if (IN(11)) REPS(11) { moe_tables(F, ctl + CW_CNT); p11_final(F, args); }
#undef IN
#undef SEAM
}

#if MK_DIAG
constexpr size_t WS_SAVE = 15 * MiB;
__device__ __forceinline__ unsigned hsh(unsigned a) { a ^= a >> 16; a *= 0x7feb352dU; a ^= a >> 15; a *= 0x846ca68bU; a ^= a >> 16; return a; }
__device__ __forceinline__ void dg_put(unsigned* ctl, int slot, float got, float want, float atol) {
    float e = fabsf(got - want) / (fabsf(want) + atol); if (!(e < 1e30f)) e = 1e30f;
    atomicMax(ctl + CW_DIAG + slot, __float_as_uint(e));
}
__device__ __forceinline__ float dg_dot(const h16* arow, const float* W, int K, int ldw, int col) { float s = 0.f; for (int k = 0; k < K; ++k) s += (float)arow[k] * W[(size_t)k * ldw + col]; return s; }
__device__ __forceinline__ void dg_cs(float ang, float& c, float& s_) { const double a = (double)ang; const double tw = 6.283185307179586476925; const double r = a - tw * floor(a / tw); c = cosf((float)r); s_ = sinf((float)r); }
__device__ __forceinline__ int dg_tstart(const unsigned* cnt, int e) { int s = 0; for (int j = 0; j < e; ++j) s += ((j < 64 ? (int)cnt[64 * j] : NTOK) + 255) >> 8; return s; }
__global__ void __launch_bounds__(256) diag_check(Args a, int phase) {
    unsigned char* ws = a.ws; unsigned* ctl = (unsigned*)(ws + WS_CTL);
    const int gid = blockIdx.x * 256 + threadIdx.x; const unsigned h0 = hsh(gid * 7919u + phase * 104729u + 12345u), h1v = hsh(h0 + 1u), h2v = hsh(h0 + 2u);
    const float* mod = (const float*)(ws + WS_MOD);
    __shared__ float red[256 * 6]; __shared__ float sc64[64]; __shared__ float bs64[64];
    if (phase == 0) {
        if (gid < 512) { const int b = h0 & 3, j = h1v % 12288; float s = 0.f; for (int k = 0; k < DM; ++k) { const float v = a.c[b * DM + k]; s += v / (1.f + expf(-v)) * a.w_ada[(size_t)k * 12288 + j]; }
            dg_put(ctl, 0, mod[b * 12288 + j], s + a.b_ada[j], 0.02f); }
        else if (gid < 4096) { const int which = h0 % 9; const int e = h1v & 63; float got, want;
            if (which == 0) { const int k = h2v % DM, n = hsh(h2v) % 9792; got = (float)((const h16*)(ws + W_IN))[(size_t)row_in(n) * DM + k]; want = a.w_in[(size_t)k * 9792 + n]; }
            else if (which == 1) { const int k = h2v % 512, n = hsh(h2v) % 1536; got = (float)((const h16*)(ws + W_QUP))[(size_t)row_qup(n) * 512 + k]; want = a.w_q_up[(size_t)k * 1536 + n] * a.q_a_norm_g[k]; }
            else if (which == 2) { const int k = h2v % 512, n = hsh(h2v) % 2048; got = (float)((const h16*)(ws + W_KVUP))[(size_t)n * 512 + k]; want = a.w_kv_up[(size_t)k * 2048 + n] * a.kv_a_norm_g[k]; }
            else if (which == 3) { const int k = h2v % 1024, n = hsh(h2v) % 2048; got = (float)((const h16*)(ws + W_MO))[(size_t)n * 1024 + k]; want = a.w_mla_o[(size_t)k * 2048 + n]; }
            else if (which == 4) { const int k = h2v % 512, n = hsh(h2v) % 2048; got = (float)((const h16*)(ws + W_DO))[(size_t)n * 512 + k]; want = a.w_dil_o[(size_t)k * 2048 + n]; }
            else if (which == 5) { const int k = h2v % DM, n = hsh(h2v) % 2048; got = (float)((const h16*)(ws + W_OUT))[(size_t)n * DM + k]; want = a.w_out[(size_t)k * DM + n]; }
            else if (which == 6) { const int k = h2v % DM, n = hsh(h2v) % 64; got = (float)((const h16*)(ws + W_R))[(size_t)n * DM + k]; want = a.w_router[(size_t)k * 64 + n]; }
            else if (which == 7) { const int k = h2v % DM, n = hsh(h2v) % 512, up = (h2v >> 20) & 1; const int ee = (h1v % 65);
                got = (float)((const h16*)(ws + W_GU))[((size_t)ee * 1024 + (n >> 7) * 256 + up * 128 + (n & 127)) * DM + k];
                const float* src = ee < 64 ? (up ? a.w_exp_up : a.w_exp_gate) + (size_t)ee * DM * 512 : (up ? a.w_sh_up : a.w_sh_gate); want = src[(size_t)k * 512 + n]; }
            else { const int k = h2v % 512, n = hsh(h2v) % DM; const int ee = (h1v % 65);
                got = (float)((const h16*)(ws + W_DN))[((size_t)ee * 2048 + n) * 512 + k]; const float* src = ee < 64 ? a.w_exp_down + (size_t)ee * 512 * DM : a.w_sh_down; want = src[(size_t)k * DM + n]; }
            (void)e; dg_put(ctl, 0, got, want, 1e-3f); }
        else if (gid < 8192) { const int t = h0 % NTOK, j = h1v % 48; const float pf = (float)a.pos[t]; float c, s_;
            if (j < 16) { dg_cs(pf * a.invf_d[j], c, s_); dg_put(ctl, 0, ((const float*)(ws + WS_COSD))[t * 16 + j], c, 0.05f); dg_put(ctl, 0, ((const float*)(ws + WS_SIND))[t * 16 + j], s_, 0.05f); }
            else { dg_cs(pf * a.invf_m[j - 16], c, s_); dg_put(ctl, 0, ((const float*)(ws + WS_COSM))[t * 32 + j - 16], c, 0.05f); dg_put(ctl, 0, ((const float*)(ws + WS_SINM))[t * 32 + j - 16], s_, 0.05f); } }
    } else if (phase == 1) {
        if (gid < 2048) { const int t = h0 % NTOK, c = h1v % DM, b = t >> 12; float ss = 0.f; for (int k = 0; k < DM; ++k) { const float v = a.x[(size_t)t * DM + k]; ss += v * v; }
            const float rstd = 1.f / sqrtf(ss / DM + EPS); const float want = a.x[(size_t)t * DM + c] * rstd * a.attn_pre_g[c] * (1.f + mod[b * 12288 + 2048 + c]) + mod[b * 12288 + c];
            dg_put(ctl, 1, (float)((const h16*)(ws + A_H1))[(size_t)t * DM + c], want, 0.05f); }
    } else if (phase == 2) {
        const h16* h1 = (const h16*)(ws + A_H1);
        if (gid < 4096) { const int t = h0 % NTOK; int c = h1v % 9792; const h16* ar = h1 + (size_t)t * DM; const float pf = (float)a.pos[t]; float got, want;
            if (c < 1024) { want = dg_dot(ar, a.w_in, DM, 9792, c); got = (float)((const h16*)(ws + A_QA))[(size_t)t * 1024 + c]; }
            else if (c < 1088) { const int i = (c - 1024) & 31, second = (c - 1024) >> 5; const float t1 = dg_dot(ar, a.w_in, DM, 9792, 1024 + i), t2 = dg_dot(ar, a.w_in, DM, 9792, 1024 + 32 + i);
                float cs, sn; dg_cs(pf * a.invf_m[i], cs, sn); want = second ? t2 * cs + t1 * sn : t1 * cs - t2 * sn; got = (float)((const h16*)(ws + A_KR))[(size_t)t * 64 + 2 * i + second]; }
            else if (c < 5696) { const int dc = c - 1088, part = dc / 1536, hd = (dc % 1536) >> 7, dim = dc & 127;
                if (part < 2 && dim < 32) { const int i = dim & 15, second = dim >> 4; const int cb = c - dim; const float t1 = dg_dot(ar, a.w_in, DM, 9792, cb + i), t2 = dg_dot(ar, a.w_in, DM, 9792, cb + 16 + i);
                    float cs, sn; dg_cs(pf * a.invf_d[i], cs, sn); want = second ? t2 * cs + t1 * sn : t1 * cs - t2 * sn; if (part == 0) want *= QS_D;
                    got = (float)((const h16*)(ws + A_DIL))[(size_t)t * 4608 + part * 1536 + hd * 128 + 2 * i + second]; }
                else { want = dg_dot(ar, a.w_in, DM, 9792, c); if (part == 0) want *= QS_D; got = (float)((const h16*)(ws + A_DIL))[(size_t)t * 4608 + dc]; } }
            else { want = 1.f / (1.f + expf(-dg_dot(ar, a.w_in, DM, 9792, c))); got = (float)((const h16*)(ws + A_GATE))[(size_t)t * 4096 + (c - 5696)]; }
            dg_put(ctl, 2, got, want, 0.05f); }
        else if (gid < 4608) { const int t = h0 % NTOK, which = h1v & 1; const h16* qa = (const h16*)(ws + A_QA) + (size_t)t * 1024 + which * 512; float ss = 0.f; for (int k = 0; k < 512; ++k) ss += (float)qa[k] * (float)qa[k];
            const float* rq = (const float*)(ws + WS_ROWSQ) + (size_t)t * 16 + which * 8; float g = 0.f; for (int k = 0; k < 8; ++k) g += rq[k]; dg_put(ctl, 2, g, ss, 1.0f); }
    } else if (phase == 3) {
        if (gid < 4096) { const int t = h0 % NTOK, which = h1v & 1; const h16* qa = (const h16*)(ws + A_QA) + (size_t)t * 1024 + which * 512; const float pf = (float)a.pos[t];
            float ss = 0.f; for (int k = 0; k < 512; ++k) ss += (float)qa[k] * (float)qa[k]; const float rstd = 1.f / sqrtf(ss / 512.f + EPS); float got, want;
            if (which == 0) { const int cq = h2v % 1536, hd = cq / 192, j = cq % 192;
                if (j < 128) { float s_ = 0.f; for (int k = 0; k < 512; ++k) s_ += (float)qa[k] * rstd * a.q_a_norm_g[k] * a.w_q_up[(size_t)k * 1536 + cq]; want = s_ * QS_M; got = (float)((const h16*)(ws + A_QM))[(size_t)t * 1536 + hd * 128 + j]; }
                else { const int i = (j - 128) & 31, second = (j - 128) >> 5; float t1 = 0.f, t2 = 0.f;
                    for (int k = 0; k < 512; ++k) { const float nv = (float)qa[k] * rstd * a.q_a_norm_g[k]; t1 += nv * a.w_q_up[(size_t)k * 1536 + hd * 192 + 128 + i]; t2 += nv * a.w_q_up[(size_t)k * 1536 + hd * 192 + 160 + i]; }
                    float cs, sn; dg_cs(pf * a.invf_m[i], cs, sn); want = (second ? t2 * cs + t1 * sn : t1 * cs - t2 * sn) * QS_M; got = (float)((const h16*)(ws + A_QM))[(size_t)t * 1536 + 1024 + hd * 64 + 2 * i + second]; } }
            else { const int c = h2v % 2048; float s_ = 0.f; for (int k = 0; k < 512; ++k) s_ += (float)qa[k] * rstd * a.kv_a_norm_g[k] * a.w_kv_up[(size_t)k * 2048 + c]; want = s_; got = (float)((const h16*)(ws + A_KV))[(size_t)t * 2048 + c]; }
            dg_put(ctl, 3, got, want, 0.05f); }
    } else if (phase == 4) {
        const unsigned hb = hsh(blockIdx.x * 2654435761u + 777u); const int t = hb % NTOK, b = t >> 12, sp = t & 4095; const int tid = threadIdx.x;
        float m = -1e30f, l = 0.f, o0 = 0.f, o1 = 0.f, o2 = 0.f, o3 = 0.f; const int dsel = (hb >> 16) & 31;
        if (blockIdx.x < 96) { const int hd = (hb >> 21) & 7; const h16* q = (const h16*)(ws + A_QM) + (size_t)t * 1536;
            for (int kp = tid; kp <= sp; kp += 256) { const size_t tk = (size_t)b * SEQ + kp; const h16* kk = (const h16*)(ws + A_KV) + tk * 2048 + hd * 256; const h16* kr = (const h16*)(ws + A_KR) + tk * 64;
                float s_ = 0.f; for (int d = 0; d < 128; ++d) s_ += (float)q[hd * 128 + d] * (float)kk[d]; for (int d = 0; d < 64; ++d) s_ += (float)q[1024 + hd * 64 + d] * (float)kr[d];
                const float mn = fmaxf(m, s_), al = exp2f(m - mn), pp = exp2f(s_ - mn); l = l * al + pp; o0 = o0 * al + pp * (float)kk[128 + dsel]; o1 = o1 * al + pp * (float)kk[128 + dsel + 32]; o2 = o2 * al + pp * (float)kk[128 + dsel + 64]; o3 = o3 * al + pp * (float)kk[128 + dsel + 96]; m = mn; }
        } else { const int head = (hb >> 21) % 12, g = head >> 2, dd = g == 0 ? 1 : g == 1 ? 4 : 16; const h16* q = (const h16*)(ws + A_DIL) + (size_t)t * 4608 + head * 128;
            for (int j = tid; j <= 128; j += 256) { const int kp = sp - dd * j; if (kp < 0) continue; const size_t tk = (size_t)b * SEQ + kp; const h16* kk = (const h16*)(ws + A_DIL) + tk * 4608 + 1536 + head * 128; const h16* vv = (const h16*)(ws + A_DIL) + tk * 4608 + 3072 + head * 128;
                float s_ = 0.f; for (int d = 0; d < 128; ++d) s_ += (float)q[d] * (float)kk[d];
                const float mn = fmaxf(m, s_), al = exp2f(m - mn), pp = exp2f(s_ - mn); l = l * al + pp; o0 = o0 * al + pp * (float)vv[dsel]; o1 = o1 * al + pp * (float)vv[dsel + 32]; o2 = o2 * al + pp * (float)vv[dsel + 64]; o3 = o3 * al + pp * (float)vv[dsel + 96]; m = mn; } }
        red[tid * 6 + 0] = m; red[tid * 6 + 1] = l; red[tid * 6 + 2] = o0; red[tid * 6 + 3] = o1; red[tid * 6 + 4] = o2; red[tid * 6 + 5] = o3; __syncthreads();
        if (tid == 0) { float M = -1e30f; for (int i = 0; i < 256; ++i) M = fmaxf(M, red[i * 6]); float L = 0.f, O0 = 0.f, O1 = 0.f, O2 = 0.f, O3 = 0.f;
            for (int i = 0; i < 256; ++i) { const float w = exp2f(red[i * 6] - M); L += red[i * 6 + 1] * w; O0 += red[i * 6 + 2] * w; O1 += red[i * 6 + 3] * w; O2 += red[i * 6 + 4] * w; O3 += red[i * 6 + 5] * w; }
            if (blockIdx.x < 96) { const int hd = (hb >> 21) & 7; const h16* og = (const h16*)(ws + A_OMLA) + (size_t)t * 1024 + hd * 128;
                dg_put(ctl, 4, (float)og[dsel], O0 / L, 0.02f); dg_put(ctl, 4, (float)og[dsel + 32], O1 / L, 0.02f); dg_put(ctl, 4, (float)og[dsel + 64], O2 / L, 0.02f); dg_put(ctl, 4, (float)og[dsel + 96], O3 / L, 0.02f); }
            else { const int head = (hb >> 21) % 12; const h16* og = (const h16*)(ws + A_OD) + (size_t)t * 1536 + head * 128;
                dg_put(ctl, 5, (float)og[dsel], O0 / L, 0.02f); dg_put(ctl, 5, (float)og[dsel + 32], O1 / L, 0.02f); dg_put(ctl, 5, (float)og[dsel + 64], O2 / L, 0.02f); dg_put(ctl, 5, (float)og[dsel + 96], O3 / L, 0.02f);
                dg_put(ctl, 5, ((const float*)(ws + WS_LSE))[(size_t)t * 12 + head], M + log2f(L), 0.5f); } }
    } else if (phase == 5) {
        if (gid < 2048) { const int t = h0 % NTOK, n = h1v % DM; const float want = dg_dot((const h16*)(ws + A_OMLA) + (size_t)t * 1024, a.w_mla_o, 1024, DM, n) * (float)((const h16*)(ws + A_GATE))[(size_t)t * 4096 + n];
            dg_put(ctl, 6, (float)((const h16*)(ws + A_M1))[(size_t)t * DM + n], want, 0.05f); }
        else if (gid < 4096) { const int t = h0 % NTOK, hs = h1v & 3, d = h2v & 127; const float* ls = (const float*)(ws + WS_LSE) + (size_t)t * 12; const h16* od = (const h16*)(ws + A_OD) + (size_t)t * 1536;
            const float mx = fmaxf(ls[hs], fmaxf(ls[4 + hs], ls[8 + hs])); const float w0 = exp2f(ls[hs] - mx), w1 = exp2f(ls[4 + hs] - mx), w2 = exp2f(ls[8 + hs] - mx);
            const float want = (w0 * (float)od[hs * 128 + d] + w1 * (float)od[512 + hs * 128 + d] + w2 * (float)od[1024 + hs * 128 + d]) / (w0 + w1 + w2);
            dg_put(ctl, 7, (float)((const h16*)(ws + A_ODIL))[(size_t)t * 512 + hs * 128 + d], want, 0.02f); }
    } else if (phase == 6) {
        if (gid < 2048) { const int t = h0 % NTOK, n = h1v % DM; const float want = (float)((const h16*)(ws + A_M1))[(size_t)t * DM + n] + dg_dot((const h16*)(ws + A_ODIL) + (size_t)t * 512, a.w_dil_o, 512, DM, n) * (float)((const h16*)(ws + A_GATE))[(size_t)t * 4096 + 2048 + n];
            dg_put(ctl, 8, (float)((const h16*)(ws + A_MRG))[(size_t)t * DM + n], want, 0.05f); }
    } else if (phase == 7) {
        if (gid < 2048) { const int t = h0 % NTOK, n = h1v % DM; const float want = dg_dot((const h16*)(ws + A_MRG) + (size_t)t * DM, a.w_out, DM, DM, n);
            dg_put(ctl, 9, (float)((const h16*)(ws + A_YAT))[(size_t)t * DM + n], want, 0.05f); }
    } else if (phase == 8) {
        if (gid < 1024) { const int t = h0 % NTOK, c = h1v % DM, b = t >> 12; const h16* y = (const h16*)(ws + A_YAT) + (size_t)t * DM; float ss = 0.f; for (int k = 0; k < DM; ++k) ss += (float)y[k] * (float)y[k];
            const float r1 = 1.f / sqrtf(ss / DM + EPS); float ss2 = 0.f, xc = 0.f;
            for (int k = 0; k < DM; ++k) { const float xm = a.x[(size_t)t * DM + k] + mod[b * 12288 + 4096 + k] * ((float)y[k] * r1 * a.attn_post_g[k]); ss2 += xm * xm; if (k == c) xc = xm; }
            const float r2 = 1.f / sqrtf(ss2 / DM + EPS);
            dg_put(ctl, 10, a.out[(size_t)t * DM + c], xc, 0.05f);
            dg_put(ctl, 10, (float)((const h16*)(ws + A_H2))[(size_t)t * DM + c], xc * r2 * a.ffn_pre_g[c] * (1.f + mod[b * 12288 + 4 * 2048 + c]) + mod[b * 12288 + 3 * 2048 + c], 0.05f); }
        if (blockIdx.x >= 8 && blockIdx.x < 72) {
            const unsigned hb = hsh(blockIdx.x * 2654435761u + 99u); const int t = hb % NTOK; const int tid = threadIdx.x;
            if (tid < 64) { const float lgt = dg_dot((const h16*)(ws + A_H2) + (size_t)t * DM, a.w_router, DM, 64, tid); const float sc = 1.f / (1.f + expf(-lgt)); sc64[tid] = sc; bs64[tid] = sc + a.router_bias[tid]; }
            __syncthreads();
            if (tid == 0) { unsigned gsel = 0u; float bad = 0.f;
                for (int r = 0; r < 4; ++r) { int best = -1; float bv = -1e30f; for (int g = 0; g < 8; ++g) { if (gsel >> g & 1u) continue; float m1 = -1e30f, m2 = -1e30f; for (int j = 0; j < 8; ++j) { const float v = bs64[g * 8 + j]; if (v > m1) { m2 = m1; m1 = v; } else if (v > m2) m2 = v; } if (m1 + m2 > bv) { bv = m1 + m2; best = g; } } gsel |= 1u << best; }
                unsigned long long esel = 0ull; float wsum = 0.f;
                for (int r = 0; r < 6; ++r) { int best = -1; float bv = -1e30f; for (int e = 0; e < 64; ++e) { if (!(gsel >> (e >> 3) & 1u) || (esel >> e & 1ull)) continue; if (bs64[e] > bv) { bv = bs64[e]; best = e; } } esel |= 1ull << best; wsum += sc64[best];
                    const unsigned pk = ((const unsigned*)(ws + WS_TOKPOS))[(size_t)t * 6 + r]; const int ge = pk >> 20, slot = pk & 0xFFFFF; if (ge != best) bad += 1.f; else if (((const unsigned*)(ws + WS_LIST))[(size_t)ge * LISTCAP + slot] != (unsigned)t) bad += 1.f; }
                for (int r = 0; r < 6; ++r) { const unsigned pk = ((const unsigned*)(ws + WS_TOKPOS))[(size_t)t * 6 + r]; const int ge = pk >> 20; const float w = ((const float*)(ws + WS_TOKW))[(size_t)t * 6 + r]; if (fabsf(w - sc64[ge] / (wsum + 1e-20f) * 2.5f) > 0.01f) bad += 1.f; }
                atomicAdd((float*)(ctl + CW_DIAG + 11), bad / (64.f * 12.f)); }
        }
        if (gid == 0) { unsigned tot = 0; for (int e = 0; e < 64; ++e) tot += ctl[CW_CNT + 64 * e]; dg_put(ctl, 10, (float)tot, (float)(NTOK * 6), 1.0f); }
    } else if (phase == 9 || phase == 10) {
        const unsigned* cnt = ctl + CW_CNT;
        if (gid < 2048) { const int t = h0 % NTOK, k = h1v % 7; int e, slot; if (k == 6) { e = 64; slot = t; } else { const unsigned pk = ((const unsigned*)(ws + WS_TOKPOS))[(size_t)t * 6 + k]; e = pk >> 20; slot = pk & 0xFFFFF; }
            const size_t prow = (size_t)dg_tstart(cnt, e) * 256 + slot;
            if (phase == 9) { const int n = h2v % 512; const float* wg = e < 64 ? a.w_exp_gate + (size_t)e * DM * 512 : a.w_sh_gate; const float* wu = e < 64 ? a.w_exp_up + (size_t)e * DM * 512 : a.w_sh_up;
                const h16* hr = (const h16*)(ws + A_H2) + (size_t)t * DM; const float g = dg_dot(hr, wg, DM, 512, n), u = dg_dot(hr, wu, DM, 512, n);
                dg_put(ctl, 12, (float)((const h16*)(ws + A_ACT))[prow * 512 + n], g / (1.f + expf(-g)) * u, 0.05f); }
            else { const int n = h2v % DM; const float* wd = e < 64 ? a.w_exp_down + (size_t)e * 512 * DM : a.w_sh_down;
                dg_put(ctl, 13, (float)((const h16*)(ws + A_YS))[prow * DM + n], dg_dot((const h16*)(ws + A_ACT) + prow * 512, wd, 512, DM, n), 0.05f); } }
    } else if (phase == 100) {
        const int si = blockIdx.x; if (si < 64) { const int t = hsh(si * 31337u + 5u) % NTOK; float* sv = (float*)(ws + WS_SAVE) + (size_t)si * DM; for (int c = threadIdx.x; c < DM; c += 256) sv[c] = a.out[(size_t)t * DM + c]; }
    } else if (phase == 11) {
        const int si = blockIdx.x; if (si < 64) { const int t = hsh(si * 31337u + 5u) % NTOK, b = t >> 12; const unsigned* cnt = ctl + CW_CNT; const float* sv = (const float*)(ws + WS_SAVE) + (size_t)si * DM; const int tid = threadIdx.x;
            float vals[8]; float ss = 0.f;
#pragma unroll
            for (int q = 0; q < 8; ++q) { const int c = tid + 256 * q; float s_ = (float)((const h16*)(ws + A_YS))[((size_t)dg_tstart(cnt, 64) * 256 + t) * DM + c];
                for (int k = 0; k < 6; ++k) { const unsigned pk = ((const unsigned*)(ws + WS_TOKPOS))[(size_t)t * 6 + k]; const int e = pk >> 20, slot = pk & 0xFFFFF;
                    s_ += ((const float*)(ws + WS_TOKW))[(size_t)t * 6 + k] * (float)((const h16*)(ws + A_YS))[((size_t)dg_tstart(cnt, e) * 256 + slot) * DM + c]; }
                vals[q] = s_; ss += s_ * s_; }
            red[tid] = ss; __syncthreads(); if (tid == 0) { float tot = 0.f; for (int i = 0; i < 256; ++i) tot += red[i]; red[256] = tot; } __syncthreads();
            const float rstd = 1.f / sqrtf(red[256] / DM + EPS);
#pragma unroll
            for (int q = 0; q < 8; ++q) { const int c = tid + 256 * q; dg_put(ctl, 14, a.out[(size_t)t * DM + c], sv[c] + mod[b * 12288 + 5 * 2048 + c] * (vals[q] * rstd * a.ffn_post_g[c]), 0.05f); } }
    }
}
__global__ void __launch_bounds__(256) diag_final(Args a) {
    unsigned* ctl = (unsigned*)(a.ws + WS_CTL); int code = 0;
    for (int sl = 14; sl >= 0; --sl) { const float e = __uint_as_float(ctl[CW_DIAG + sl]); const float thr = (sl == 11) ? 0.08f : 0.03f; if (!(e <= thr)) code = sl + 1; }
    if (code == 0) return;
    const float f = 1.0f + 0.5f * (float)code;
    for (size_t i = (size_t)blockIdx.x * 256 + threadIdx.x; i < (size_t)NTOK * DM; i += (size_t)gridDim.x * 256) a.out[i] = a.x[i] * f;
}
#endif

extern "C" void kernel_launch(void* const* d_in, const int* in_sizes, int n_in, void* d_out, int out_size, void* d_ws, size_t ws_size, hipStream_t stream) {
    static int grid = 0;
    if (grid == 0) {
        if (n_in != 25 || in_sizes[0] != NTOK * DM || out_size != NTOK * DM || ws_size < WS_END) {
            fprintf(stderr, "kernel_launch: unexpected shapes / workspace (n_in %d, ws %zu, need %zu); nothing launched\n", n_in, ws_size, (size_t)WS_END); grid = -1; return; }
        int dev = 0, cus = 0, per_cu = 0;
        if (hipGetDevice(&dev) != hipSuccess || hipDeviceGetAttribute(&cus, hipDeviceAttributeMultiprocessorCount, dev) != hipSuccess) { grid = -1; return; }
        if (hipFuncSetAttribute((const void*)mk_fwd, hipFuncAttributeMaxDynamicSharedMemorySize, LDS_BYTES) != hipSuccess) { fprintf(stderr, "kernel_launch: hipFuncSetAttribute failed\n"); grid = -1; return; }
        if (hipOccupancyMaxActiveBlocksPerMultiprocessor(&per_cu, (const void*)mk_fwd, NTHR, LDS_BYTES) != hipSuccess || per_cu < 1)
            fprintf(stderr, "kernel_launch: note: occupancy query reports %d workgroups per CU\n", per_cu);
        (void)hipGetLastError();
        grid = cus;
    }
    if (grid < 0) return;
    if (hipMemsetAsync((char*)d_ws + WS_CTL, 0, CTL_ZERO_BYTES, stream) != hipSuccess) return;
    Args a{};
    a.x = (const float*)d_in[0]; a.c = (const float*)d_in[1]; a.pos = (const int*)d_in[2]; a.w_ada = (const float*)d_in[3]; a.b_ada = (const float*)d_in[4];
    a.attn_pre_g = (const float*)d_in[5]; a.w_in = (const float*)d_in[6]; a.q_a_norm_g = (const float*)d_in[7]; a.w_q_up = (const float*)d_in[8];
    a.kv_a_norm_g = (const float*)d_in[9]; a.w_kv_up = (const float*)d_in[10]; a.w_mla_o = (const float*)d_in[11]; a.w_dil_o = (const float*)d_in[12];
    a.w_out = (const float*)d_in[13]; a.attn_post_g = (const float*)d_in[14]; a.ffn_pre_g = (const float*)d_in[15]; a.w_router = (const float*)d_in[16];
    a.router_bias = (const float*)d_in[17]; a.w_exp_gate = (const float*)d_in[18]; a.w_exp_up = (const float*)d_in[19]; a.w_exp_down = (const float*)d_in[20];
    a.w_sh_gate = (const float*)d_in[21]; a.w_sh_up = (const float*)d_in[22]; a.w_sh_down = (const float*)d_in[23]; a.ffn_post_g = (const float*)d_in[24];
    a.out = (float*)d_out; a.ws = (unsigned char*)d_ws;
    for (int i = 0; i < 16; ++i) a.invf_d[i] = 1.0f / powf(500000.0f, (float)(2 * i) / 32.0f);
    for (int i = 0; i < 32; ++i) a.invf_m[i] = 1.0f / powf(500000.0f, (float)(2 * i) / 64.0f);
#if MK_LAUNCHES == 1
    a.ph_lo = 0; a.ph_hi = NPHASE;
    hipLaunchKernelGGL(mk_fwd, dim3(grid), dim3(NTHR), LDS_BYTES, stream, a);
#else
#ifndef MK_STOP
#define MK_STOP NPHASE
#endif
    for (int p = 0; p < MK_STOP; ++p) { a.ph_lo = p; a.ph_hi = p + 1;
#if MK_DIAG
        if (p == 11) hipLaunchKernelGGL(diag_check, dim3(256), dim3(256), 0, stream, a, 100);
#endif
        hipLaunchKernelGGL(mk_fwd, dim3(grid), dim3(NTHR), LDS_BYTES, stream, a);
#if MK_DIAG
        hipLaunchKernelGGL(diag_check, dim3(256), dim3(256), 0, stream, a, p);
#endif
    }
#if MK_DIAG
    hipLaunchKernelGGL(diag_final, dim3(1024), dim3(256), 0, stream, a);
#endif
#endif
}
```

```cpp
#include <hip/hip_runtime.h>
#include <cstdio>
#include <cstdint>
#include <cmath>

#ifndef MK_LAUNCHES
#define MK_LAUNCHES 1
#endif
#ifndef MK_DIAG
#define MK_DIAG 0
#endif

#define GAS __attribute__((address_space(1)))
#define LAS __attribute__((address_space(3)))
typedef _Float16 h16;
typedef _Float16 h16x8 __attribute__((ext_vector_type(8)));
typedef _Float16 h16x4 __attribute__((ext_vector_type(4)));
typedef _Float16 h16x2 __attribute__((ext_vector_type(2)));
typedef short s16x4 __attribute__((ext_vector_type(4)));
typedef float f32x4 __attribute__((ext_vector_type(4)));
typedef float f32x2 __attribute__((ext_vector_type(2)));
typedef float f32x16 __attribute__((ext_vector_type(16)));
typedef unsigned u32x4 __attribute__((ext_vector_type(4)));
typedef unsigned u32x2 __attribute__((ext_vector_type(2)));
typedef int i32x8 __attribute__((ext_vector_type(8)));
typedef int i32x4 __attribute__((ext_vector_type(4)));

constexpr int NB = 4, SEQ = 4096, NTOK = NB * SEQ, DM = 2048;
constexpr int NPROJ = 9984;
constexpr int NEXP = 64, TOPK = 6, EDIM = 512;
constexpr int LISTCAP = 16384;
constexpr int MAXTILES = 512;
constexpr float EPS = 1e-6f;
constexpr float LOG2E = 1.4426950408889634f;
constexpr float QS_M = 0.07216878364870322f * LOG2E;
constexpr float QS_D = 0.08838834764831845f * LOG2E;
constexpr float SC_GU = 64.0f, SC_DN = 32.0f;

constexpr size_t MiB = 1u << 20;
constexpr size_t WS_CTL = 0, CTL_ZERO_BYTES = 1 * MiB;
constexpr size_t WS_ROWSQ = 1 * MiB;
constexpr size_t WS_MOD = 2 * MiB;
constexpr size_t WS_COSD = 3 * MiB, WS_SIND = 4 * MiB;
constexpr size_t WS_COSM = 5 * MiB, WS_SINM = 7 * MiB;
constexpr size_t WS_LSE = 9 * MiB;
constexpr size_t WS_TOKPOS = 10 * MiB;
constexpr size_t WS_TOKW = 10 * MiB + 512 * 1024;
constexpr size_t WS_LIST = 11 * MiB;
constexpr size_t WS_W = 16 * MiB;
constexpr size_t W_IN = WS_W;
constexpr size_t W_QUP = W_IN + 39 * MiB;
constexpr size_t W_KVUP = W_QUP + 3 * MiB / 2;
constexpr size_t W_MO = W_KVUP + 2 * MiB;
constexpr size_t W_DO = W_MO + 4 * MiB;
constexpr size_t W_OUT = W_DO + 2 * MiB;
constexpr size_t W_R = W_OUT + 8 * MiB;
constexpr size_t W_GU = W_R + MiB / 4;
constexpr size_t W_DN = W_GU + 260 * MiB;
constexpr size_t WS_AR = W_DN + 130 * MiB;
static_assert(WS_AR == (16 + 447) * MiB - MiB / 4, "weights");
constexpr size_t AR = ((WS_AR + MiB - 1) / MiB) * MiB;
constexpr size_t A_YS = AR + 0 * MiB;
constexpr size_t A_ACT = AR + 512 * MiB;
constexpr size_t A_H2 = AR + 0 * MiB;
constexpr size_t A_YAT = AR + 64 * MiB;
constexpr size_t A_MRG = AR + 128 * MiB;
constexpr size_t A_GATE = AR + 192 * MiB;
constexpr size_t A_M1 = AR + 320 * MiB;
constexpr size_t A_CAT = AR + 384 * MiB;
constexpr size_t A_ODIL = A_CAT, A_OMLA = A_CAT;
constexpr size_t A_OD = AR + 432 * MiB;
constexpr size_t A_DIL = AR + 0 * MiB;
constexpr size_t A_QM = AR + 144 * MiB;
constexpr size_t A_KV = AR + 480 * MiB;
constexpr size_t A_KR = AR + 544 * MiB;
constexpr size_t A_QA = AR + 546 * MiB;
constexpr size_t A_H1 = AR + 480 * MiB;
constexpr size_t WS_END = AR + 640 * MiB;

constexpr int CW_BAR = 0;
constexpr int CW_CNT = 16384;
constexpr int CW_DIAG = 32768;

constexpr int LDS_BYTES = 147456;
constexpr int LDS_TAB = 131072;
constexpr int LDS_MISC = LDS_BYTES - 64;
constexpr int NWAVES = 8, NTHR = 512;

#define LDS_WAIT() asm volatile("s_waitcnt lgkmcnt(0)" ::: "memory")
#define VM_WAIT() asm volatile("s_waitcnt vmcnt(0)" ::: "memory")

__device__ __forceinline__ unsigned pkh(float a, float b) { h16x2 r; r.x = (h16)a; r.y = (h16)b; return __builtin_bit_cast(unsigned, r); }
__device__ __forceinline__ u32x4 pk8(f32x4 a, f32x4 b) { u32x4 w; w.x = pkh(a[0], a[1]); w.y = pkh(a[2], a[3]); w.z = pkh(b[0], b[1]); w.w = pkh(b[2], b[3]); return w; }
__device__ __forceinline__ unsigned pk4_fp8(float a, float b, float c, float d) { int w = 0; w = __builtin_amdgcn_cvt_pk_fp8_f32(a, b, w, false); w = __builtin_amdgcn_cvt_pk_fp8_f32(c, d, w, true); return (unsigned)w; }
__device__ __forceinline__ float wave_sum(float v) {
#pragma unroll
    for (int o = 1; o < 64; o <<= 1) v += __shfl_xor(v, o);
    return v;
}
__device__ __forceinline__ float sigmoidf_(float x) { return __builtin_amdgcn_rcpf(1.0f + __builtin_amdgcn_exp2f(x * -1.4426950408889634f)); }

#define XB_TMO      128
#define XB_XCNT(j)  (256  + 64 * (j))
#define XB_XSUB(j)  (1280 + 64 * (j))
#define XB_XGEN(j)  (2304 + 64 * (j))
#define XB_TOP      3328
#define XB_TOPGEN   3392
#define XCD_BAR_WORDS 3456
#define XB_SPIN_CAP (1u << 18)
__device__ __forceinline__ unsigned xb_ld(unsigned* p)              { return __hip_atomic_load(p, __ATOMIC_RELAXED, __HIP_MEMORY_SCOPE_AGENT); }
__device__ __forceinline__ unsigned xb_add(unsigned* p, unsigned v) { return __hip_atomic_fetch_add(p, v, __ATOMIC_RELAXED, __HIP_MEMORY_SCOPE_AGENT); }
__device__ __forceinline__ unsigned xb_xcc_id() { return (unsigned)__builtin_amdgcn_s_getreg((3 << 11) | 20) & 0xFu; }
#define XB_SPIN(cond, bar) do { unsigned _sp = 0; while (cond) { __builtin_amdgcn_s_sleep(1); \
    if ((++_sp & 255u) == 0u) { if (xb_ld(&(bar)[XB_TMO])) break; if (_sp > XB_SPIN_CAP) { atomicAdd(&(bar)[XB_TMO], 1u); break; } } } } while (0)
struct XcdBarrier { unsigned* bar; unsigned x; volatile LAS unsigned* st; };
__device__ __forceinline__ XcdBarrier xcd_barrier_post(unsigned* bar, volatile LAS unsigned* st) {
    XcdBarrier b; b.bar = bar; b.x = xb_xcc_id(); b.st = st;
    if (threadIdx.x == 0) (void)xb_add(&bar[XB_XCNT(b.x)], 1u);
    return b;
}
__device__ __forceinline__ void xcd_barrier_complete(unsigned* bar, unsigned x, unsigned& nloc, unsigned& nx) {
    const unsigned G = gridDim.x * gridDim.y * gridDim.z;
    unsigned sum, cnt, mine, sp = 0u;
    for (;;) {
        sum = 0u; cnt = 0u; mine = 0u;
#pragma unroll
        for (unsigned j = 0; j < 16; ++j) { const unsigned c = xb_ld(&bar[XB_XCNT(j)]); sum += c; cnt += (c > 0u) ? 1u : 0u; mine = (j == x) ? c : mine; }
        if (sum == G) break;
        __builtin_amdgcn_s_sleep(1);
        if ((++sp & 255u) == 0u) { if (xb_ld(&bar[XB_TMO])) break; if (sp > XB_SPIN_CAP) { atomicAdd(&bar[XB_TMO], 1u); break; } }
    }
    nloc = mine > 0u ? mine : 1u; nx = cnt > 0u ? cnt : 1u;
}
__device__ __forceinline__ void xcd_barrier(const XcdBarrier& b) {
    asm volatile("s_waitcnt vmcnt(0)" ::: "memory");
    __syncthreads();
    if (threadIdx.x == 0) {
        unsigned* bar = b.bar;
        __builtin_amdgcn_s_waitcnt(0);
        unsigned nloc = b.st[0], nx = b.st[1];
        if (nloc == 0u) { xcd_barrier_complete(bar, b.x, nloc, nx); b.st[0] = nloc; b.st[1] = nx; }
        const unsigned old = xb_add(&bar[XB_XSUB(b.x)], 1u);
        const unsigned gen = old / nloc;
        if (old + 1u == (gen + 1u) * nloc) {
            __builtin_amdgcn_fence(__ATOMIC_RELEASE, "agent");
            asm volatile("s_waitcnt vmcnt(0)" ::: "memory");
            const unsigned og = xb_add(&bar[XB_TOP], 1u);
            const unsigned tg = og / nx;
            if (og + 1u == (tg + 1u) * nx) xb_add(&bar[XB_TOPGEN], 1u);
            else XB_SPIN(xb_ld(&bar[XB_TOPGEN]) == tg, bar);
            __builtin_amdgcn_fence(__ATOMIC_ACQUIRE, "agent");
            xb_add(&bar[XB_XGEN(b.x)], 1u);
            asm volatile("s_waitcnt vmcnt(0)" ::: "memory");
        } else {
            XB_SPIN(xb_ld(&bar[XB_XGEN(b.x)]) == gen, bar);
            __builtin_amdgcn_fence(__ATOMIC_ACQUIRE, "agent");
            asm volatile("s_waitcnt vmcnt(0)" ::: "memory");
        }
    }
    __syncthreads();
}

struct Args {
    const float* x; const float* c; const int* pos; const float* w_ada; const float* b_ada; const float* attn_pre_g; const float* w_in;
    const float* q_a_norm_g; const float* w_q_up; const float* kv_a_norm_g; const float* w_kv_up; const float* w_mla_o; const float* w_dil_o;
    const float* w_out; const float* attn_post_g; const float* ffn_pre_g; const float* w_router; const float* router_bias;
    const float* w_exp_gate; const float* w_exp_up; const float* w_exp_down; const float* w_sh_gate; const float* w_sh_up; const float* w_sh_down;
    const float* ffn_post_g;
    float* out; unsigned char* ws;
    float invf_d[16]; float invf_m[32];
    int ph_lo, ph_hi;
};

struct Frame {
    LAS unsigned char* lds;
    int tid, lane, wave, vcu, G;
    unsigned char* ws;
};
template <class T> __device__ __forceinline__ T* wsp(const Frame& F, size_t off) { return (T*)(F.ws + off); }

namespace pg8 {
constexpr int BM = 256, BK = 64, HALF = 128, HTB = HALF * BK * 2, STAGE_BYTES = 8 * HTB;
__device__ __forceinline__ int lds_byte(int r, int c) { const int st = (r >> 4) * 2 + (c >> 5), rr = r & 15, cc = c & 31, ob = rr * 64 + cc * 2; return st * 1024 + (ob ^ (((ob >> 9) & 1) << 5)); }
__device__ __forceinline__ void stage_rc(int b, int& R, int& C) { const int st = b / 1024, sb = b % 1024, swz = sb ^ (((sb >> 9) & 1) << 5); R = (st >> 1) * 16 + swz / 64; C = (st & 1) * 32 + (swz % 64) / 2; }
__device__ __forceinline__ int perm32(int rho) { const int n = rho >> 4, i = rho & 15; return 8 * (i >> 2) + 4 * n + (i & 3); }

struct Unit { const char* A; const char* B; int pm, pn, e, slot0, cnt, tag; };
typedef f32x4 Acc[2][2][4][2];

template <bool FP8> struct Frag;
template <> struct Frag<false> { h16x8 h[2]; };
template <> struct Frag<true> { i32x8 f8; };
template <class Epi, class Sched, bool GATHER, bool FP8 = false>
__device__ __forceinline__ void gemm_phase(LAS unsigned char* lds, const int K, const int lda, const Sched& S, const Epi& E) {
    const int tid = threadIdx.x, wid = __builtin_amdgcn_readfirstlane(tid >> 6), lane = tid & 63, wr = wid >> 2, wc = wid & 3, fr = lane & 15, fq = lane >> 4;
    int nt = K / BK; asm volatile("" : "+s"(nt));
    int sc1 = 0x7F7F7F7F; asm volatile("" : "+v"(sc1));
    int sR[2], sC[2];
    unsigned voffB[2], va[2][2], vn[2][2];
#pragma unroll
    for (int i = 0; i < 2; ++i) { int R, C; stage_rc(tid * 16 + i * 8192, R, C); sR[i] = R; sC[i] = C; const int Rb = (R & ~31) + perm32(R & 31);
        voffB[i] = (unsigned)(Rb * K + C) * 2u;
        if constexpr (Epi::PERM16) {
            const int wc_ = R >> 5, rho = R & 31, n_ = rho >> 4, fq_ = (rho & 15) >> 2, j_ = rho & 3;
            voffB[i] = (unsigned)((64 * wc_ + 16 * fq_ + 4 * n_ + j_) * K + C) * 2u; }
        va[0][i] = (unsigned)(R * lda + C) * 2u; va[1][i] = (unsigned)((R + HALF) * lda + C) * 2u; vn[0][i] = va[0][i]; vn[1][i] = va[1][i]; }
    const size_t kstep = (size_t)(BK * 2);
    const size_t hstepB = Epi::PERM16 ? (size_t)8 * K * 2 : (size_t)HALF * K * 2;
    const unsigned ldsw = (unsigned)wid * 1024u;
    const int aoff = lds_byte(wr * 64 + fr, fq * 8), boff = lds_byte(wc * 32 + fr, fq * 8);
#define PG8_SA(b, h) (((b) * 2 + (h)) * HTB)
#define PG8_SB(b, h) ((4 + (b) * 2 + (h)) * HTB)
#define PG8_STAGE(bufoff, gbase, voff) do { _Pragma("unroll") for (int _i = 0; _i < 2; ++_i) \
        __builtin_amdgcn_global_load_lds((const unsigned*)((const char*)(gbase) + (voff)[_i]), (LAS unsigned*)(lds + (bufoff) + ldsw + _i * 8192), 16, 0, 0); } while (0)
#define PG8_LD1(dst, addr) do { if constexpr (FP8) { const i32x4 lo_ = *(const LAS i32x4*)(addr), hi_ = *(const LAS i32x4*)((addr) + 1024); dst.f8 = __builtin_shufflevector(lo_, hi_, 0, 1, 2, 3, 4, 5, 6, 7); } \
        else { dst.h[0] = *(const LAS h16x8*)(addr); dst.h[1] = *(const LAS h16x8*)((addr) + 1024); } } while (0)
#define PG8_LDA(dst, b, h) do { _Pragma("unroll") for (int m = 0; m < 4; ++m) PG8_LD1(dst[m], lds + PG8_SA(b, h) + aoff + m * 2048); } while (0)
#define PG8_LDB(dst, b, h) do { _Pragma("unroll") for (int n = 0; n < 2; ++n) PG8_LD1(dst[n], lds + PG8_SB(b, h) + boff + n * 2048); } while (0)
#define PG8_MMA(ai, bj, At, Bt) do { __builtin_amdgcn_s_setprio(1); _Pragma("unroll") for (int m = 0; m < 4; ++m) _Pragma("unroll") for (int n = 0; n < 2; ++n) { \
        if constexpr (FP8) asm volatile("v_mfma_scale_f32_16x16x128_f8f6f4 %0, %1, %2, %0, %3, %3 op_sel_hi:[0,0,0]" : "+v"(acc[ai][bj][m][n]) : "v"(Bt[n].f8), "v"(At[m].f8), "v"(sc1)); \
        else { _Pragma("unroll") for (int k = 0; k < 2; ++k) acc[ai][bj][m][n] = __builtin_amdgcn_mfma_f32_16x16x32_f16(Bt[n].h[k], At[m].h[k], acc[ai][bj][m][n], 0, 0, 0); } } \
        __builtin_amdgcn_s_setprio(0); } while (0)
#define PG8_WAIT_V(n) asm volatile("s_waitcnt vmcnt(" #n ")" ::: "memory")
#define PG8_WAIT_L(n) asm volatile("s_waitcnt lgkmcnt(" #n ")" ::: "memory")
#define PG8_BAR __builtin_amdgcn_s_barrier()
#define PG8_SCHED __builtin_amdgcn_sched_barrier(0)
    Unit cur, nxt; int ui = 0;
    if (!S.next(0, cur)) return;
    Acc acc;
#pragma unroll
    for (int a = 0; a < 2; ++a)
#pragma unroll
        for (int b = 0; b < 2; ++b)
#pragma unroll
            for (int m = 0; m < 4; ++m)
#pragma unroll
                for (int n = 0; n < 2; ++n) acc[a][b][m][n] = (f32x4){0.f, 0.f, 0.f, 0.f};
    Frag<FP8> At[4], B0[2], B1[2];
    const char* cA = cur.A; const char* cB = cur.B;
    if constexpr (GATHER) {
#pragma unroll
        for (int h = 0; h < 2; ++h)
#pragma unroll
            for (int i = 0; i < 2; ++i) va[h][i] = S.voff(cur, h * HALF + sR[i], sC[i]);
    }
    PG8_STAGE(PG8_SB(0, 0), cB, voffB); PG8_STAGE(PG8_SB(0, 1), cB + hstepB, voffB); PG8_STAGE(PG8_SA(0, 0), cA, va[0]); PG8_STAGE(PG8_SA(0, 1), cA, va[1]);
    if (wr == 1) PG8_BAR;
    PG8_WAIT_V(2); PG8_BAR;
    PG8_STAGE(PG8_SB(1, 0), cB + kstep, voffB); PG8_STAGE(PG8_SA(1, 0), cA + kstep, va[0]); PG8_STAGE(PG8_SB(1, 1), cB + hstepB + kstep, voffB);
    PG8_WAIT_V(6); PG8_BAR;
    for (;;) {
        const bool has_next = S.next(ui + 1, nxt);
        const char* nA = has_next ? nxt.A : cA; const char* nB = has_next ? nxt.B : cB;
        if constexpr (GATHER) {
            if (has_next) {
#pragma unroll
                for (int h = 0; h < 2; ++h)
#pragma unroll
                    for (int i = 0; i < 2; ++i) vn[h][i] = S.voff(nxt, h * HALF + sR[i], sC[i]);
            } else {
#pragma unroll
                for (int h = 0; h < 2; ++h)
#pragma unroll
                    for (int i = 0; i < 2; ++i) vn[h][i] = va[h][i];
            }
        }
        for (int t = 0; t < nt; t += 2) {
            const bool last = (t == nt - 2);
            if constexpr (Epi::MID_T >= 0) { if (t == Epi::MID_T) E.mid(acc, cur, wr, wc, fr, fq); }
            const char* a1 = cA + (size_t)(t + 1) * kstep;
            const char* a2 = last ? nA : cA + (size_t)(t + 2) * kstep; const char* b2 = last ? nB : cB + (size_t)(t + 2) * kstep;
            const char* a3 = a2 + kstep; const char* b3 = b2 + kstep;
            unsigned v2[2][2];
#pragma unroll
            for (int h = 0; h < 2; ++h)
#pragma unroll
                for (int i = 0; i < 2; ++i) v2[h][i] = (GATHER && last) ? vn[h][i] : va[h][i];
            PG8_LDB(B0, 0, 0); PG8_LDB(B1, 0, 1); PG8_SCHED; PG8_LDA(At, 0, 0); PG8_STAGE(PG8_SA(1, 1), a1, va[1]);
            PG8_WAIT_V(8); PG8_WAIT_L(0); PG8_BAR; PG8_MMA(0, 0, At, B0); PG8_MMA(0, 1, At, B1); PG8_BAR; PG8_SCHED;
            PG8_LDA(At, 0, 1); PG8_STAGE(PG8_SB(0, 0), b2, voffB); PG8_STAGE(PG8_SB(0, 1), b2 + hstepB, voffB); PG8_STAGE(PG8_SA(0, 0), a2, v2[0]);
            PG8_WAIT_V(8); PG8_WAIT_L(0); PG8_BAR; PG8_MMA(1, 0, At, B0); PG8_MMA(1, 1, At, B1); PG8_BAR; PG8_SCHED;
            PG8_LDB(B0, 1, 0); PG8_LDB(B1, 1, 1); PG8_SCHED; PG8_LDA(At, 1, 0); PG8_STAGE(PG8_SA(0, 1), a2, v2[1]);
            PG8_WAIT_V(8); PG8_WAIT_L(0); PG8_BAR; PG8_MMA(0, 0, At, B0); PG8_MMA(0, 1, At, B1); PG8_BAR; PG8_SCHED;
            PG8_LDA(At, 1, 1); PG8_STAGE(PG8_SB(1, 0), b3, voffB); PG8_STAGE(PG8_SB(1, 1), b3 + hstepB, voffB); PG8_STAGE(PG8_SA(1, 0), a3, v2[0]);
            PG8_WAIT_V(8); PG8_WAIT_L(0); PG8_BAR; PG8_MMA(1, 0, At, B0); PG8_MMA(1, 1, At, B1); PG8_BAR; PG8_SCHED;
        }
        if (wr == 0) PG8_BAR;
        if constexpr (FP8) asm volatile("s_nop 15\n\ts_nop 15\n\ts_nop 15" ::: "memory");
        E(acc, cur, wr, wc, fr, fq);
        if (!has_next) break;
#pragma unroll
        for (int a = 0; a < 2; ++a)
#pragma unroll
            for (int b = 0; b < 2; ++b)
#pragma unroll
                for (int m = 0; m < 4; ++m)
#pragma unroll
                    for (int n = 0; n < 2; ++n) acc[a][b][m][n] = (f32x4){0.f, 0.f, 0.f, 0.f};
        cur = nxt; cA = nA; cB = nB; ++ui;
        if constexpr (GATHER) {
#pragma unroll
            for (int h = 0; h < 2; ++h)
#pragma unroll
                for (int i = 0; i < 2; ++i) va[h][i] = vn[h][i];
        }
        if (wr == 1) PG8_BAR;
    }
    PG8_WAIT_V(0);
    PG8_BAR;
#undef PG8_SA
#undef PG8_SB
#undef PG8_STAGE
#undef PG8_LDA
#undef PG8_LDB
#undef PG8_MMA
#undef PG8_LD1
#undef PG8_WAIT_V
#undef PG8_WAIT_L
#undef PG8_BAR
#undef PG8_SCHED
}

struct StaticOrder {
    const char* A; const char* B; size_t a_tile, b_tile;
    int nM, nN, nwg, G, c;
    __device__ __forceinline__ void init(const void* A_, int lda, const void* B_, int K, int N, int G_, int c_) {
        A = (const char*)A_; B = (const char*)B_; a_tile = (size_t)256 * lda * 2; b_tile = (size_t)256 * K * 2; nM = NTOK / BM; nN = N / BM; nwg = nM * nN; G = G_; c = c_; }
    __device__ __forceinline__ bool next(int i, Unit& u) const {
        const long L = (long)i * G + c; if (L >= nwg) return false;
        int wgid = (int)L; { const int q = nwg / 8, r = nwg % 8, xcd = wgid % 8, off = wgid / 8; wgid = (xcd < r ? xcd * (q + 1) : r * (q + 1) + (xcd - r) * q) + off; }
        const int nig = 8 * nN, gid = wgid / nig, fm = gid * 8, gsz = (nM - fm) < 8 ? (nM - fm) : 8;
        u.pm = fm + ((wgid % nig) % gsz); u.pn = (wgid % nig) / gsz; u.e = 0; u.slot0 = 0; u.cnt = 0; u.tag = 0;
        u.A = A + (size_t)u.pm * a_tile; u.B = B + (size_t)u.pn * b_tile; return true;
    }
    __device__ __forceinline__ unsigned voff(const Unit&, int, int) const { return 0u; }
};
}
using pg8::Unit; using pg8::Acc;

#define ACC8(acc, ai, bj, m, v0, v1) const f32x4 v0 = acc[ai][bj][m][0], v1 = acc[ai][bj][m][1]
#define EPI_ROWS(u, wr, fr) const int row0 = (u).pm * 256 + (wr) * 64 + (fr)
__device__ __forceinline__ void rope8(f32x4& v0, f32x4& v1, const f32x4 cs, const f32x4 sn) {
    const float a0 = v0[0] * cs[0] - v0[1] * sn[0], b0 = v0[1] * cs[0] + v0[0] * sn[0];
    const float a1 = v0[2] * cs[1] - v0[3] * sn[1], b1 = v0[3] * cs[1] + v0[2] * sn[1];
    const float a2 = v1[0] * cs[2] - v1[1] * sn[2], b2 = v1[1] * cs[2] + v1[0] * sn[2];
    const float a3 = v1[2] * cs[3] - v1[3] * sn[3], b3 = v1[3] * cs[3] + v1[2] * sn[3];
    v0 = (f32x4){a0, b0, a1, b1}; v1 = (f32x4){a2, b2, a3, b3};
}
struct EpiIn {
    static constexpr bool PERM16 = false; static constexpr int MID_T = -1;
    h16* qa; h16* krope; h16* dil; h16* gates; float* rowsq; const float* cosd; const float* sind; const float* cosm; const float* sinm;
    __device__ __forceinline__ void operator()(const Acc& acc, const Unit& u, int wr, int wc, int fr, int fq) const {
        asm volatile("" : "+v"(fr), "+v"(fq));
        EPI_ROWS(u, wr, fr); const int pn = u.pn, colin = wc * 32 + 8 * fq;
        constexpr float WS_ = 1.0f / SC_GU;
        if (pn < 4) {
#pragma unroll
            for (int ai = 0; ai < 2; ++ai)
#pragma unroll
                for (int m = 0; m < 4; ++m) { const int row = row0 + ai * 128 + m * 16; float ss = 0.f;
#pragma unroll
                    for (int bj = 0; bj < 2; ++bj) { const f32x4 v0 = acc[ai][bj][m][0] * WS_, v1 = acc[ai][bj][m][1] * WS_;
                        ss += (v0[0] * v0[0] + v0[1] * v0[1]) + (v0[2] * v0[2] + v0[3] * v0[3]) + (v1[0] * v1[0] + v1[1] * v1[1]) + (v1[2] * v1[2] + v1[3] * v1[3]);
                        *(u32x4*)(qa + (size_t)row * 1024 + pn * 256 + bj * 128 + colin) = pk8(v0, v1); }
                    ss += __shfl_xor(ss, 16); ss += __shfl_xor(ss, 32);
                    if (fq == 0) rowsq[(size_t)row * 16 + pn * 4 + wc] = ss; }
        } else if (pn == 4) {
            if (wc < 2) {
                u32x4 pk[2][4];
#pragma unroll
                for (int ai = 0; ai < 2; ++ai) {
                    f32x4 cs[4], sn[4];
#pragma unroll
                    for (int m = 0; m < 4; ++m) { const int row = row0 + ai * 128 + m * 16;
                        cs[m] = *(const f32x4*)(cosm + (size_t)row * 32 + 16 * wc + 4 * fq); sn[m] = *(const f32x4*)(sinm + (size_t)row * 32 + 16 * wc + 4 * fq); }
                    __builtin_amdgcn_sched_barrier(0);
#pragma unroll
                    for (int m = 0; m < 4; ++m) { f32x4 v0 = acc[ai][0][m][0] * WS_, v1 = acc[ai][0][m][1] * WS_; rope8(v0, v1, cs[m], sn[m]); pk[ai][m] = pk8(v0, v1); }
                    __builtin_amdgcn_sched_barrier(0);
                }
#pragma unroll
                for (int ai = 0; ai < 2; ++ai)
#pragma unroll
                    for (int m = 0; m < 4; ++m) { const int row = row0 + ai * 128 + m * 16; *(u32x4*)(krope + (size_t)row * 64 + colin) = pk[ai][m]; }
            }
        } else if (pn < 23) {
            const int part = (pn - 5) / 6; const bool rope = (part < 2 && wc == 0);
            const float sc_ = (part == 0) ? WS_ * QS_D : WS_;
            if (rope) {
                u32x4 pk[2][4][2];
#pragma unroll
                for (int ai = 0; ai < 2; ++ai) {
                    f32x4 cs[4], sn[4];
#pragma unroll
                    for (int m = 0; m < 4; ++m) { const int row = row0 + ai * 128 + m * 16;
                        cs[m] = *(const f32x4*)(cosd + (size_t)row * 16 + 4 * fq); sn[m] = *(const f32x4*)(sind + (size_t)row * 16 + 4 * fq); }
                    __builtin_amdgcn_sched_barrier(0);
#pragma unroll
                    for (int m = 0; m < 4; ++m)
#pragma unroll
                        for (int bj = 0; bj < 2; ++bj) { f32x4 v0 = acc[ai][bj][m][0] * sc_, v1 = acc[ai][bj][m][1] * sc_; rope8(v0, v1, cs[m], sn[m]); pk[ai][m][bj] = pk8(v0, v1); }
                    __builtin_amdgcn_sched_barrier(0);
                }
                __builtin_amdgcn_sched_barrier(0);
                int row0s = row0; asm volatile("" : "+v"(row0s));
#pragma unroll
                for (int ai = 0; ai < 2; ++ai)
#pragma unroll
                    for (int m = 0; m < 4; ++m) { const int row = row0s + ai * 128 + m * 16;
#pragma unroll
                        for (int bj = 0; bj < 2; ++bj) *(u32x4*)(dil + (size_t)row * 4608 + (pn - 5) * 256 + bj * 128 + colin) = pk[ai][m][bj]; }
            } else {
#pragma unroll
                for (int ai = 0; ai < 2; ++ai)
#pragma unroll
                    for (int m = 0; m < 4; ++m) { const int row = row0 + ai * 128 + m * 16;
#pragma unroll
                        for (int bj = 0; bj < 2; ++bj)
                            *(u32x4*)(dil + (size_t)row * 4608 + (pn - 5) * 256 + bj * 128 + colin) = pk8(acc[ai][bj][m][0] * sc_, acc[ai][bj][m][1] * sc_); }
            }
        } else {
#pragma unroll
            for (int ai = 0; ai < 2; ++ai)
#pragma unroll
                for (int m = 0; m < 4; ++m) { const int row = row0 + ai * 128 + m * 16;
#pragma unroll
                    for (int bj = 0; bj < 2; ++bj) { f32x4 v0 = acc[ai][bj][m][0] * WS_, v1 = acc[ai][bj][m][1] * WS_;
#pragma unroll
                        for (int j = 0; j < 4; ++j) { v0[j] = sigmoidf_(v0[j]); v1[j] = sigmoidf_(v1[j]); }
                        *(u32x4*)(gates + (size_t)row * 4096 + (pn - 23) * 256 + bj * 128 + colin) = pk8(v0, v1); } }
        }
    }
};
struct EpiUp {
    static constexpr bool PERM16 = false; static constexpr int MID_T = -1;
    h16* qm; h16* kv; const float* rowsq; const float* cosm; const float* sinm;
    __device__ __forceinline__ void operator()(const Acc& acc, const Unit& u, int wr, int wc, int fr, int fq) const {
        asm volatile("" : "+v"(fr), "+v"(fq));
        EPI_ROWS(u, wr, fr); const int pn = u.pn, colin = wc * 32 + 8 * fq; const bool rope = (u.tag == 0 && pn >= 4);
        float rs[2][4];
        {   f32x4 s0[2][4], s1[2][4];
#pragma unroll
            for (int ai = 0; ai < 2; ++ai)
#pragma unroll
                for (int m = 0; m < 4; ++m) { const int row = row0 + ai * 128 + m * 16;
                    s0[ai][m] = *(const f32x4*)(rowsq + (size_t)row * 16 + u.tag * 8); s1[ai][m] = *(const f32x4*)(rowsq + (size_t)row * 16 + u.tag * 8 + 4); }
            __builtin_amdgcn_sched_barrier(0);
#pragma unroll
            for (int ai = 0; ai < 2; ++ai)
#pragma unroll
                for (int m = 0; m < 4; ++m) { const float ss = ((s0[ai][m][0] + s0[ai][m][1]) + (s0[ai][m][2] + s0[ai][m][3])) + ((s1[ai][m][0] + s1[ai][m][1]) + (s1[ai][m][2] + s1[ai][m][3]));
                    rs[ai][m] = __builtin_amdgcn_rsqf(ss * (1.0f / 512.0f) + EPS) * (u.tag == 0 ? QS_M : 1.0f); } }
        u32x4 pk[2][4][2];
        if (rope) {
#pragma unroll
            for (int ai = 0; ai < 2; ++ai) {
                f32x4 cs[4], sn[4];
#pragma unroll
                for (int m = 0; m < 4; ++m) { const int row = row0 + ai * 128 + m * 16;
                    cs[m] = *(const f32x4*)(cosm + (size_t)row * 32 + 16 * (wc & 1) + 4 * fq); sn[m] = *(const f32x4*)(sinm + (size_t)row * 32 + 16 * (wc & 1) + 4 * fq); }
                __builtin_amdgcn_sched_barrier(0);
#pragma unroll
                for (int m = 0; m < 4; ++m)
#pragma unroll
                    for (int bj = 0; bj < 2; ++bj) { f32x4 v0 = acc[ai][bj][m][0] * rs[ai][m], v1 = acc[ai][bj][m][1] * rs[ai][m]; rope8(v0, v1, cs[m], sn[m]); pk[ai][m][bj] = pk8(v0, v1); }
                __builtin_amdgcn_sched_barrier(0);
            }
        } else {
#pragma unroll
            for (int ai = 0; ai < 2; ++ai)
#pragma unroll
                for (int m = 0; m < 4; ++m)
#pragma unroll
                    for (int bj = 0; bj < 2; ++bj) pk[ai][m][bj] = pk8(acc[ai][bj][m][0] * rs[ai][m], acc[ai][bj][m][1] * rs[ai][m]);
        }
        __builtin_amdgcn_sched_barrier(0);
        int row0s = row0; asm volatile("" : "+v"(row0s));
#pragma unroll
        for (int ai = 0; ai < 2; ++ai)
#pragma unroll
            for (int m = 0; m < 4; ++m) { const int row = row0s + ai * 128 + m * 16;
#pragma unroll
                for (int bj = 0; bj < 2; ++bj) {
                    if (u.tag == 0) *(u32x4*)(qm + (size_t)row * 1536 + pn * 256 + bj * 128 + colin) = pk[ai][m][bj];
                    else *(u32x4*)(kv + (size_t)row * 2048 + pn * 256 + bj * 128 + colin) = pk[ai][m][bj]; } }
    }
};
__device__ __forceinline__ void unpk8(const u32x4 w, f32x4& a, f32x4& b) {
    const h16x8 h = __builtin_bit_cast(h16x8, w);
    a = (f32x4){(float)h[0], (float)h[1], (float)h[2], (float)h[3]}; b = (f32x4){(float)h[4], (float)h[5], (float)h[6], (float)h[7]};
}
template <int MODE> struct EpiOut {
    static constexpr bool PERM16 = (MODE == 3); static constexpr int MID_T = -1;
    h16* out; int ldc; const h16* gate; int ldg; const h16* add; float scale;
    __device__ __forceinline__ void operator()(const Acc& acc, const Unit& u, int wr, int wc, int fr, int fq) const {
        asm volatile("" : "+v"(fr), "+v"(fq));
        EPI_ROWS(u, wr, fr); const int col0 = u.pn * 256 + wc * 32 + 8 * fq;
#pragma unroll
        for (int ai = 0; ai < 2; ++ai) {
            u32x4 gv[4][2], av[4][2];
            if (MODE == 1 || MODE == 2) {
#pragma unroll
                for (int m = 0; m < 4; ++m)
#pragma unroll
                    for (int bj = 0; bj < 2; ++bj) { const int row = row0 + ai * 128 + m * 16;
                        gv[m][bj] = *(const u32x4*)(gate + (size_t)row * ldg + col0 + bj * 128);
                        if (MODE == 2) av[m][bj] = *(const u32x4*)(add + (size_t)row * ldc + col0 + bj * 128); }
                __builtin_amdgcn_sched_barrier(0);
            }
#pragma unroll
            for (int m = 0; m < 4; ++m) { const int row = row0 + ai * 128 + m * 16;
                if (MODE == 3) {
                    const f32x4 a0 = acc[ai][0][m][0] * scale, a1 = acc[ai][0][m][1] * scale, b0 = acc[ai][1][m][0] * scale, b1 = acc[ai][1][m][1] * scale;
                    u32x4 w; w.x = pk4_fp8(a0[0], a0[1], a0[2], a0[3]); w.y = pk4_fp8(a1[0], a1[1], a1[2], a1[3]); w.z = pk4_fp8(b0[0], b0[1], b0[2], b0[3]); w.w = pk4_fp8(b1[0], b1[1], b1[2], b1[3]);
                    *(u32x4*)((unsigned char*)out + (size_t)row * ldc + u.pn * 256 + wc * 64 + 16 * fq) = w;
                    continue; }
#pragma unroll
                for (int bj = 0; bj < 2; ++bj) { f32x4 v0 = acc[ai][bj][m][0], v1 = acc[ai][bj][m][1];
                    if (MODE == 0) { v0 *= scale; v1 *= scale; }
                    if (MODE == 1 || MODE == 2) { f32x4 g0, g1; unpk8(gv[m][bj], g0, g1); v0 *= g0; v1 *= g1; }
                    if (MODE == 2) { f32x4 a0, a1; unpk8(av[m][bj], a0, a1); v0 += a0; v1 += a1; }
                    *(u32x4*)(out + (size_t)row * ldc + col0 + bj * 128) = pk8(v0, v1); } }
        }
    }
};
struct EpiMerge {
    static constexpr bool PERM16 = false; static constexpr int MID_T = 16;
    h16* out; const h16* gate;
    __device__ __forceinline__ void mid(Acc& acc, const Unit& u, int wr, int wc, int fr, int fq) const {
        asm volatile("" : "+v"(fr), "+v"(fq));
        EPI_ROWS(u, wr, fr); const int col0 = u.pn * 256 + wc * 32 + 8 * fq;
#pragma unroll
        for (int ai = 0; ai < 2; ++ai) {
            u32x4 ga[4][2], gb[4][2];
#pragma unroll
            for (int m = 0; m < 4; ++m)
#pragma unroll
                for (int bj = 0; bj < 2; ++bj) { const int row = row0 + ai * 128 + m * 16;
                    ga[m][bj] = *(const u32x4*)(gate + (size_t)row * 4096 + col0 + bj * 128); gb[m][bj] = *(const u32x4*)(gate + (size_t)row * 4096 + 2048 + col0 + bj * 128); }
            __builtin_amdgcn_sched_barrier(0);
#pragma unroll
            for (int m = 0; m < 4; ++m)
#pragma unroll
                for (int bj = 0; bj < 2; ++bj) { f32x4 a0, a1, b0, b1; unpk8(ga[m][bj], a0, a1); unpk8(gb[m][bj], b0, b1);
#pragma unroll
                    for (int j = 0; j < 4; ++j) { acc[ai][bj][m][0][j] *= a0[j] * __builtin_amdgcn_rcpf(fmaxf(b0[j], 6.2e-5f)); acc[ai][bj][m][1][j] *= a1[j] * __builtin_amdgcn_rcpf(fmaxf(b1[j], 6.2e-5f)); } }
        }
    }
    __device__ __forceinline__ void operator()(Acc& acc, const Unit& u, int wr, int wc, int fr, int fq) const {
        asm volatile("" : "+v"(fr), "+v"(fq));
        EPI_ROWS(u, wr, fr); const int col0 = u.pn * 256 + wc * 32 + 8 * fq;
#pragma unroll
        for (int ai = 0; ai < 2; ++ai) {
            u32x4 gb[4][2];
#pragma unroll
            for (int m = 0; m < 4; ++m)
#pragma unroll
                for (int bj = 0; bj < 2; ++bj) { const int row = row0 + ai * 128 + m * 16; gb[m][bj] = *(const u32x4*)(gate + (size_t)row * 4096 + 2048 + col0 + bj * 128); }
            __builtin_amdgcn_sched_barrier(0);
#pragma unroll
            for (int m = 0; m < 4; ++m)
#pragma unroll
                for (int bj = 0; bj < 2; ++bj) { f32x4 b0, b1; unpk8(gb[m][bj], b0, b1);
#pragma unroll
                    for (int j = 0; j < 4; ++j) { b0[j] = fmaxf(b0[j], 6.2e-5f); b1[j] = fmaxf(b1[j], 6.2e-5f); }
                    acc[ai][bj][m][0] *= b0; acc[ai][bj][m][1] *= b1; }
        }
        __builtin_amdgcn_sched_barrier(0);
#pragma unroll
        for (int ai = 0; ai < 2; ++ai)
#pragma unroll
            for (int m = 0; m < 4; ++m) { const int row = row0 + ai * 128 + m * 16;
#pragma unroll
                for (int bj = 0; bj < 2; ++bj) { const f32x4 r0 = acc[ai][bj][m][0], r1 = acc[ai][bj][m][1]; u32x2 w; w.x = pk4_fp8(r0[0], r0[1], r0[2], r0[3]); w.y = pk4_fp8(r1[0], r1[1], r1[2], r1[3]);
                    *(u32x2*)((unsigned char*)out + (size_t)row * DM + col0 + bj * 128) = w; } }
    }
};
struct EpiSwiglu {
    static constexpr bool PERM16 = false; static constexpr int MID_T = -1;
    unsigned char* act;
    __device__ __forceinline__ void operator()(const Acc& acc, const Unit& u, int wr, int wc, int fr, int fq) const {
        asm volatile("" : "+v"(fr), "+v"(fq));
        EPI_ROWS(u, wr, fr); const int col0 = u.pn * 128 + wc * 32 + 8 * fq;
#pragma unroll
        for (int ai = 0; ai < 2; ++ai)
#pragma unroll
            for (int m = 0; m < 4; ++m) { const int row = row0 + ai * 128 + m * 16;
                f32x4 g0 = acc[ai][0][m][0] * (1.0f / SC_GU), g1 = acc[ai][0][m][1] * (1.0f / SC_GU); const f32x4 u0 = acc[ai][1][m][0] * (1.0f / SC_GU), u1 = acc[ai][1][m][1] * (1.0f / SC_GU);
#pragma unroll
                for (int j = 0; j < 4; ++j) { g0[j] = g0[j] * sigmoidf_(g0[j]) * u0[j]; g1[j] = g1[j] * sigmoidf_(g1[j]) * u1[j]; }
                u32x2 w; w.x = pk4_fp8(g0[0], g0[1], g0[2], g0[3]); w.y = pk4_fp8(g1[0], g1[1], g1[2], g1[3]);
                *(u32x2*)(act + (size_t)row * 512 + col0) = w; }
    }
};

struct UpOrder {
    const char* qa; const char* wq; const char* wkv; int G, c;
    __device__ __forceinline__ bool next(int i, Unit& u) const {
        const int L = i * G + c; if (L >= 896) return false;
        u.e = 0; u.slot0 = 0; u.cnt = 0;
        if (L < 384) { u.pm = L / 6; u.pn = L % 6; u.tag = 0; u.A = qa + (size_t)u.pm * 256 * 2048; u.B = wq + (size_t)u.pn * 256 * 1024; }
        else { const int l = L - 384; u.pm = l >> 3; u.pn = l & 7; u.tag = 1; u.A = qa + (size_t)u.pm * 256 * 2048 + 1024; u.B = wkv + (size_t)u.pn * 256 * 1024; }
        return true;
    }
    __device__ __forceinline__ unsigned voff(const Unit&, int, int) const { return 0u; }
};
__device__ __forceinline__ void moe_tables(const Frame& F, const unsigned* cnt) {
    LAS int* tstart = (LAS int*)(F.lds + LDS_TAB); LAS int* cnts = (LAS int*)(F.lds + LDS_TAB + 512); LAS int* tmap = (LAS int*)(F.lds + LDS_TAB + 1024);
    __syncthreads();
    if (F.tid < 65) cnts[F.tid] = F.tid < 64 ? (int)__hip_atomic_load(cnt + 64 * F.tid, __ATOMIC_RELAXED, __HIP_MEMORY_SCOPE_AGENT) : NTOK;
    __syncthreads();
    if (F.tid == 0) { int s = 0; for (int e = 0; e < 65; ++e) { tstart[e] = s; s += (cnts[e] + 255) >> 8; } tstart[65] = s; }
    __syncthreads();
    { int e = 0; for (int j = 1; j < 65; ++j) e += (tstart[j] <= F.tid) ? 1 : 0; tmap[F.tid] = (F.tid < tstart[65]) ? e : 255; }
    __syncthreads();
}
template <int NPN, bool GU> struct MoeOrder {
    const LAS int* tstart; const LAS int* cnts; const LAS int* tmap; const char* A; const char* W; const unsigned* list; int G, c;
    __device__ __forceinline__ bool next(int i, Unit& u) const {
        const int T = __builtin_amdgcn_readfirstlane(tstart[65]); int L;
        if (G == 256) { const int U8 = (T * NPN + 7) >> 3, q = i * 32 + (c & 31); if (q >= U8) return false; L = (c >> 5) * U8 + q; }
        else L = i * G + c;
        const int mt = L / NPN;
        if (mt >= T) return false;
        const int e = __builtin_amdgcn_readfirstlane(tmap[mt]);
        u.pm = mt; u.pn = L % NPN; u.e = e; u.slot0 = (mt - __builtin_amdgcn_readfirstlane(tstart[e])) * 256; u.cnt = __builtin_amdgcn_readfirstlane(cnts[e]); u.tag = 0;
        if (GU) { u.A = A; u.B = W + (size_t)e * (1024 * 2048) + (size_t)u.pn * (256 * 2048); }
        else { u.A = A + (size_t)mt * (256 * 512); u.B = W + (size_t)e * (2048 * 512) + (size_t)u.pn * (256 * 512); }
        return true;
    }
    __device__ __forceinline__ unsigned voff(const Unit& u, int row, int col) const {
        const int slot = u.slot0 + row; unsigned tok;
        if (u.e == 64) tok = (unsigned)slot; else tok = slot < u.cnt ? list[(size_t)u.e * LISTCAP + slot] : 0u;
        return tok * 2048u + (unsigned)col * 2u;
    }
};

namespace att {
constexpr int KVBLK = 64, SHM_K = 16384, SHM_V = 16384, SHM_KR = 8192;
template <bool MLA> struct Lay { static constexpr int NB = MLA ? 2 : 4, OFF_V = 0, OFF_K = NB * SHM_V, OFF_KR = OFF_K + NB * SHM_K, OFF_WS = OFF_KR + (MLA ? NB * SHM_KR : 0), OFF_QR = OFF_WS + 2048; };
constexpr float THR2 = 11.5f;
#define KSWZ(row, colB) ((row) * 256 + ((colB) ^ (((row) & 7) << 4)))
#define RSWZ(row, colB) ((row) * 128 + ((colB) ^ (((row) & 7) << 4)))
#define SBAR() __builtin_amdgcn_sched_barrier(0)
__device__ __forceinline__ int v_st(int k, int c) { const int kk = (k & ~0xC) | ((k & 4) << 1) | ((k & 8) >> 1); return ((kk >> 3) * 4 + (c >> 5)) * 512 + ((kk & 7) * 32 + (c & 31)) * 2; }
__device__ __forceinline__ int v_rd_base(int lane) { return ((lane & 3) << 3) | (((lane >> 2) & 3) << 6) | (((lane >> 4) & 1) << 5) | (((lane >> 5) & 1) << 8); }
constexpr int v_rd_off(int d0, int ks, int half) { return d0 * 512 + ks * 4096 + half * 2048; }
__device__ __forceinline__ int crow(int r, int hi) { return (r & 3) + 8 * (r >> 2) + 4 * hi; }
__device__ __forceinline__ void mask_tile(f32x16& p0, f32x16& p1, int dq, unsigned W) {
    const float NEG = -__builtin_inff();
#pragma unroll
    for (int r = 0; r < 16; ++r) {
        const int c = (r & 3) + 8 * (r >> 2);
        if ((unsigned)(dq - c) >= W) p0[r] = NEG;
        if ((unsigned)(dq - c - 32) >= W) p1[r] = NEG;
    }
}
__device__ __forceinline__ void softmax_tile(f32x16& p0, f32x16& p1, float& m_reg, float& l_reg, float& alpha, h16x8& pa0, h16x8& pa1, h16x8& pa2, h16x8& pa3) {
    float pmax = p0[0];
#pragma unroll
    for (int r = 1; r < 16; ++r) pmax = fmaxf(pmax, p0[r]);
#pragma unroll
    for (int r = 0; r < 16; ++r) pmax = fmaxf(pmax, p1[r]);
    { auto rr = __builtin_amdgcn_permlane32_swap(__float_as_uint(pmax), __float_as_uint(pmax), false, false);
      pmax = fmaxf(__uint_as_float(rr[0]), __uint_as_float(rr[1])); }
    float mn;
    if (__all((pmax - m_reg) <= THR2)) { mn = m_reg; alpha = 1.f; }
    else { mn = fmaxf(m_reg, pmax); alpha = __builtin_amdgcn_exp2f(m_reg - mn); m_reg = mn; }
#pragma unroll
    for (int r = 0; r < 16; ++r) { p0[r] = __builtin_amdgcn_exp2f(p0[r] - mn); p1[r] = __builtin_amdgcn_exp2f(p1[r] - mn); }
    float ps = 0;
#pragma unroll
    for (int r = 0; r < 16; ++r) ps += p0[r];
#pragma unroll
    for (int r = 0; r < 16; ++r) ps += p1[r];
    { auto rr = __builtin_amdgcn_permlane32_swap(__float_as_uint(ps), __float_as_uint(ps), false, false);
      ps = __uint_as_float(rr[0]) + __uint_as_float(rr[1]); }
    l_reg = l_reg * alpha + ps;
#define PK4(P, B_, OUT) do { unsigned a0 = pkh(P[B_+0], P[B_+1]), a1 = pkh(P[B_+2], P[B_+3]);                          \
        unsigned b0 = pkh(P[B_+4], P[B_+5]), b1 = pkh(P[B_+6], P[B_+7]);                                             \
        auto r0 = __builtin_amdgcn_permlane32_swap(a0, b0, false, false); auto r1 = __builtin_amdgcn_permlane32_swap(a1, b1, false, false); \
        u32x4 w = {r0[0], r1[0], r0[1], r1[1]}; OUT = __builtin_bit_cast(h16x8, w); } while (0)
    PK4(p0, 0, pa0); PK4(p0, 8, pa1); PK4(p1, 0, pa2); PK4(p1, 8, pa3);
#undef PK4
}
struct AUnit {
    const char* Q; const char* QR;
    const char* K; const char* V;
    const char* KR;
    char* O;
    float* LSE;
    unsigned qs, kvs, krs, os, ls;
    int P0, jlo, jhi; unsigned W;
};
template <bool MLA>
__device__ __forceinline__ void attn_unit(LAS unsigned char* lds, const AUnit& u) {
    const int tid = threadIdx.x, wid = __builtin_amdgcn_readfirstlane(tid >> 6), lane = tid & 63, r32 = lane & 31, hi = lane >> 5;
    typedef Lay<MLA> L; constexpr int NB = L::NB, PER_TILE = MLA ? 5 : 4;
    LAS unsigned char* V_lds = lds + L::OFF_V; LAS unsigned char* K_lds = lds + L::OFF_K; LAS unsigned char* R_lds = lds + L::OFF_KR;
    LAS float* wsf = (LAS float*)(lds + L::OFF_WS) + wid * 64;
    LAS unsigned char* QRl = lds + L::OFF_QR + wid * 4096 + lane * 16;
    const int qlo = u.P0 + wid * 32, qm = qlo + r32 - 4 * hi;
    unsigned ko[2], vo[2], kro = 0u;
#pragma unroll
    for (int i = 0; i < 2; ++i) { const int p = (wid * 2 + i) * 64 + lane;
        { const int row = p >> 4, pc = p & 15; ko[i] = (unsigned)row * u.kvs + (unsigned)((pc ^ (row & 7)) << 4); }
        { const int cc = (p & 3) | (((p >> 5) & 3) << 2), kk = ((p >> 2) & 7) | ((p >> 7) << 3), k = (kk & ~0xC) | ((kk & 4) << 1) | ((kk & 8) >> 1);
          vo[i] = (unsigned)k * u.kvs + (unsigned)cc * 16u; } }
    if constexpr (MLA) { const int p = wid * 64 + lane, row = p >> 3, pc = p & 7; kro = (unsigned)row * u.krs + (unsigned)((pc ^ (row & 7)) << 4); }
#define ST_ISSUE(t, bf) do { const size_t tb_ = (size_t)(t) * KVBLK * u.kvs; const char* Kt_ = u.K + tb_; const char* Vt_ = u.V + tb_; \
        _Pragma("unroll") for (int i_ = 0; i_ < 2; ++i_) { \
            __builtin_amdgcn_global_load_lds((const unsigned*)(Kt_ + ko[i_]), (LAS unsigned*)(K_lds + (bf) * SHM_K + (wid * 2 + i_) * 1024), 16, 0, 0); \
            __builtin_amdgcn_global_load_lds((const unsigned*)(Vt_ + vo[i_]), (LAS unsigned*)(V_lds + (bf) * SHM_V + (wid * 2 + i_) * 1024), 16, 0, 0); } \
        if constexpr (MLA) __builtin_amdgcn_global_load_lds((const unsigned*)(u.KR + (size_t)(t) * KVBLK * u.krs + kro), (LAS unsigned*)(R_lds + (bf) * SHM_KR + wid * 1024), 16, 0, 0); } while (0)
    __syncthreads();
#pragma unroll
    for (int i = 0; i < NB - 1; ++i) if (u.jlo + i < u.jhi) ST_ISSUE(u.jlo + i, i);
    h16x8 qr[8];
    { const unsigned qo = (unsigned)(wid * 32 + r32) * u.qs + (unsigned)hi * 16u;
#pragma unroll
      for (int d0 = 0; d0 < 8; ++d0) qr[d0] = *(const h16x8*)(u.Q + d0 * 32 + qo);
      if constexpr (MLA) {
#pragma unroll
        for (int d0 = 0; d0 < 4; ++d0) *(LAS h16x8*)(QRl + d0 * 1024) = *(const h16x8*)(u.QR + d0 * 32 + qo); } }
    float m_reg = -1e30f, l_reg = 0.f; f32x16 o[4];
#pragma unroll
    for (int d = 0; d < 4; ++d)
#pragma unroll
        for (int r = 0; r < 16; ++r) o[d][r] = 0.f;
    const int vbb = (int)(uintptr_t)V_lds + v_rd_base(lane);
    for (int t = u.jlo; t < u.jhi; ++t) {
        const int bf = (t - u.jlo) & (NB - 1);
        if constexpr (NB == 4) { if (t + 2 < u.jhi) asm volatile("s_waitcnt vmcnt(8)" ::: "memory"); else if (t + 1 < u.jhi) asm volatile("s_waitcnt vmcnt(4)" ::: "memory"); else asm volatile("s_waitcnt vmcnt(0)" ::: "memory"); }
        else asm volatile("s_waitcnt vmcnt(0)" ::: "memory");
        __syncthreads();
        if (t + NB - 1 < u.jhi) ST_ISSUE(t + NB - 1, (bf + NB - 1) & (NB - 1));
        const int vb0 = vbb + bf * SHM_V;
        const int kb = t * KVBLK;
        const bool act = (kb <= qlo + 31) && ((long)kb + KVBLK - 1 >= (long)qlo - (long)(u.W - 1));
        if (act) {
            f32x16 p0, p1;
#pragma unroll
            for (int r = 0; r < 16; ++r) { p0[r] = 0.f; p1[r] = 0.f; }
            {   const LAS unsigned char* kbp[4];
#pragma unroll
                for (int dd = 0; dd < 4; ++dd) kbp[dd] = K_lds + bf * SHM_K + KSWZ(r32, (dd * 16 + hi * 8) * 2);
#pragma unroll
                for (int d0 = 0; d0 < 8; ++d0) { const LAS unsigned char* a = kbp[d0 & 3] + (d0 >> 2) * 128;
                    const h16x8 b0 = *(const LAS h16x8*)a, b1 = *(const LAS h16x8*)(a + 32 * 256);
                    p0 = __builtin_amdgcn_mfma_f32_32x32x16_f16(b0, qr[d0], p0, 0, 0, 0);
                    p1 = __builtin_amdgcn_mfma_f32_32x32x16_f16(b1, qr[d0], p1, 0, 0, 0); }
                if constexpr (MLA) {
#pragma unroll
                    for (int d0 = 0; d0 < 4; ++d0) { const LAS unsigned char* a = R_lds + bf * SHM_KR + RSWZ(r32, (d0 * 16 + hi * 8) * 2);
                        const h16x8 b0 = *(const LAS h16x8*)a, b1 = *(const LAS h16x8*)(a + 32 * 128); const h16x8 qf = *(const LAS h16x8*)(QRl + d0 * 1024);
                        p0 = __builtin_amdgcn_mfma_f32_32x32x16_f16(b0, qf, p0, 0, 0, 0);
                        p1 = __builtin_amdgcn_mfma_f32_32x32x16_f16(b1, qf, p1, 0, 0, 0); }
                }
            }
            if (kb + KVBLK - 1 > qlo || (long)kb <= (long)qlo + 31 - (long)u.W) mask_tile(p0, p1, qm - kb, u.W);
            float alpha; h16x8 pa0, pa1, pa2, pa3;
            softmax_tile(p0, p1, m_reg, l_reg, alpha, pa0, pa1, pa2, pa3);
            if (__any(alpha < 1.f)) {
                if (hi == 0) wsf[r32] = alpha;
                LDS_WAIT();
#pragma unroll
                for (int r = 0; r < 16; ++r) { const float a_ = wsf[crow(r, hi)];
#pragma unroll
                    for (int d = 0; d < 4; ++d) o[d][r] *= a_; }
            }
#define TRRD(dst, off) asm volatile("ds_read_b64_tr_b16 %0, %1 offset:%2" : "=&v"(dst) : "v"(vb0), "i"(off) : "memory")
#define PV_D0(VB, d0) do { s16x4 l0, l1, l2, l3, h0, h1, h2, h3; constexpr int b_ = (VB) * SHM_V + v_rd_off(d0, 0, 0); \
        TRRD(l0, b_); TRRD(h0, b_ + 2048); TRRD(l1, b_ + 4096); TRRD(h1, b_ + 6144); TRRD(l2, b_ + 8192); TRRD(h2, b_ + 10240); TRRD(l3, b_ + 12288); TRRD(h3, b_ + 14336); \
        asm volatile("s_waitcnt lgkmcnt(0)" ::: "memory"); SBAR(); \
        o[d0] = __builtin_amdgcn_mfma_f32_32x32x16_f16(pa0, __builtin_bit_cast(h16x8, (short __attribute__((ext_vector_type(8)))){l0[0], l0[1], l0[2], l0[3], h0[0], h0[1], h0[2], h0[3]}), o[d0], 0, 0, 0); \
        o[d0] = __builtin_amdgcn_mfma_f32_32x32x16_f16(pa1, __builtin_bit_cast(h16x8, (short __attribute__((ext_vector_type(8)))){l1[0], l1[1], l1[2], l1[3], h1[0], h1[1], h1[2], h1[3]}), o[d0], 0, 0, 0); \
        o[d0] = __builtin_amdgcn_mfma_f32_32x32x16_f16(pa2, __builtin_bit_cast(h16x8, (short __attribute__((ext_vector_type(8)))){l2[0], l2[1], l2[2], l2[3], h2[0], h2[1], h2[2], h2[3]}), o[d0], 0, 0, 0); \
        o[d0] = __builtin_amdgcn_mfma_f32_32x32x16_f16(pa3, __builtin_bit_cast(h16x8, (short __attribute__((ext_vector_type(8)))){l3[0], l3[1], l3[2], l3[3], h3[0], h3[1], h3[2], h3[3]}), o[d0], 0, 0, 0); } while (0)
            PV_D0(0, 0); PV_D0(0, 1); PV_D0(0, 2); PV_D0(0, 3);
#undef PV_D0
#undef TRRD
        }
    }
#undef ST_ISSUE
    if (hi == 0) wsf[32 + r32] = l_reg;
    LDS_WAIT();
    if (u.LSE && hi == 0) u.LSE[(unsigned)(wid * 32 + r32) * u.ls] = m_reg + __builtin_amdgcn_logf(l_reg);
    char* Ow = u.O + (size_t)(wid * 32) * u.os;
    unsigned loff = (unsigned)(4 * hi) * u.os + (unsigned)r32 * 2u;
    asm volatile("" : "+v"(loff));
#pragma unroll
    for (int r = 0; r < 16; ++r) { const int orow = crow(r, hi); const float rl = __builtin_amdgcn_rcpf(wsf[32 + orow]);
        char* rowp = Ow + (size_t)((r & 3) + 8 * (r >> 2)) * u.os;
#pragma unroll
        for (int d0 = 0; d0 < 4; ++d0) { const float v = o[d0][r] * rl; const float vn_ = __shfl_xor(v, 1);
            if ((r32 & 1) == 0) *(unsigned*)(rowp + d0 * 64 + loff) = pkh(v, vn_); } }
}
}

template <class RowOf>
__device__ __forceinline__ void cvt_item(const float* W, int K, int N, h16* WT, LAS float* scr, int item, int lane, const float* kscale, RowOf row_of, int ldo = 0, int ko = 0) {
    if (ldo == 0) ldo = K;
    const int nblk = N >> 6, kb = item / nblk, nb = item - kb * nblk, k0 = kb * 64, n0 = nb * 64;
    f32x4 v[16];
#pragma unroll
    for (int i = 0; i < 16; ++i) { const int kk = 4 * i + (lane >> 4); v[i] = *(const GAS f32x4*)(W + (size_t)(k0 + kk) * N + n0 + (lane & 15) * 4); }
#pragma unroll
    for (int i = 0; i < 16; ++i) { const int kk = 4 * i + (lane >> 4); f32x4 t = v[i]; if (kscale) t *= kscale[k0 + kk];
        LAS float* s = scr + kk * 65 + (lane & 15) * 4; s[0] = t[0]; s[1] = t[1]; s[2] = t[2]; s[3] = t[3]; }
    LDS_WAIT(); asm volatile("" ::: "memory");
    const int c = lane & 7;
#pragma unroll
    for (int j = 0; j < 8; ++j) { const int n = (lane >> 3) + 8 * j; const LAS float* s = scr + (8 * c) * 65 + n;
        u32x4 o; o.x = pkh(s[0 * 65], s[1 * 65]); o.y = pkh(s[2 * 65], s[3 * 65]); o.z = pkh(s[4 * 65], s[5 * 65]); o.w = pkh(s[6 * 65], s[7 * 65]);
        *(GAS u32x4*)(WT + (size_t)row_of(n0 + n) * ldo + ko + k0 + 8 * c) = o; }
    LDS_WAIT(); asm volatile("" ::: "memory");
}
template <class RowOf>
__device__ __forceinline__ void cvt_item8(const float* W, int K, int N, unsigned char* WT, LAS float* scr, int item, int lane, float scale, RowOf row_of) {
    const int nblk = N >> 6, kb = item / nblk, nb = item - kb * nblk, k0 = kb * 64, n0 = nb * 64;
    f32x4 v[16];
#pragma unroll
    for (int i = 0; i < 16; ++i) { const int kk = 4 * i + (lane >> 4); v[i] = *(const GAS f32x4*)(W + (size_t)(k0 + kk) * N + n0 + (lane & 15) * 4); }
#pragma unroll
    for (int i = 0; i < 16; ++i) { const int kk = 4 * i + (lane >> 4); const f32x4 t = v[i] * scale;
        LAS float* s = scr + kk * 65 + (lane & 15) * 4; s[0] = t[0]; s[1] = t[1]; s[2] = t[2]; s[3] = t[3]; }
    LDS_WAIT(); asm volatile("" ::: "memory");
    const int c = lane & 7;
#pragma unroll
    for (int j = 0; j < 8; ++j) { const int n = (lane >> 3) + 8 * j; const LAS float* s = scr + (8 * c) * 65 + n;
        u32x2 o; o.x = pk4_fp8(s[0 * 65], s[1 * 65], s[2 * 65], s[3 * 65]); o.y = pk4_fp8(s[4 * 65], s[5 * 65], s[6 * 65], s[7 * 65]);
        *(GAS u32x2*)(WT + (size_t)row_of(n0 + n) * K + k0 + 8 * c) = o; }
    LDS_WAIT(); asm volatile("" ::: "memory");
}
__device__ __forceinline__ int rope_perm(int i, int half) { return i < half ? 2 * i : 2 * (i - half) + 1; }
__device__ __forceinline__ int row_in(int c) {
    if (c < 1024) return c;
    if (c < 1088) return 1024 + rope_perm(c - 1024, 32);
    if (c < 5696) { const int dc = c - 1088, part = dc / 1536, dim = dc & 127;
        return 1280 + ((part < 2 && dim < 32) ? (dc - dim + rope_perm(dim, 16)) : dc); }
    return 5888 + (c - 5696);
}
__device__ __forceinline__ int row_qup(int c) { const int h = c / 192, j = c - h * 192; return j < 128 ? h * 128 + j : 1024 + h * 64 + rope_perm(j - 128, 32); }
__device__ __forceinline__ int row_gu(int n, int up) { return (n >> 7) * 256 + up * 128 + (n & 127); }
__device__ __forceinline__ void sincos_d(float angf, float& s, float& c) {
    const double a = (double)angf; const double k = __builtin_rint(a * 0.63661977236758134308);
    const double r = (a - k * 1.57079632679489655800) - k * 6.12323399573676603587e-17; const double r2 = r * r;
    double sp = -7.6471637318198164759e-13; sp = sp * r2 + 1.6059043836821614599e-10; sp = sp * r2 - 2.5052108385441718775e-08; sp = sp * r2 + 2.7557319223985890653e-06;
    sp = sp * r2 - 1.9841269841269841270e-04; sp = sp * r2 + 8.3333333333333333333e-03; sp = sp * r2 - 1.6666666666666666667e-01; const double sn = r + r * r2 * sp;
    double cp = 4.7794773323873852974e-14; cp = cp * r2 - 1.1470745597729724714e-11; cp = cp * r2 + 2.0876756987868098979e-09; cp = cp * r2 - 2.7557319223985890653e-07;
    cp = cp * r2 + 2.4801587301587301587e-05; cp = cp * r2 - 1.3888888888888888889e-03; cp = cp * r2 + 4.1666666666666666667e-02; cp = cp * r2 - 0.5; const double cn = 1.0 + r2 * cp;
    const int q = ((int)k) & 3;
    const double ss = (q == 0) ? sn : (q == 1) ? cn : (q == 2) ? -sn : -cn;
    const double cc = (q == 0) ? cn : (q == 1) ? -sn : (q == 2) ? -cn : sn;
    s = (float)ss; c = (float)cc;
}
__device__ __forceinline__ void p0_prologue(const Frame& F, const Args& a) {
    {
        LAS float* sc = (LAS float*)F.lds; LAS float* part = (LAS float*)(F.lds + 32768);
        float* mod = wsp<float>(F, WS_MOD);
        for (int i = F.tid; i < 4 * DM; i += NTHR) { const float v = a.c[i]; sc[i] = v / (1.0f + __expf(-v)); }
        __syncthreads();
        for (int un = F.vcu; un < 384; un += F.G) {
            const int j0 = un * 32, col4 = F.tid & 7, kg = F.tid >> 3;
            f32x4 ac[4];
#pragma unroll
            for (int b = 0; b < 4; ++b) ac[b] = (f32x4){0.f, 0.f, 0.f, 0.f};
#pragma unroll 8
            for (int i = 0; i < 32; ++i) { const int k = kg + 64 * i; const f32x4 w = *(const GAS f32x4*)(a.w_ada + (size_t)k * 12288 + j0 + col4 * 4);
#pragma unroll
                for (int b = 0; b < 4; ++b) ac[b] += w * sc[b * DM + k]; }
#pragma unroll
            for (int b = 0; b < 4; ++b) *(LAS f32x4*)(part + (kg * 4 + b) * 32 + col4 * 4) = ac[b];
            __syncthreads();
            if (F.tid < 128) { const int b = F.tid >> 5, col = F.tid & 31; float s = 0.f;
                for (int g = 0; g < 64; ++g) s += part[(g * 4 + b) * 32 + col];
                mod[b * 12288 + j0 + col] = s + a.b_ada[j0 + col]; }
            __syncthreads();
        }
    }
    const int gw = F.vcu * NWAVES + F.wave, NGW = F.G * NWAVES, gt = F.vcu * NTHR + F.tid, NGT = F.G * NTHR;
    {
        float* cosd = wsp<float>(F, WS_COSD); float* sind = wsp<float>(F, WS_SIND); float* cosm = wsp<float>(F, WS_COSM); float* sinm = wsp<float>(F, WS_SINM);
        for (int i = gt; i < NTOK * 48; i += NGT) { const int t = i / 48, j = i - t * 48; const float p = (float)a.pos[t];
            float s, c;
            if (j < 16) { sincos_d(p * a.invf_d[j], s, c); cosd[t * 16 + j] = c; sind[t * 16 + j] = s; }
            else { sincos_d(p * a.invf_m[j - 16], s, c); cosm[t * 32 + j - 16] = c; sinm[t * 32 + j - 16] = s; } }
    }
    { h16* wr = wsp<h16>(F, W_R);
      for (int i = gt; i < 64 * DM; i += NGT) { const int j = i & 7, lane = (i >> 3) & 63, kk = (i >> 9) & 63, et = i >> 15, fr = lane & 15, fq = lane >> 4;
          wr[i] = (h16)a.w_router[(size_t)(kk * 32 + fq * 8 + j) * 64 + et * 16 + fr]; } }
    { u32x4* z = (u32x4*)(wsp<unsigned char>(F, W_IN) + (size_t)1088 * DM); for (int i = gt; i < 192 * DM / 16; i += NGT) z[i] = (u32x4){0u, 0u, 0u, 0u}; }
    {
        __syncthreads();
        LAS float* scr = (LAS float*)(F.lds + F.wave * 16640);
        constexpr int I_IN = 32 * 153, I_QUP = 8 * 24, I_KVUP = 8 * 32, I_MO = 16 * 32, I_DO = 8 * 32, I_OUT = 32 * 32, I_R = 32, I_SH = 256, I_EX = 256;
        constexpr int NSMALL = I_IN + I_QUP + I_KVUP + I_MO + I_DO + I_OUT + I_R + 3 * I_SH;
        constexpr int NITEMS = NSMALL;
        for (int it = gw; it < NITEMS; it += NGW) {
            int r = it;
            if (r < I_IN) { cvt_item8(a.w_in, DM, 9792, wsp<unsigned char>(F, W_IN), scr, r, F.lane, SC_GU, [](int n) { return row_in(n); }); continue; } r -= I_IN;
            if (r < I_QUP) { cvt_item(a.w_q_up, 512, 1536, wsp<h16>(F, W_QUP), scr, r, F.lane, a.q_a_norm_g, [](int n) { return row_qup(n); }); continue; } r -= I_QUP;
            if (r < I_KVUP) { cvt_item(a.w_kv_up, 512, 2048, wsp<h16>(F, W_KVUP), scr, r, F.lane, a.kv_a_norm_g, [](int n) { return n; }); continue; } r -= I_KVUP;
            if (r < I_MO) { cvt_item(a.w_mla_o, 1024, 2048, wsp<h16>(F, W_MO), scr, r, F.lane, nullptr, [](int n) { return n; }, 1536, 0); continue; } r -= I_MO;
            if (r < I_DO) { cvt_item(a.w_dil_o, 512, 2048, wsp<h16>(F, W_MO), scr, r, F.lane, nullptr, [](int n) { return n; }, 1536, 1024); continue; } r -= I_DO;
            if (r < I_OUT) { cvt_item8(a.w_out, DM, DM, wsp<unsigned char>(F, W_OUT), scr, r, F.lane, SC_GU, [](int n) { return n; }); continue; } r -= I_OUT;
            if (r < I_R) { continue; } r -= I_R;
            if (r < I_SH) { cvt_item8(a.w_sh_gate, DM, 512, wsp<unsigned char>(F, W_GU) + (size_t)64 * 1024 * 2048, scr, r, F.lane, SC_GU, [](int n) { return row_gu(n, 0); }); continue; } r -= I_SH;
            if (r < I_SH) { cvt_item8(a.w_sh_up, DM, 512, wsp<unsigned char>(F, W_GU) + (size_t)64 * 1024 * 2048, scr, r, F.lane, SC_GU, [](int n) { return row_gu(n, 1); }); continue; } r -= I_SH;
            if (r < I_SH) { cvt_item8(a.w_sh_down, 512, DM, wsp<unsigned char>(F, W_DN) + (size_t)64 * 2048 * 512, scr, r, F.lane, SC_DN, [](int n) { return n; }); continue; } r -= I_SH;
        }
        __syncthreads();
    }
}

constexpr int NCONV = 29;
constexpr int N_EXP_ITEMS = 3 * 64 * 256;
struct ExpItem { const float* src; unsigned char* dst; int K, N, kb, nb, up; float scale; };
__device__ __forceinline__ ExpItem exp_item(const Frame& F, const Args& a, int r) {
    const int mat = r / (64 * 256), rr = r - mat * (64 * 256), e = rr >> 8, ii = rr & 255; ExpItem it;
    if (mat < 2) { it.src = (mat ? a.w_exp_up : a.w_exp_gate) + (size_t)e * DM * 512; it.dst = wsp<unsigned char>(F, W_GU) + (size_t)e * 1024 * 2048; it.K = DM; it.N = 512; it.up = mat; it.scale = SC_GU; it.kb = ii >> 3; it.nb = ii & 7; }
    else { it.src = a.w_exp_down + (size_t)e * 512 * DM; it.dst = wsp<unsigned char>(F, W_DN) + (size_t)e * 2048 * 512; it.K = 512; it.N = DM; it.up = -1; it.scale = SC_DN; it.kb = ii >> 5; it.nb = ii & 31; }
    return it;
}
#define EXP_LOAD(v, it) do { _Pragma("unroll") for (int i_ = 0; i_ < 16; ++i_) { const int kk_ = 4 * i_ + (F.lane >> 4); \
        v[i_] = __builtin_nontemporal_load((const GAS f32x4*)((it).src + (size_t)((it).kb * 64 + kk_) * (it).N + (it).nb * 64 + (F.lane & 15) * 4)); } } while (0)
#define EXP_STORE(v, it) do { _Pragma("unroll") for (int i_ = 0; i_ < 16; ++i_) { const int kk_ = 4 * i_ + (F.lane >> 4); const f32x4 t_ = v[i_] * (it).scale; \
            scr[kk_ * 17 + (F.lane & 15)] = pk4_fp8(t_[0], t_[1], t_[2], t_[3]); } \
        LDS_WAIT(); asm volatile("" ::: "memory"); \
        { const int c_ = F.lane & 7; _Pragma("unroll") for (int g_ = 0; g_ < 2; ++g_) { const int n4_ = (F.lane >> 3) + 8 * g_; unsigned d_[8]; \
            _Pragma("unroll") for (int j_ = 0; j_ < 8; ++j_) d_[j_] = scr[(8 * c_ + j_) * 17 + n4_]; \
            unsigned lo_[4], hi_[4]; \
            { const unsigned ta = __builtin_amdgcn_perm(d_[1], d_[0], 0x05010400u), tb = __builtin_amdgcn_perm(d_[1], d_[0], 0x07030602u), ua = __builtin_amdgcn_perm(d_[3], d_[2], 0x05010400u), ub = __builtin_amdgcn_perm(d_[3], d_[2], 0x07030602u); \
              lo_[0] = __builtin_amdgcn_perm(ua, ta, 0x05040100u); lo_[1] = __builtin_amdgcn_perm(ua, ta, 0x07060302u); lo_[2] = __builtin_amdgcn_perm(ub, tb, 0x05040100u); lo_[3] = __builtin_amdgcn_perm(ub, tb, 0x07060302u); } \
            { const unsigned ta = __builtin_amdgcn_perm(d_[5], d_[4], 0x05010400u), tb = __builtin_amdgcn_perm(d_[5], d_[4], 0x07030602u), ua = __builtin_amdgcn_perm(d_[7], d_[6], 0x05010400u), ub = __builtin_amdgcn_perm(d_[7], d_[6], 0x07030602u); \
              hi_[0] = __builtin_amdgcn_perm(ua, ta, 0x05040100u); hi_[1] = __builtin_amdgcn_perm(ua, ta, 0x07060302u); hi_[2] = __builtin_amdgcn_perm(ub, tb, 0x05040100u); hi_[3] = __builtin_amdgcn_perm(ub, tb, 0x07060302u); } \
            _Pragma("unroll") for (int q_ = 0; q_ < 4; ++q_) { const int n_ = (it).nb * 64 + 4 * n4_ + q_; const int row_ = (it).up < 0 ? n_ : row_gu(n_, (it).up); u32x2 o_; o_.x = lo_[q_]; o_.y = hi_[q_]; \
                __builtin_nontemporal_store(o_, (GAS u32x2*)((it).dst + (size_t)row_ * (it).K + (it).kb * 64 + 8 * c_)); } } } \
        LDS_WAIT(); asm volatile("" ::: "memory"); } while (0)
__device__ __forceinline__ void p_convert_experts(const Frame& F, const Args& a, int cw, int ncw, int i0, int i1) {
    __syncthreads();
    LAS unsigned* scr = (LAS unsigned*)(F.lds + F.wave * 4352);
    const int stride = ncw * NWAVES; int r = i0 + cw * NWAVES + F.wave;
    for (; r < i1; r += 2 * stride) {
        f32x4 v0[16], v1[16]; const int r1 = r + stride; const bool h1 = r1 < i1;
        const ExpItem it0 = exp_item(F, a, r), it1 = exp_item(F, a, h1 ? r1 : r);
        EXP_LOAD(v0, it0); if (h1) EXP_LOAD(v1, it1);
        __builtin_amdgcn_sched_barrier(0);
        EXP_STORE(v0, it0);
        if (h1) EXP_STORE(v1, it1);
    }
    __syncthreads();
}
#undef EXP_LOAD
#undef EXP_STORE

__device__ __forceinline__ void p1_h1(const Frame& F, const Args& a) {
    const int gw = F.vcu * NWAVES + F.wave, NGW = F.G * NWAVES;
    const float* mod = wsp<float>(F, WS_MOD); h16* h1 = wsp<h16>(F, A_H1);
    for (int t = gw; t < NTOK; t += NGW) {
        const int b = t >> 12; const GAS f32x4* xr = (const GAS f32x4*)(a.x + (size_t)t * DM) + F.lane;
        f32x4 v[8]; float ss = 0.f;
#pragma unroll
        for (int j = 0; j < 8; ++j) { v[j] = xr[64 * j]; ss += (v[j][0] * v[j][0] + v[j][1] * v[j][1]) + (v[j][2] * v[j][2] + v[j][3] * v[j][3]); }
        const float rstd = 1.0f / sqrtf(wave_sum(ss) * (1.0f / DM) + EPS);
#pragma unroll
        for (int j = 0; j < 8; ++j) { const int c = 4 * F.lane + 256 * j;
            const f32x4 g = *(const f32x4*)(a.attn_pre_g + c), sc = *(const f32x4*)(mod + b * 12288 + 2048 + c), sh = *(const f32x4*)(mod + b * 12288 + c);
            const f32x4 h = v[j] * rstd * g * (sc + 1.0f) + sh;
            *(GAS unsigned*)((unsigned char*)h1 + (size_t)t * DM + c) = pk4_fp8(h[0], h[1], h[2], h[3]); }
    }
}

__device__ __forceinline__ void p4_attention(const Frame& F) {
    const char* qm = (const char*)wsp<h16>(F, A_QM); const char* kv = (const char*)wsp<h16>(F, A_KV); const char* kr = (const char*)wsp<h16>(F, A_KR);
    const char* dil = (const char*)wsp<h16>(F, A_DIL); char* omla = (char*)wsp<h16>(F, A_OMLA); char* od = (char*)wsp<h16>(F, A_OD); float* lse = wsp<float>(F, WS_LSE);
#ifndef MK_REP4
#define MK_REP4 0
#endif
    _Pragma("unroll") for (int rep4a = 0; rep4a < (MK_REP4 == 1 ? 2 : 1); ++rep4a)
    for (int it = F.vcu; it < 256; it += F.G) {
        const int bh = it >> 3, x = it & 7, b = bh >> 3, h = bh & 7;
#pragma unroll 1
        for (int half = 0; half < 2; ++half) {
            const int qb = half ? 15 - x : x; const size_t tok0 = (size_t)b * SEQ;
            att::AUnit u;
            u.Q = qm + (tok0 + qb * 256) * 3072 + h * 256; u.qs = 3072; u.QR = qm + (tok0 + qb * 256) * 3072 + 2048 + h * 128;
            u.K = kv + tok0 * 4096 + h * 512; u.kvs = 4096; u.V = u.K + 256; u.KR = kr + tok0 * 128; u.krs = 128;
            u.O = omla + (tok0 + qb * 256) * 3072 + h * 256; u.os = 3072; u.LSE = nullptr; u.ls = 0;
            u.P0 = qb * 256; u.jlo = 0; u.jhi = qb * 4 + 4; u.W = 0x40000000u;
            att::attn_unit<true>(F.lds, u);
        }
    }
    _Pragma("unroll") for (int rep4b = 0; rep4b < (MK_REP4 == 2 ? 2 : 1); ++rep4b)
    for (int un = F.vcu; un < 768; un += F.G) {
        const int b = un / 192, rem = un - b * 192, head = rem >> 4, sub = rem & 15, g = head >> 2;
        const int d = (g == 0) ? 1 : (g == 1) ? 4 : 16; const int r = sub % d, jb = sub / d;
        const size_t tok0 = (size_t)b * SEQ + r; const unsigned rs = (unsigned)d * 9216u;
        att::AUnit u;
        u.Q = dil + (tok0 + (size_t)d * 256 * jb) * 9216 + head * 256; u.qs = rs; u.QR = nullptr;
        u.K = dil + tok0 * 9216 + 3072 + head * 256; u.kvs = rs; u.V = dil + tok0 * 9216 + 6144 + head * 256; u.KR = nullptr; u.krs = 0;
        u.O = od + (tok0 + (size_t)d * 256 * jb) * 3072 + head * 256; u.os = (unsigned)d * 3072u;
        u.LSE = lse + (tok0 + (size_t)d * 256 * jb) * 12 + head; u.ls = (unsigned)d * 12u;
        u.P0 = jb * 256; u.jlo = jb == 0 ? 0 : jb * 4 - 2; u.jhi = jb * 4 + 4; u.W = 129u;
        att::attn_unit<false>(F.lds, u);
    }
    __syncthreads();
}
__device__ __forceinline__ void p5_combine(const Frame& F) {
    const int gw = F.vcu * NWAVES + F.wave, NGW = F.G * NWAVES;
    const h16* od = wsp<h16>(F, A_OD); const float* lse = wsp<float>(F, WS_LSE); h16* odil = wsp<h16>(F, A_ODIL);
    for (int t = gw; t < NTOK; t += NGW) {
        const int hs = F.lane >> 4, dc = (F.lane & 15) * 8;
        const float l0 = lse[(size_t)t * 12 + hs], l1 = lse[(size_t)t * 12 + 4 + hs], l2 = lse[(size_t)t * 12 + 8 + hs];
        const float mx = fmaxf(l0, fmaxf(l1, l2));
        float w0 = __builtin_amdgcn_exp2f(l0 - mx), w1 = __builtin_amdgcn_exp2f(l1 - mx), w2 = __builtin_amdgcn_exp2f(l2 - mx);
        const float inv = 1.0f / (w0 + w1 + w2); w0 *= inv; w1 *= inv; w2 *= inv;
        f32x4 a0, a1, b0, b1, c0, c1;
        unpk8(*(const GAS u32x4*)(od + (size_t)t * 1536 + hs * 128 + dc), a0, a1);
        unpk8(*(const GAS u32x4*)(od + (size_t)t * 1536 + 512 + hs * 128 + dc), b0, b1);
        unpk8(*(const GAS u32x4*)(od + (size_t)t * 1536 + 1024 + hs * 128 + dc), c0, c1);
        const f32x4 r0 = a0 * w0 + b0 * w1 + c0 * w2, r1 = a1 * w0 + b1 * w1 + c1 * w2;
        *(GAS u32x4*)(odil + (size_t)t * 1536 + 1024 + hs * 128 + dc) = pk8(r0, r1);
    }
}

__device__ __forceinline__ void p8_router(const Frame& F, const Args& a) {
    constexpr int HP = 4128;
    LAS unsigned char* h2l = F.lds; LAS float* lg = (LAS float*)(F.lds + 32 * HP);
    LAS unsigned* lcnt = (LAS unsigned*)(F.lds + 32 * HP + 8192); LAS unsigned* lbase = lcnt + 64; LAS unsigned* rec = lbase + 64; LAS float* recw = (LAS float*)(rec + 192);
    if (F.tid < 64) lcnt[F.tid] = 0u;
    const float* mod = wsp<float>(F, WS_MOD); const h16* yat = wsp<h16>(F, A_YAT); unsigned char* h2 = wsp<unsigned char>(F, A_H2); const h16* wr_t = wsp<h16>(F, W_R);
    unsigned* cnt = wsp<unsigned>(F, WS_CTL) + CW_CNT; unsigned* list = wsp<unsigned>(F, WS_LIST); unsigned* tokpos = wsp<unsigned>(F, WS_TOKPOS); float* tokw = wsp<float>(F, WS_TOKW);
    const int fr = F.lane & 15, fq = F.lane >> 4;
    for (int tb = F.vcu; tb < NTOK / 32; tb += F.G) {
        __syncthreads();
#ifndef MK_REP8
#define MK_REP8 0
#endif
#pragma unroll 1
        for (int q8 = 0; q8 < (MK_REP8 == 1 ? 8 : 4); q8 += 2) { const int q = q8 & 3;
            const int tl = F.wave * 4 + q, t = tb * 32 + tl, b = t >> 12;
            h16x4 yh[2][8]; f32x4 xv[2][8];
#pragma unroll
            for (int z = 0; z < 2; ++z)
#pragma unroll
                for (int j = 0; j < 8; ++j) { yh[z][j] = *(const GAS h16x4*)(yat + (size_t)(t + z) * DM + 4 * F.lane + 256 * j); xv[z][j] = *(const GAS f32x4*)(a.x + (size_t)(t + z) * DM + 4 * F.lane + 256 * j); }
            __builtin_amdgcn_sched_barrier(0);
            float ss[2] = {0.f, 0.f};
#pragma unroll
            for (int z = 0; z < 2; ++z)
#pragma unroll
                for (int j = 0; j < 8; ++j) { const float y0 = (float)yh[z][j][0], y1 = (float)yh[z][j][1], y2 = (float)yh[z][j][2], y3 = (float)yh[z][j][3]; ss[z] += (y0 * y0 + y1 * y1) + (y2 * y2 + y3 * y3); }
            const float r10 = 1.0f / sqrtf(wave_sum(ss[0]) * (1.0f / DM) + EPS), r11 = 1.0f / sqrtf(wave_sum(ss[1]) * (1.0f / DM) + EPS);
            float ss2[2] = {0.f, 0.f};
#pragma unroll
            for (int j = 0; j < 8; ++j) { const int c = 4 * F.lane + 256 * j; const f32x4 pg = *(const f32x4*)(a.attn_post_g + c), pa = *(const f32x4*)(mod + b * 12288 + 2 * 2048 + c);
#pragma unroll
                for (int z = 0; z < 2; ++z) { const float r1 = z ? r11 : r10;
                    const f32x4 yv = (f32x4){(float)yh[z][j][0], (float)yh[z][j][1], (float)yh[z][j][2], (float)yh[z][j][3]};
                    const f32x4 xm = xv[z][j] + pa * (yv * r1 * pg);
                    *(GAS f32x4*)(a.out + (size_t)(t + z) * DM + c) = xm; xv[z][j] = xm;
                    ss2[z] += (xm[0] * xm[0] + xm[1] * xm[1]) + (xm[2] * xm[2] + xm[3] * xm[3]); } }
            const float r20 = 1.0f / sqrtf(wave_sum(ss2[0]) * (1.0f / DM) + EPS), r21 = 1.0f / sqrtf(wave_sum(ss2[1]) * (1.0f / DM) + EPS);
#pragma unroll
            for (int j = 0; j < 8; ++j) { const int c = 4 * F.lane + 256 * j;
                const f32x4 pg = *(const f32x4*)(a.ffn_pre_g + c), sc = *(const f32x4*)(mod + b * 12288 + 4 * 2048 + c), sh = *(const f32x4*)(mod + b * 12288 + 3 * 2048 + c);
#pragma unroll
                for (int z = 0; z < 2; ++z) { const float r2 = z ? r21 : r20;
                    const f32x4 h = xv[z][j] * r2 * pg * (sc + 1.0f) + sh;
                    u32x2 w; w.x = pkh(h[0], h[1]); w.y = pkh(h[2], h[3]);
                    *(GAS unsigned*)(h2 + (size_t)(t + z) * DM + c) = pk4_fp8(h[0], h[1], h[2], h[3]);
                    *(LAS u32x2*)(h2l + (tl + z) * HP + c * 2) = w; } }
        }
        __syncthreads();
        {
            const int et = F.wave & 3, kh = F.wave >> 2; f32x4 acc0 = (f32x4){0.f, 0.f, 0.f, 0.f}, acc1 = acc0;
            const LAS unsigned char* ap = h2l + fr * HP + fq * 16 + kh * 2048; const h16* bp = wr_t + (size_t)(et * 64 + kh * 32) * 512 + F.lane * 8;
#pragma unroll 16
            for (int kk = 0; kk < 32; ++kk) { const h16x8 bv = *(const GAS h16x8*)(bp + kk * 512);
                const h16x8 a0 = *(const LAS h16x8*)(ap + kk * 64), a1 = *(const LAS h16x8*)(ap + 16 * HP + kk * 64);
                acc0 = __builtin_amdgcn_mfma_f32_16x16x32_f16(a0, bv, acc0, 0, 0, 0); acc1 = __builtin_amdgcn_mfma_f32_16x16x32_f16(a1, bv, acc1, 0, 0, 0); }
            __syncthreads();
            LAS float* pt = (LAS float*)h2l;
            if (kh == 1) {
#pragma unroll
                for (int j = 0; j < 4; ++j) { pt[(4 * fq + j) * 64 + et * 16 + fr] = acc0[j]; pt[(16 + 4 * fq + j) * 64 + et * 16 + fr] = acc1[j]; } }
            __syncthreads();
            if (kh == 0) {
#pragma unroll
                for (int j = 0; j < 4; ++j) { lg[(4 * fq + j) * 64 + et * 16 + fr] = acc0[j] + pt[(4 * fq + j) * 64 + et * 16 + fr]; lg[(16 + 4 * fq + j) * 64 + et * 16 + fr] = acc1[j] + pt[(16 + 4 * fq + j) * 64 + et * 16 + fr]; } }
        }
        __syncthreads();
#pragma unroll 1
        for (int q = 0; q < 4; ++q) {
            const int tl = F.wave * 4 + q, e = F.lane;
            const float score = sigmoidf_(lg[tl * 64 + e]); const float biased = score + a.router_bias[e];
            float m1 = biased;
            m1 = fmaxf(m1, __shfl_xor(m1, 1)); m1 = fmaxf(m1, __shfl_xor(m1, 2)); m1 = fmaxf(m1, __shfl_xor(m1, 4));
            const unsigned long long bal = __ballot(biased == m1); const unsigned gb = (unsigned)(bal >> (e & 56)) & 0xFFu; const int first = __builtin_ctz(gb);
            float v2 = ((e & 7) == first) ? -__builtin_inff() : biased;
            v2 = fmaxf(v2, __shfl_xor(v2, 1)); v2 = fmaxf(v2, __shfl_xor(v2, 2)); v2 = fmaxf(v2, __shfl_xor(v2, 4));
            const float gs = m1 + v2; const int g = e >> 3; int grank = 0;
#pragma unroll
            for (int g2 = 0; g2 < 8; ++g2) { const float s2 = __int_as_float(__builtin_amdgcn_readlane(__float_as_int(gs), g2 * 8)); grank += (s2 > gs || (s2 == gs && g2 < g)) ? 1 : 0; }
            const float sel = grank < 4 ? biased : -__builtin_inff(); int rank = 0;
#pragma unroll
            for (int e2 = 0; e2 < 64; ++e2) { const float s2 = __int_as_float(__builtin_amdgcn_readlane(__float_as_int(sel), e2)); rank += (s2 > sel || (s2 == sel && e2 < e)) ? 1 : 0; }
            const bool chosen = rank < TOPK;
            const float wsum = wave_sum(chosen ? score : 0.f);
            if (chosen) { const float w = score / (wsum + 1e-20f) * 2.5f;
                const unsigned sl = __hip_atomic_fetch_add(lcnt + e, 1u, __ATOMIC_RELAXED, __HIP_MEMORY_SCOPE_WORKGROUP);
                rec[tl * 6 + rank] = ((unsigned)e << 20) | sl; recw[tl * 6 + rank] = w; }
        }
        __syncthreads();
        if (F.tid < 64) { const unsigned n = lcnt[F.tid]; lbase[F.tid] = n ? __hip_atomic_fetch_add(cnt + 64 * F.tid, n, __ATOMIC_RELAXED, __HIP_MEMORY_SCOPE_AGENT) : 0u; lcnt[F.tid] = 0u; }
        __syncthreads();
        if (F.tid < 192) { const int tl = F.tid / 6, r = F.tid - tl * 6, t = tb * 32 + tl; const unsigned rc = rec[F.tid]; const unsigned e = rc >> 20, slot = lbase[e] + (rc & 0xFFFFFu);
            list[(size_t)e * LISTCAP + slot] = (unsigned)t; tokpos[(size_t)t * 6 + r] = (e << 20) | slot; tokw[(size_t)t * 6 + r] = recw[F.tid]; }
    }
}

__device__ __forceinline__ void p11_final(const Frame& F, const Args& a) {
    const int gw = F.vcu * NWAVES + F.wave, NGW = F.G * NWAVES;
    const LAS int* tstart = (const LAS int*)(F.lds + LDS_TAB);
    const float* mod = wsp<float>(F, WS_MOD); const unsigned char* ys = wsp<unsigned char>(F, A_YS); const unsigned* tokpos = wsp<unsigned>(F, WS_TOKPOS); const float* tokw = wsp<float>(F, WS_TOKW);
    for (int t = gw; t < NTOK; t += NGW) {
        const int b = t >> 12;
        unsigned prow = 0; float w = 0.f;
        if (F.lane < 6) { const unsigned p = tokpos[(size_t)t * 6 + F.lane]; prow = (unsigned)tstart[p >> 20] * 256u + (p & 0xFFFFFu); w = tokw[(size_t)t * 6 + F.lane]; }
        if (F.lane == 6) { prow = (unsigned)tstart[64] * 256u + (unsigned)t; w = 1.0f; }
        u32x2 raw[7][4]; f32x4 xm[8];
#pragma unroll
        for (int k = 0; k < 7; ++k) { const unsigned pr = __shfl(prow, k);
#pragma unroll
            for (int j = 0; j < 4; ++j) raw[k][j] = *(const GAS u32x2*)(ys + (size_t)pr * DM + 8 * F.lane + 512 * j); }
#pragma unroll
        for (int j = 0; j < 8; ++j) xm[j] = *(const GAS f32x4*)(a.out + (size_t)t * DM + 8 * F.lane + 512 * (j >> 1) + 4 * (j & 1));
        __builtin_amdgcn_sched_barrier(0);
        f32x4 acc[8];
#pragma unroll
        for (int j = 0; j < 8; ++j) acc[j] = (f32x4){0.f, 0.f, 0.f, 0.f};
#pragma unroll
        for (int k = 0; k < 7; ++k) { const float wk = __shfl(w, k);
#pragma unroll
            for (int j = 0; j < 4; ++j) { const f32x2 a0 = __builtin_amdgcn_cvt_pk_f32_fp8((int)raw[k][j].x, false), a1 = __builtin_amdgcn_cvt_pk_f32_fp8((int)raw[k][j].x, true),
                                                      b0 = __builtin_amdgcn_cvt_pk_f32_fp8((int)raw[k][j].y, false), b1 = __builtin_amdgcn_cvt_pk_f32_fp8((int)raw[k][j].y, true);
                acc[2 * j] += (f32x4){a0[0], a0[1], a1[0], a1[1]} * wk; acc[2 * j + 1] += (f32x4){b0[0], b0[1], b1[0], b1[1]} * wk; } }
        float ss = 0.f;
#pragma unroll
        for (int j = 0; j < 8; ++j) ss += (acc[j][0] * acc[j][0] + acc[j][1] * acc[j][1]) + (acc[j][2] * acc[j][2] + acc[j][3] * acc[j][3]);
        f32x4 pg[8], pf[8];
#pragma unroll
        for (int j = 0; j < 8; ++j) { const int c = 8 * F.lane + 512 * (j >> 1) + 4 * (j & 1); pg[j] = *(const f32x4*)(a.ffn_post_g + c); pf[j] = *(const f32x4*)(mod + b * 12288 + 5 * 2048 + c); }
        const float rstd = 1.0f / sqrtf(wave_sum(ss) * (1.0f / DM) + EPS);
#pragma unroll
        for (int j = 0; j < 8; ++j) { const int c = 8 * F.lane + 512 * (j >> 1) + 4 * (j & 1);
            *(GAS f32x4*)(a.out + (size_t)t * DM + c) = xm[j] + pf[j] * (acc[j] * rstd * pg[j]); }
    }
}

constexpr int NPHASE = 12;
__global__ void __launch_bounds__(NTHR, 2) mk_fwd(Args args) {
    extern __shared__ __attribute__((aligned(16))) unsigned char lds_raw[];
    Frame F;
    F.lds = (LAS unsigned char*)lds_raw;
    F.tid = threadIdx.x; F.lane = F.tid & 63; F.wave = __builtin_amdgcn_readfirstlane(F.tid >> 6);
    F.G = gridDim.x; { const int bx = blockIdx.x; F.vcu = (F.G % 8 == 0) ? (bx % 8) * (F.G / 8) + bx / 8 : bx; }
    F.ws = args.ws;
    unsigned* ctl = (unsigned*)(args.ws + WS_CTL);
    const int lo = args.ph_lo, hi = args.ph_hi;
    if (F.tid < 16) ((LAS unsigned*)(F.lds + LDS_MISC))[F.tid] = 0u;
    __syncthreads();
    XcdBarrier bar; bar.bar = ctl + CW_BAR; bar.x = 0; bar.st = nullptr;
    if (hi - lo > 1) bar = xcd_barrier_post(ctl + CW_BAR, (volatile LAS unsigned*)(F.lds + LDS_MISC));
#ifndef MK_ONLY
#define MK_ONLY -1
#endif
#define IN(k) ((MK_ONLY < 0 || (k) == MK_ONLY) && lo <= (k) && (k) < hi)
#ifndef MK_TP
#define MK_TP -1
#endif
#ifndef MK_TK
#define MK_TK 8
#endif
    unsigned long long tp_prev = 0ull, tp_dt = 0ull;
    if (MK_TP >= 0 && blockIdx.x == 0 && F.tid == 0) tp_prev = wall_clock64();
    const unsigned long long tp_start = tp_prev;
#define SEAM(k) do { if (IN(k) && IN((k) + 1)) xcd_barrier(bar); \
        if (MK_TP >= 0 && blockIdx.x == 0 && F.tid == 0) { const unsigned long long now_ = wall_clock64(); if ((k) == MK_TP) tp_dt = now_ - tp_prev; tp_prev = now_; } } while (0)
#ifndef MK_REP
#define MK_REP -1
#endif
#define REPS(k) _Pragma("unroll") for (int rep_ = 0; rep_ < ((k) == MK_REP ? 2 : 1); ++rep_)

    if (IN(0)) REPS(0) { p0_prologue(F, args); } SEAM(0);
    if (IN(1)) REPS(1) { p1_h1(F, args); } SEAM(1);
    const bool split = F.G > 4 * NCONV; const int GG = split ? F.G - NCONV : F.G; const bool conv = split && (int)blockIdx.x >= GG; const int cw = (int)blockIdx.x - GG;
    constexpr int CONV_DEF = (N_EXP_ITEMS / 100) * 30, CONV_CUT = (N_EXP_ITEMS / 100) * 23;
    if (IN(0)) p_convert_experts(F, args, F.vcu, F.G, split ? CONV_DEF : 0, N_EXP_ITEMS);
    if (IN(2)) REPS(2) {
        if (conv) p_convert_experts(F, args, cw, NCONV, 0, CONV_CUT);
        else {
        pg8::StaticOrder S; S.init(wsp<h16>(F, A_H1), DM / 2, wsp<h16>(F, W_IN), DM / 2, NPROJ, GG, (int)blockIdx.x);
        EpiIn E{wsp<h16>(F, A_QA), wsp<h16>(F, A_KR), wsp<h16>(F, A_DIL), wsp<h16>(F, A_GATE), wsp<float>(F, WS_ROWSQ), wsp<float>(F, WS_COSD), wsp<float>(F, WS_SIND), wsp<float>(F, WS_COSM), wsp<float>(F, WS_SINM)};
        pg8::gemm_phase<EpiIn, pg8::StaticOrder, false, true>(F.lds, DM / 2, DM / 2, S, E);
        }
    } SEAM(2);
    if (IN(3)) REPS(3) {
        if (conv) p_convert_experts(F, args, cw, NCONV, CONV_CUT, CONV_DEF);
        else {
        UpOrder S{(const char*)wsp<h16>(F, A_QA), (const char*)wsp<h16>(F, W_QUP), (const char*)wsp<h16>(F, W_KVUP), GG, split ? (int)blockIdx.x : F.vcu};
        EpiUp E{wsp<h16>(F, A_QM), wsp<h16>(F, A_KV), wsp<float>(F, WS_ROWSQ), wsp<float>(F, WS_COSM), wsp<float>(F, WS_SINM)};
        pg8::gemm_phase<EpiUp, UpOrder, false>(F.lds, 512, 1024, S, E);
        }
    } SEAM(3);
    if (IN(4)) REPS(4) { p4_attention(F); } SEAM(4);
    if (IN(5)) REPS(5) { p5_combine(F); } SEAM(5);
    if (IN(6)) REPS(6) {
        pg8::StaticOrder S; S.init(wsp<h16>(F, A_CAT), 1536, wsp<h16>(F, W_MO), 1536, DM, F.G, (int)blockIdx.x);
        EpiMerge E{wsp<h16>(F, A_MRG), wsp<h16>(F, A_GATE)};
        pg8::gemm_phase<EpiMerge, pg8::StaticOrder, false>(F.lds, 1536, 1536, S, E);
    } SEAM(6);
    if (IN(7)) REPS(7) {
        pg8::StaticOrder S; S.init(wsp<h16>(F, A_MRG), DM / 2, wsp<h16>(F, W_OUT), DM / 2, DM, F.G, (int)blockIdx.x);
        EpiOut<0> E{wsp<h16>(F, A_YAT), DM, nullptr, 0, nullptr, 1.0f / SC_GU};
        pg8::gemm_phase<EpiOut<0>, pg8::StaticOrder, false, true>(F.lds, DM / 2, DM / 2, S, E);
    } SEAM(7);
    if (IN(8)) { p8_router(F, args);
        if (MK_REP == 8) { xcd_barrier(bar); if (blockIdx.x == 0 && F.tid < 64) (ctl + CW_CNT)[64 * F.tid] = 0u; xcd_barrier(bar); p8_router(F, args); }
        if (MK_REP == 100) { for (int i = 0; i < 10; ++i) xcd_barrier(bar); }
    } SEAM(8);
    if (IN(9)) REPS(9) {
        moe_tables(F, ctl + CW_CNT);
        MoeOrder<4, true> S{(const LAS int*)(F.lds + LDS_TAB), (const LAS int*)(F.lds + LDS_TAB + 512), (const LAS int*)(F.lds + LDS_TAB + 1024),
                            (const char*)wsp<h16>(F, A_H2), (const char*)wsp<h16>(F, W_GU), wsp<unsigned>(F, WS_LIST), F.G, F.vcu};
        EpiSwiglu E{wsp<unsigned char>(F, A_ACT)};
        pg8::gemm_phase<EpiSwiglu, MoeOrder<4, true>, true, true>(F.lds, DM / 2, DM / 2, S, E);
    } SEAM(9);
    if (IN(10)) REPS(10) {
        moe_tables(F, ctl + CW_CNT);
        MoeOrder<8, false> S{(const LAS int*)(F.lds + LDS_TAB), (const LAS int*)(F.lds + LDS_TAB + 512), (const LAS int*)(F.lds + LDS_TAB + 1024),
                             (const char*)wsp<h16>(F, A_ACT), (const char*)wsp<h16>(F, W_DN), wsp<unsigned>(F, WS_LIST), F.G, F.vcu};
        EpiOut<3> E{wsp<h16>(F, A_YS), DM, nullptr, 0, nullptr, 1.0f / SC_DN};
        pg8::gemm_phase<EpiOut<3>, MoeOrder<8, false>, false, true>(F.lds, 256, 256, S, E);
    } SEAM(10);
    if (IN(11)) REPS(11) { moe_tables(F, ctl + CW_CNT); p11_final(F, args); }
    if (MK_TP >= 12 && hi - lo > 1) xcd_barrier(bar);
    if (MK_TP >= 0 && blockIdx.x == 0 && F.tid == 0) {
        if (MK_TP == 11 || MK_TP == 12) { VM_WAIT(); tp_dt = wall_clock64() - tp_prev; }
        if (MK_TP == 13) { VM_WAIT(); tp_dt = wall_clock64() - tp_start; }
        const unsigned long long t0_ = wall_clock64();
        while (wall_clock64() - t0_ < tp_dt * MK_TK) __builtin_amdgcn_s_sleep(8);
    }
#undef IN
#undef SEAM
}

#if MK_DIAG
constexpr size_t WS_SAVE = 15 * MiB;
__device__ __forceinline__ unsigned hsh(unsigned a) { a ^= a >> 16; a *= 0x7feb352dU; a ^= a >> 15; a *= 0x846ca68bU; a ^= a >> 16; return a; }
__device__ __forceinline__ void dg_put(unsigned* ctl, int slot, float got, float want, float atol) {
    float e = fabsf(got - want) / (fabsf(want) + atol); if (!(e < 1e30f)) e = 1e30f;
    atomicMax(ctl + CW_DIAG + slot, __float_as_uint(e));
}
__device__ __forceinline__ float dg_dot(const h16* arow, const float* W, int K, int ldw, int col) { float s = 0.f; for (int k = 0; k < K; ++k) s += (float)arow[k] * W[(size_t)k * ldw + col]; return s; }
__device__ __forceinline__ void dg_cs(float ang, float& c, float& s_) { const double a = (double)ang; const double tw = 6.283185307179586476925; const double r = a - tw * floor(a / tw); c = cosf((float)r); s_ = sinf((float)r); }
__device__ __forceinline__ int dg_tstart(const unsigned* cnt, int e) { int s = 0; for (int j = 0; j < e; ++j) s += ((j < 64 ? (int)cnt[64 * j] : NTOK) + 255) >> 8; return s; }
__global__ void __launch_bounds__(256) diag_check(Args a, int phase) {
    unsigned char* ws = a.ws; unsigned* ctl = (unsigned*)(ws + WS_CTL);
    const int gid = blockIdx.x * 256 + threadIdx.x; const unsigned h0 = hsh(gid * 7919u + phase * 104729u + 12345u), h1v = hsh(h0 + 1u), h2v = hsh(h0 + 2u);
    const float* mod = (const float*)(ws + WS_MOD);
    __shared__ float red[256 * 6]; __shared__ float sc64[64]; __shared__ float bs64[64];
    if (phase == 0) {
        if (gid < 512) { const int b = h0 & 3, j = h1v % 12288; float s = 0.f; for (int k = 0; k < DM; ++k) { const float v = a.c[b * DM + k]; s += v / (1.f + expf(-v)) * a.w_ada[(size_t)k * 12288 + j]; }
            dg_put(ctl, 0, mod[b * 12288 + j], s + a.b_ada[j], 0.02f); }
        else if (gid < 4096) { const int which = h0 % 9; const int e = h1v & 63; float got, want;
            if (which == 0) { const int k = h2v % DM, n = hsh(h2v) % 9792; got = (float)((const h16*)(ws + W_IN))[(size_t)row_in(n) * DM + k]; want = a.w_in[(size_t)k * 9792 + n]; }
            else if (which == 1) { const int k = h2v % 512, n = hsh(h2v) % 1536; got = (float)((const h16*)(ws + W_QUP))[(size_t)row_qup(n) * 512 + k]; want = a.w_q_up[(size_t)k * 1536 + n] * a.q_a_norm_g[k]; }
            else if (which == 2) { const int k = h2v % 512, n = hsh(h2v) % 2048; got = (float)((const h16*)(ws + W_KVUP))[(size_t)n * 512 + k]; want = a.w_kv_up[(size_t)k * 2048 + n] * a.kv_a_norm_g[k]; }
            else if (which == 3) { const int k = h2v % 1024, n = hsh(h2v) % 2048; got = (float)((const h16*)(ws + W_MO))[(size_t)n * 1024 + k]; want = a.w_mla_o[(size_t)k * 2048 + n]; }
            else if (which == 4) { const int k = h2v % 512, n = hsh(h2v) % 2048; got = (float)((const h16*)(ws + W_DO))[(size_t)n * 512 + k]; want = a.w_dil_o[(size_t)k * 2048 + n]; }
            else if (which == 5) { const int k = h2v % DM, n = hsh(h2v) % 2048; got = (float)((const h16*)(ws + W_OUT))[(size_t)n * DM + k]; want = a.w_out[(size_t)k * DM + n]; }
            else if (which == 6) { const int k = h2v % DM, n = hsh(h2v) % 64; got = (float)((const h16*)(ws + W_R))[(size_t)n * DM + k]; want = a.w_router[(size_t)k * 64 + n]; }
            else if (which == 7) { const int k = h2v % DM, n = hsh(h2v) % 512, up = (h2v >> 20) & 1; const int ee = (h1v % 65);
                got = (float)((const h16*)(ws + W_GU))[((size_t)ee * 1024 + (n >> 7) * 256 + up * 128 + (n & 127)) * DM + k];
                const float* src = ee < 64 ? (up ? a.w_exp_up : a.w_exp_gate) + (size_t)ee * DM * 512 : (up ? a.w_sh_up : a.w_sh_gate); want = src[(size_t)k * 512 + n]; }
            else { const int k = h2v % 512, n = hsh(h2v) % DM; const int ee = (h1v % 65);
                got = (float)((const h16*)(ws + W_DN))[((size_t)ee * 2048 + n) * 512 + k]; const float* src = ee < 64 ? a.w_exp_down + (size_t)ee * 512 * DM : a.w_sh_down; want = src[(size_t)k * DM + n]; }
            (void)e; dg_put(ctl, 0, got, want, 1e-3f); }
        else if (gid < 8192) { const int t = h0 % NTOK, j = h1v % 48; const float pf = (float)a.pos[t]; float c, s_;
            if (j < 16) { dg_cs(pf * a.invf_d[j], c, s_); dg_put(ctl, 0, ((const float*)(ws + WS_COSD))[t * 16 + j], c, 0.05f); dg_put(ctl, 0, ((const float*)(ws + WS_SIND))[t * 16 + j], s_, 0.05f); }
            else { dg_cs(pf * a.invf_m[j - 16], c, s_); dg_put(ctl, 0, ((const float*)(ws + WS_COSM))[t * 32 + j - 16], c, 0.05f); dg_put(ctl, 0, ((const float*)(ws + WS_SINM))[t * 32 + j - 16], s_, 0.05f); } }
    } else if (phase == 1) {
        if (gid < 2048) { const int t = h0 % NTOK, c = h1v % DM, b = t >> 12; float ss = 0.f; for (int k = 0; k < DM; ++k) { const float v = a.x[(size_t)t * DM + k]; ss += v * v; }
            const float rstd = 1.f / sqrtf(ss / DM + EPS); const float want = a.x[(size_t)t * DM + c] * rstd * a.attn_pre_g[c] * (1.f + mod[b * 12288 + 2048 + c]) + mod[b * 12288 + c];
            dg_put(ctl, 1, (float)((const h16*)(ws + A_H1))[(size_t)t * DM + c], want, 0.05f); }
    } else if (phase == 2) {
        const h16* h1 = (const h16*)(ws + A_H1);
        if (gid < 4096) { const int t = h0 % NTOK; int c = h1v % 9792; const h16* ar = h1 + (size_t)t * DM; const float pf = (float)a.pos[t]; float got, want;
            if (c < 1024) { want = dg_dot(ar, a.w_in, DM, 9792, c); got = (float)((const h16*)(ws + A_QA))[(size_t)t * 1024 + c]; }
            else if (c < 1088) { const int i = (c - 1024) & 31, second = (c - 1024) >> 5; const float t1 = dg_dot(ar, a.w_in, DM, 9792, 1024 + i), t2 = dg_dot(ar, a.w_in, DM, 9792, 1024 + 32 + i);
                float cs, sn; dg_cs(pf * a.invf_m[i], cs, sn); want = second ? t2 * cs + t1 * sn : t1 * cs - t2 * sn; got = (float)((const h16*)(ws + A_KR))[(size_t)t * 64 + 2 * i + second]; }
            else if (c < 5696) { const int dc = c - 1088, part = dc / 1536, hd = (dc % 1536) >> 7, dim = dc & 127;
                if (part < 2 && dim < 32) { const int i = dim & 15, second = dim >> 4; const int cb = c - dim; const float t1 = dg_dot(ar, a.w_in, DM, 9792, cb + i), t2 = dg_dot(ar, a.w_in, DM, 9792, cb + 16 + i);
                    float cs, sn; dg_cs(pf * a.invf_d[i], cs, sn); want = second ? t2 * cs + t1 * sn : t1 * cs - t2 * sn; if (part == 0) want *= QS_D;
                    got = (float)((const h16*)(ws + A_DIL))[(size_t)t * 4608 + part * 1536 + hd * 128 + 2 * i + second]; }
                else { want = dg_dot(ar, a.w_in, DM, 9792, c); if (part == 0) want *= QS_D; got = (float)((const h16*)(ws + A_DIL))[(size_t)t * 4608 + dc]; } }
            else { want = 1.f / (1.f + expf(-dg_dot(ar, a.w_in, DM, 9792, c))); got = (float)((const h16*)(ws + A_GATE))[(size_t)t * 4096 + (c - 5696)]; }
            dg_put(ctl, 2, got, want, 0.05f); }
        else if (gid < 4608) { const int t = h0 % NTOK, which = h1v & 1; const h16* qa = (const h16*)(ws + A_QA) + (size_t)t * 1024 + which * 512; float ss = 0.f; for (int k = 0; k < 512; ++k) ss += (float)qa[k] * (float)qa[k];
            const float* rq = (const float*)(ws + WS_ROWSQ) + (size_t)t * 16 + which * 8; float g = 0.f; for (int k = 0; k < 8; ++k) g += rq[k]; dg_put(ctl, 2, g, ss, 1.0f); }
    } else if (phase == 3) {
        if (gid < 4096) { const int t = h0 % NTOK, which = h1v & 1; const h16* qa = (const h16*)(ws + A_QA) + (size_t)t * 1024 + which * 512; const float pf = (float)a.pos[t];
            float ss = 0.f; for (int k = 0; k < 512; ++k) ss += (float)qa[k] * (float)qa[k]; const float rstd = 1.f / sqrtf(ss / 512.f + EPS); float got, want;
            if (which == 0) { const int cq = h2v % 1536, hd = cq / 192, j = cq % 192;
                if (j < 128) { float s_ = 0.f; for (int k = 0; k < 512; ++k) s_ += (float)qa[k] * rstd * a.q_a_norm_g[k] * a.w_q_up[(size_t)k * 1536 + cq]; want = s_ * QS_M; got = (float)((const h16*)(ws + A_QM))[(size_t)t * 1536 + hd * 128 + j]; }
                else { const int i = (j - 128) & 31, second = (j - 128) >> 5; float t1 = 0.f, t2 = 0.f;
                    for (int k = 0; k < 512; ++k) { const float nv = (float)qa[k] * rstd * a.q_a_norm_g[k]; t1 += nv * a.w_q_up[(size_t)k * 1536 + hd * 192 + 128 + i]; t2 += nv * a.w_q_up[(size_t)k * 1536 + hd * 192 + 160 + i]; }
                    float cs, sn; dg_cs(pf * a.invf_m[i], cs, sn); want = (second ? t2 * cs + t1 * sn : t1 * cs - t2 * sn) * QS_M; got = (float)((const h16*)(ws + A_QM))[(size_t)t * 1536 + 1024 + hd * 64 + 2 * i + second]; } }
            else { const int c = h2v % 2048; float s_ = 0.f; for (int k = 0; k < 512; ++k) s_ += (float)qa[k] * rstd * a.kv_a_norm_g[k] * a.w_kv_up[(size_t)k * 2048 + c]; want = s_; got = (float)((const h16*)(ws + A_KV))[(size_t)t * 2048 + c]; }
            dg_put(ctl, 3, got, want, 0.05f); }
    } else if (phase == 4) {
        const unsigned hb = hsh(blockIdx.x * 2654435761u + 777u); const int t = hb % NTOK, b = t >> 12, sp = t & 4095; const int tid = threadIdx.x;
        float m = -1e30f, l = 0.f, o0 = 0.f, o1 = 0.f, o2 = 0.f, o3 = 0.f; const int dsel = (hb >> 16) & 31;
        if (blockIdx.x < 96) { const int hd = (hb >> 21) & 7; const h16* q = (const h16*)(ws + A_QM) + (size_t)t * 1536;
            for (int kp = tid; kp <= sp; kp += 256) { const size_t tk = (size_t)b * SEQ + kp; const h16* kk = (const h16*)(ws + A_KV) + tk * 2048 + hd * 256; const h16* kr = (const h16*)(ws + A_KR) + tk * 64;
                float s_ = 0.f; for (int d = 0; d < 128; ++d) s_ += (float)q[hd * 128 + d] * (float)kk[d]; for (int d = 0; d < 64; ++d) s_ += (float)q[1024 + hd * 64 + d] * (float)kr[d];
                const float mn = fmaxf(m, s_), al = exp2f(m - mn), pp = exp2f(s_ - mn); l = l * al + pp; o0 = o0 * al + pp * (float)kk[128 + dsel]; o1 = o1 * al + pp * (float)kk[128 + dsel + 32]; o2 = o2 * al + pp * (float)kk[128 + dsel + 64]; o3 = o3 * al + pp * (float)kk[128 + dsel + 96]; m = mn; }
        } else { const int head = (hb >> 21) % 12, g = head >> 2, dd = g == 0 ? 1 : g == 1 ? 4 : 16; const h16* q = (const h16*)(ws + A_DIL) + (size_t)t * 4608 + head * 128;
            for (int j = tid; j <= 128; j += 256) { const int kp = sp - dd * j; if (kp < 0) continue; const size_t tk = (size_t)b * SEQ + kp; const h16* kk = (const h16*)(ws + A_DIL) + tk * 4608 + 1536 + head * 128; const h16* vv = (const h16*)(ws + A_DIL) + tk * 4608 + 3072 + head * 128;
                float s_ = 0.f; for (int d = 0; d < 128; ++d) s_ += (float)q[d] * (float)kk[d];
                const float mn = fmaxf(m, s_), al = exp2f(m - mn), pp = exp2f(s_ - mn); l = l * al + pp; o0 = o0 * al + pp * (float)vv[dsel]; o1 = o1 * al + pp * (float)vv[dsel + 32]; o2 = o2 * al + pp * (float)vv[dsel + 64]; o3 = o3 * al + pp * (float)vv[dsel + 96]; m = mn; } }
        red[tid * 6 + 0] = m; red[tid * 6 + 1] = l; red[tid * 6 + 2] = o0; red[tid * 6 + 3] = o1; red[tid * 6 + 4] = o2; red[tid * 6 + 5] = o3; __syncthreads();
        if (tid == 0) { float M = -1e30f; for (int i = 0; i < 256; ++i) M = fmaxf(M, red[i * 6]); float L = 0.f, O0 = 0.f, O1 = 0.f, O2 = 0.f, O3 = 0.f;
            for (int i = 0; i < 256; ++i) { const float w = exp2f(red[i * 6] - M); L += red[i * 6 + 1] * w; O0 += red[i * 6 + 2] * w; O1 += red[i * 6 + 3] * w; O2 += red[i * 6 + 4] * w; O3 += red[i * 6 + 5] * w; }
            if (blockIdx.x < 96) { const int hd = (hb >> 21) & 7; const h16* og = (const h16*)(ws + A_OMLA) + (size_t)t * 1024 + hd * 128;
                dg_put(ctl, 4, (float)og[dsel], O0 / L, 0.02f); dg_put(ctl, 4, (float)og[dsel + 32], O1 / L, 0.02f); dg_put(ctl, 4, (float)og[dsel + 64], O2 / L, 0.02f); dg_put(ctl, 4, (float)og[dsel + 96], O3 / L, 0.02f); }
            else { const int head = (hb >> 21) % 12; const h16* og = (const h16*)(ws + A_OD) + (size_t)t * 1536 + head * 128;
                dg_put(ctl, 5, (float)og[dsel], O0 / L, 0.02f); dg_put(ctl, 5, (float)og[dsel + 32], O1 / L, 0.02f); dg_put(ctl, 5, (float)og[dsel + 64], O2 / L, 0.02f); dg_put(ctl, 5, (float)og[dsel + 96], O3 / L, 0.02f);
                dg_put(ctl, 5, ((const float*)(ws + WS_LSE))[(size_t)t * 12 + head], M + log2f(L), 0.5f); } }
    } else if (phase == 5) {
        if (gid < 2048) { const int t = h0 % NTOK, n = h1v % DM; const float want = dg_dot((const h16*)(ws + A_OMLA) + (size_t)t * 1024, a.w_mla_o, 1024, DM, n) * (float)((const h16*)(ws + A_GATE))[(size_t)t * 4096 + n];
            dg_put(ctl, 6, (float)((const h16*)(ws + A_M1))[(size_t)t * DM + n], want, 0.05f); }
        else if (gid < 4096) { const int t = h0 % NTOK, hs = h1v & 3, d = h2v & 127; const float* ls = (const float*)(ws + WS_LSE) + (size_t)t * 12; const h16* od = (const h16*)(ws + A_OD) + (size_t)t * 1536;
            const float mx = fmaxf(ls[hs], fmaxf(ls[4 + hs], ls[8 + hs])); const float w0 = exp2f(ls[hs] - mx), w1 = exp2f(ls[4 + hs] - mx), w2 = exp2f(ls[8 + hs] - mx);
            const float want = (w0 * (float)od[hs * 128 + d] + w1 * (float)od[512 + hs * 128 + d] + w2 * (float)od[1024 + hs * 128 + d]) / (w0 + w1 + w2);
            dg_put(ctl, 7, (float)((const h16*)(ws + A_ODIL))[(size_t)t * 512 + hs * 128 + d], want, 0.02f); }
    } else if (phase == 6) {
        if (gid < 2048) { const int t = h0 % NTOK, n = h1v % DM; const float want = (float)((const h16*)(ws + A_M1))[(size_t)t * DM + n] + dg_dot((const h16*)(ws + A_ODIL) + (size_t)t * 512, a.w_dil_o, 512, DM, n) * (float)((const h16*)(ws + A_GATE))[(size_t)t * 4096 + 2048 + n];
            dg_put(ctl, 8, (float)((const h16*)(ws + A_MRG))[(size_t)t * DM + n], want, 0.05f); }
    } else if (phase == 7) {
        if (gid < 2048) { const int t = h0 % NTOK, n = h1v % DM; const float want = dg_dot((const h16*)(ws + A_MRG) + (size_t)t * DM, a.w_out, DM, DM, n);
            dg_put(ctl, 9, (float)((const h16*)(ws + A_YAT))[(size_t)t * DM + n], want, 0.05f); }
    } else if (phase == 8) {
        if (gid < 1024) { const int t = h0 % NTOK, c = h1v % DM, b = t >> 12; const h16* y = (const h16*)(ws + A_YAT) + (size_t)t * DM; float ss = 0.f; for (int k = 0; k < DM; ++k) ss += (float)y[k] * (float)y[k];
            const float r1 = 1.f / sqrtf(ss / DM + EPS); float ss2 = 0.f, xc = 0.f;
            for (int k = 0; k < DM; ++k) { const float xm = a.x[(size_t)t * DM + k] + mod[b * 12288 + 4096 + k] * ((float)y[k] * r1 * a.attn_post_g[k]); ss2 += xm * xm; if (k == c) xc = xm; }
            const float r2 = 1.f / sqrtf(ss2 / DM + EPS);
            dg_put(ctl, 10, a.out[(size_t)t * DM + c], xc, 0.05f);
            dg_put(ctl, 10, (float)((const h16*)(ws + A_H2))[(size_t)t * DM + c], xc * r2 * a.ffn_pre_g[c] * (1.f + mod[b * 12288 + 4 * 2048 + c]) + mod[b * 12288 + 3 * 2048 + c], 0.05f); }
        if (blockIdx.x >= 8 && blockIdx.x < 72) {
            const unsigned hb = hsh(blockIdx.x * 2654435761u + 99u); const int t = hb % NTOK; const int tid = threadIdx.x;
            if (tid < 64) { const float lgt = dg_dot((const h16*)(ws + A_H2) + (size_t)t * DM, a.w_router, DM, 64, tid); const float sc = 1.f / (1.f + expf(-lgt)); sc64[tid] = sc; bs64[tid] = sc + a.router_bias[tid]; }
            __syncthreads();
            if (tid == 0) { unsigned gsel = 0u; float bad = 0.f;
                for (int r = 0; r < 4; ++r) { int best = -1; float bv = -1e30f; for (int g = 0; g < 8; ++g) { if (gsel >> g & 1u) continue; float m1 = -1e30f, m2 = -1e30f; for (int j = 0; j < 8; ++j) { const float v = bs64[g * 8 + j]; if (v > m1) { m2 = m1; m1 = v; } else if (v > m2) m2 = v; } if (m1 + m2 > bv) { bv = m1 + m2; best = g; } } gsel |= 1u << best; }
                unsigned long long esel = 0ull; float wsum = 0.f;
                for (int r = 0; r < 6; ++r) { int best = -1; float bv = -1e30f; for (int e = 0; e < 64; ++e) { if (!(gsel >> (e >> 3) & 1u) || (esel >> e & 1ull)) continue; if (bs64[e] > bv) { bv = bs64[e]; best = e; } } esel |= 1ull << best; wsum += sc64[best];
                    const unsigned pk = ((const unsigned*)(ws + WS_TOKPOS))[(size_t)t * 6 + r]; const int ge = pk >> 20, slot = pk & 0xFFFFF; if (ge != best) bad += 1.f; else if (((const unsigned*)(ws + WS_LIST))[(size_t)ge * LISTCAP + slot] != (unsigned)t) bad += 1.f; }
                for (int r = 0; r < 6; ++r) { const unsigned pk = ((const unsigned*)(ws + WS_TOKPOS))[(size_t)t * 6 + r]; const int ge = pk >> 20; const float w = ((const float*)(ws + WS_TOKW))[(size_t)t * 6 + r]; if (fabsf(w - sc64[ge] / (wsum + 1e-20f) * 2.5f) > 0.01f) bad += 1.f; }
                atomicAdd((float*)(ctl + CW_DIAG + 11), bad / (64.f * 12.f)); }
        }
        if (gid == 0) { unsigned tot = 0; for (int e = 0; e < 64; ++e) tot += ctl[CW_CNT + 64 * e]; dg_put(ctl, 10, (float)tot, (float)(NTOK * 6), 1.0f); }
    } else if (phase == 9 || phase == 10) {
        const unsigned* cnt = ctl + CW_CNT;
        if (gid < 2048) { const int t = h0 % NTOK, k = h1v % 7; int e, slot; if (k == 6) { e = 64; slot = t; } else { const unsigned pk = ((const unsigned*)(ws + WS_TOKPOS))[(size_t)t * 6 + k]; e = pk >> 20; slot = pk & 0xFFFFF; }
            const size_t prow = (size_t)dg_tstart(cnt, e) * 256 + slot;
            if (phase == 9) { const int n = h2v % 512; const float* wg = e < 64 ? a.w_exp_gate + (size_t)e * DM * 512 : a.w_sh_gate; const float* wu = e < 64 ? a.w_exp_up + (size_t)e * DM * 512 : a.w_sh_up;
                const h16* hr = (const h16*)(ws + A_H2) + (size_t)t * DM; const float g = dg_dot(hr, wg, DM, 512, n), u = dg_dot(hr, wu, DM, 512, n);
                dg_put(ctl, 12, (float)((const h16*)(ws + A_ACT))[prow * 512 + n], g / (1.f + expf(-g)) * u, 0.05f); }
            else { const int n = h2v % DM; const float* wd = e < 64 ? a.w_exp_down + (size_t)e * 512 * DM : a.w_sh_down;
                dg_put(ctl, 13, (float)((const h16*)(ws + A_YS))[prow * DM + n], dg_dot((const h16*)(ws + A_ACT) + prow * 512, wd, 512, DM, n), 0.05f); } }
    } else if (phase == 100) {
        const int si = blockIdx.x; if (si < 64) { const int t = hsh(si * 31337u + 5u) % NTOK; float* sv = (float*)(ws + WS_SAVE) + (size_t)si * DM; for (int c = threadIdx.x; c < DM; c += 256) sv[c] = a.out[(size_t)t * DM + c]; }
    } else if (phase == 11) {
        const int si = blockIdx.x; if (si < 64) { const int t = hsh(si * 31337u + 5u) % NTOK, b = t >> 12; const unsigned* cnt = ctl + CW_CNT; const float* sv = (const float*)(ws + WS_SAVE) + (size_t)si * DM; const int tid = threadIdx.x;
            float vals[8]; float ss = 0.f;
#pragma unroll
            for (int q = 0; q < 8; ++q) { const int c = tid + 256 * q; float s_ = (float)((const h16*)(ws + A_YS))[((size_t)dg_tstart(cnt, 64) * 256 + t) * DM + c];
                for (int k = 0; k < 6; ++k) { const unsigned pk = ((const unsigned*)(ws + WS_TOKPOS))[(size_t)t * 6 + k]; const int e = pk >> 20, slot = pk & 0xFFFFF;
                    s_ += ((const float*)(ws + WS_TOKW))[(size_t)t * 6 + k] * (float)((const h16*)(ws + A_YS))[((size_t)dg_tstart(cnt, e) * 256 + slot) * DM + c]; }
                vals[q] = s_; ss += s_ * s_; }
            red[tid] = ss; __syncthreads(); if (tid == 0) { float tot = 0.f; for (int i = 0; i < 256; ++i) tot += red[i]; red[256] = tot; } __syncthreads();
            const float rstd = 1.f / sqrtf(red[256] / DM + EPS);
#pragma unroll
            for (int q = 0; q < 8; ++q) { const int c = tid + 256 * q; dg_put(ctl, 14, a.out[(size_t)t * DM + c], sv[c] + mod[b * 12288 + 5 * 2048 + c] * (vals[q] * rstd * a.ffn_post_g[c]), 0.05f); } }
    }
}
__global__ void __launch_bounds__(256) diag_final(Args a) {
    unsigned* ctl = (unsigned*)(a.ws + WS_CTL); int code = 0;
    for (int sl = 14; sl >= 0; --sl) { const float e = __uint_as_float(ctl[CW_DIAG + sl]); const float thr = (sl == 11) ? 0.08f : 0.03f; if (!(e <= thr)) code = sl + 1; }
    if (code == 0) return;
    const float f = 1.0f + 0.5f * (float)code;
    for (size_t i = (size_t)blockIdx.x * 256 + threadIdx.x; i < (size_t)NTOK * DM; i += (size_t)gridDim.x * 256) a.out[i] = a.x[i] * f;
}
#endif

extern "C" void kernel_launch(void* const* d_in, const int* in_sizes, int n_in, void* d_out, int out_size, void* d_ws, size_t ws_size, hipStream_t stream) {
    static int grid = 0;
    if (grid == 0) {
        if (n_in != 25 || in_sizes[0] != NTOK * DM || out_size != NTOK * DM || ws_size < WS_END) {
            fprintf(stderr, "kernel_launch: unexpected shapes / workspace (n_in %d, ws %zu, need %zu); nothing launched\n", n_in, ws_size, (size_t)WS_END); grid = -1; return; }
        int dev = 0, cus = 0, per_cu = 0;
        if (hipGetDevice(&dev) != hipSuccess || hipDeviceGetAttribute(&cus, hipDeviceAttributeMultiprocessorCount, dev) != hipSuccess) { grid = -1; return; }
        if (hipFuncSetAttribute((const void*)mk_fwd, hipFuncAttributeMaxDynamicSharedMemorySize, LDS_BYTES) != hipSuccess) { fprintf(stderr, "kernel_launch: hipFuncSetAttribute failed\n"); grid = -1; return; }
        if (hipOccupancyMaxActiveBlocksPerMultiprocessor(&per_cu, (const void*)mk_fwd, NTHR, LDS_BYTES) != hipSuccess || per_cu < 1)
            fprintf(stderr, "kernel_launch: note: occupancy query reports %d workgroups per CU\n", per_cu);
        (void)hipGetLastError();
        grid = cus;
    }
    if (grid < 0) return;
    if (hipMemsetAsync((char*)d_ws + WS_CTL, 0, CTL_ZERO_BYTES, stream) != hipSuccess) return;
    Args a{};
    a.x = (const float*)d_in[0]; a.c = (const float*)d_in[1]; a.pos = (const int*)d_in[2]; a.w_ada = (const float*)d_in[3]; a.b_ada = (const float*)d_in[4];
    a.attn_pre_g = (const float*)d_in[5]; a.w_in = (const float*)d_in[6]; a.q_a_norm_g = (const float*)d_in[7]; a.w_q_up = (const float*)d_in[8];
    a.kv_a_norm_g = (const float*)d_in[9]; a.w_kv_up = (const float*)d_in[10]; a.w_mla_o = (const float*)d_in[11]; a.w_dil_o = (const float*)d_in[12];
    a.w_out = (const float*)d_in[13]; a.attn_post_g = (const float*)d_in[14]; a.ffn_pre_g = (const float*)d_in[15]; a.w_router = (const float*)d_in[16];
    a.router_bias = (const float*)d_in[17]; a.w_exp_gate = (const float*)d_in[18]; a.w_exp_up = (const float*)d_in[19]; a.w_exp_down = (const float*)d_in[20];
    a.w_sh_gate = (const float*)d_in[21]; a.w_sh_up = (const float*)d_in[22]; a.w_sh_down = (const float*)d_in[23]; a.ffn_post_g = (const float*)d_in[24];
    a.out = (float*)d_out; a.ws = (unsigned char*)d_ws;
    for (int i = 0; i < 16; ++i) a.invf_d[i] = 1.0f / powf(500000.0f, (float)(2 * i) / 32.0f);
    for (int i = 0; i < 32; ++i) a.invf_m[i] = 1.0f / powf(500000.0f, (float)(2 * i) / 64.0f);
#if MK_LAUNCHES == 1
    a.ph_lo = 0; a.ph_hi = NPHASE;
    hipLaunchKernelGGL(mk_fwd, dim3(grid), dim3(NTHR), LDS_BYTES, stream, a);
#else
#ifndef MK_STOP
#define MK_STOP NPHASE
#endif
    for (int p = 0; p < MK_STOP; ++p) { a.ph_lo = p; a.ph_hi = p + 1;
#if MK_DIAG
        if (p == 11) hipLaunchKernelGGL(diag_check, dim3(256), dim3(256), 0, stream, a, 100);
#endif
        hipLaunchKernelGGL(mk_fwd, dim3(grid), dim3(NTHR), LDS_BYTES, stream, a);
#if MK_DIAG
        hipLaunchKernelGGL(diag_check, dim3(256), dim3(256), 0, stream, a, p);
#endif
    }
#if MK_DIAG
    hipLaunchKernelGGL(diag_final, dim3(1024), dim3(256), 0, stream, a);
#endif
#endif
}
```

```cpp
#include <hip/hip_runtime.h>
#include <cstdio>
#include <cstdint>
#include <cmath>

#ifndef MK_LAUNCHES
#define MK_LAUNCHES 1
#endif
#ifndef MK_DIAG
#define MK_DIAG 0
#endif

#define GAS __attribute__((address_space(1)))
#define LAS __attribute__((address_space(3)))
typedef _Float16 h16;
typedef _Float16 h16x8 __attribute__((ext_vector_type(8)));
typedef _Float16 h16x4 __attribute__((ext_vector_type(4)));
typedef _Float16 h16x2 __attribute__((ext_vector_type(2)));
typedef short s16x4 __attribute__((ext_vector_type(4)));
typedef float f32x4 __attribute__((ext_vector_type(4)));
typedef float f32x2 __attribute__((ext_vector_type(2)));
typedef float f32x16 __attribute__((ext_vector_type(16)));
typedef unsigned u32x4 __attribute__((ext_vector_type(4)));
typedef unsigned u32x2 __attribute__((ext_vector_type(2)));
typedef int i32x8 __attribute__((ext_vector_type(8)));
typedef int i32x4 __attribute__((ext_vector_type(4)));

constexpr int NB = 4, SEQ = 4096, NTOK = NB * SEQ, DM = 2048;
constexpr int NPROJ = 9984;
constexpr int NEXP = 64, TOPK = 6, EDIM = 512;
constexpr int LISTCAP = 16384;
constexpr int MAXTILES = 512;
constexpr float EPS = 1e-6f;
constexpr float LOG2E = 1.4426950408889634f;
constexpr float QS_M = 0.07216878364870322f * LOG2E;
constexpr float QS_D = 0.08838834764831845f * LOG2E;
constexpr float SC_GU = 64.0f, SC_DN = 32.0f;

constexpr size_t MiB = 1u << 20;
constexpr size_t WS_CTL = 0, CTL_ZERO_BYTES = 1 * MiB;
constexpr size_t WS_ROWSQ = 1 * MiB;
constexpr size_t WS_MOD = 2 * MiB;
constexpr size_t WS_COSD = 3 * MiB, WS_SIND = 4 * MiB;
constexpr size_t WS_COSM = 5 * MiB, WS_SINM = 7 * MiB;
constexpr size_t WS_LSE = 9 * MiB;
constexpr size_t WS_TOKPOS = 10 * MiB;
constexpr size_t WS_TOKW = 10 * MiB + 512 * 1024;
constexpr size_t WS_LIST = 11 * MiB;
constexpr size_t WS_W = 16 * MiB;
constexpr size_t W_IN = WS_W;
constexpr size_t W_QUP = W_IN + 39 * MiB;
constexpr size_t W_KVUP = W_QUP + 3 * MiB / 2;
constexpr size_t W_MO = W_KVUP + 2 * MiB;
constexpr size_t W_DO = W_MO + 4 * MiB;
constexpr size_t W_OUT = W_DO + 2 * MiB;
constexpr size_t W_R = W_OUT + 8 * MiB;
constexpr size_t W_GU = W_R + MiB / 4;
constexpr size_t W_DN = W_GU + 260 * MiB;
constexpr size_t WS_AR = W_DN + 130 * MiB;
static_assert(WS_AR == (16 + 447) * MiB - MiB / 4, "weights");
constexpr size_t AR = ((WS_AR + MiB - 1) / MiB) * MiB;
constexpr size_t A_YS = AR + 0 * MiB;
constexpr size_t A_ACT = AR + 512 * MiB;
constexpr size_t A_H2 = AR + 0 * MiB;
constexpr size_t A_YAT = AR + 64 * MiB;
constexpr size_t A_MRG = AR + 128 * MiB;
constexpr size_t A_GATE = AR + 192 * MiB;
constexpr size_t A_M1 = AR + 320 * MiB;
constexpr size_t A_XMID = AR + 320 * MiB;
constexpr size_t A_CAT = AR + 384 * MiB;
constexpr size_t A_ODIL = A_CAT, A_OMLA = A_CAT;
constexpr size_t A_OD = AR + 432 * MiB;
constexpr size_t A_DIL = AR + 0 * MiB;
constexpr size_t A_QM = AR + 144 * MiB;
constexpr size_t A_KV = AR + 480 * MiB;
constexpr size_t A_KR = AR + 544 * MiB;
constexpr size_t A_QA = AR + 546 * MiB;
constexpr size_t A_H1 = AR + 480 * MiB;
constexpr size_t WS_END = AR + 640 * MiB;

constexpr int CW_BAR = 0;
constexpr int CW_CNT = 16384;
constexpr int CW_DIAG = 32768;

constexpr int LDS_BYTES = 147456;
constexpr int LDS_TAB = 131072;
constexpr int LDS_MISC = LDS_BYTES - 64;
constexpr int NWAVES = 8, NTHR = 512;

#define LDS_WAIT() asm volatile("s_waitcnt lgkmcnt(0)" ::: "memory")
#define VM_WAIT() asm volatile("s_waitcnt vmcnt(0)" ::: "memory")

__device__ __forceinline__ unsigned pkh(float a, float b) { h16x2 r; r.x = (h16)a; r.y = (h16)b; return __builtin_bit_cast(unsigned, r); }
__device__ __forceinline__ u32x4 pk8(f32x4 a, f32x4 b) { u32x4 w; w.x = pkh(a[0], a[1]); w.y = pkh(a[2], a[3]); w.z = pkh(b[0], b[1]); w.w = pkh(b[2], b[3]); return w; }
__device__ __forceinline__ unsigned pk4_fp8(float a, float b, float c, float d) { int w = 0; w = __builtin_amdgcn_cvt_pk_fp8_f32(a, b, w, false); w = __builtin_amdgcn_cvt_pk_fp8_f32(c, d, w, true); return (unsigned)w; }
__device__ __forceinline__ float wave_sum(float v) {
#pragma unroll
    for (int o = 1; o < 64; o <<= 1) v += __shfl_xor(v, o);
    return v;
}
__device__ __forceinline__ float sigmoidf_(float x) { return __builtin_amdgcn_rcpf(1.0f + __builtin_amdgcn_exp2f(x * -1.4426950408889634f)); }

#define XB_TMO      128
#define XB_XCNT(j)  (256  + 64 * (j))
#define XB_XSUB(j)  (1280 + 64 * (j))
#define XB_XGEN(j)  (2304 + 64 * (j))
#define XB_TOP      3328
#define XB_TOPGEN   3392
#define XCD_BAR_WORDS 3456
#define XB_SPIN_CAP (1u << 18)
__device__ __forceinline__ unsigned xb_ld(unsigned* p)              { return __hip_atomic_load(p, __ATOMIC_RELAXED, __HIP_MEMORY_SCOPE_AGENT); }
__device__ __forceinline__ unsigned xb_add(unsigned* p, unsigned v) { return __hip_atomic_fetch_add(p, v, __ATOMIC_RELAXED, __HIP_MEMORY_SCOPE_AGENT); }
__device__ __forceinline__ unsigned xb_xcc_id() { return (unsigned)__builtin_amdgcn_s_getreg((3 << 11) | 20) & 0xFu; }
#define XB_SPIN(cond, bar) do { unsigned _sp = 0; while (cond) { __builtin_amdgcn_s_sleep(1); \
    if ((++_sp & 255u) == 0u) { if (xb_ld(&(bar)[XB_TMO])) break; if (_sp > XB_SPIN_CAP) { atomicAdd(&(bar)[XB_TMO], 1u); break; } } } } while (0)
struct XcdBarrier { unsigned* bar; unsigned x; volatile LAS unsigned* st; };
__device__ __forceinline__ XcdBarrier xcd_barrier_post(unsigned* bar, volatile LAS unsigned* st) {
    XcdBarrier b; b.bar = bar; b.x = xb_xcc_id(); b.st = st;
    if (threadIdx.x == 0) (void)xb_add(&bar[XB_XCNT(b.x)], 1u);
    return b;
}
__device__ __forceinline__ void xcd_barrier_complete(unsigned* bar, unsigned x, unsigned& nloc, unsigned& nx) {
    const unsigned G = gridDim.x * gridDim.y * gridDim.z;
    unsigned sum, cnt, mine, sp = 0u;
    for (;;) {
        sum = 0u; cnt = 0u; mine = 0u;
#pragma unroll
        for (unsigned j = 0; j < 16; ++j) { const unsigned c = xb_ld(&bar[XB_XCNT(j)]); sum += c; cnt += (c > 0u) ? 1u : 0u; mine = (j == x) ? c : mine; }
        if (sum == G) break;
        __builtin_amdgcn_s_sleep(1);
        if ((++sp & 255u) == 0u) { if (xb_ld(&bar[XB_TMO])) break; if (sp > XB_SPIN_CAP) { atomicAdd(&bar[XB_TMO], 1u); break; } }
    }
    nloc = mine > 0u ? mine : 1u; nx = cnt > 0u ? cnt : 1u;
}
__device__ __forceinline__ void xcd_barrier(const XcdBarrier& b) {
    asm volatile("s_waitcnt vmcnt(0)" ::: "memory");
    __syncthreads();
    if (threadIdx.x == 0) {
        unsigned* bar = b.bar;
        __builtin_amdgcn_s_waitcnt(0);
        unsigned nloc = b.st[0], nx = b.st[1];
        if (nloc == 0u) { xcd_barrier_complete(bar, b.x, nloc, nx); b.st[0] = nloc; b.st[1] = nx; }
        const unsigned old = xb_add(&bar[XB_XSUB(b.x)], 1u);
        const unsigned gen = old / nloc;
        if (old + 1u == (gen + 1u) * nloc) {
            __builtin_amdgcn_fence(__ATOMIC_RELEASE, "agent");
            asm volatile("s_waitcnt vmcnt(0)" ::: "memory");
            const unsigned og = xb_add(&bar[XB_TOP], 1u);
            const unsigned tg = og / nx;
            if (og + 1u == (tg + 1u) * nx) xb_add(&bar[XB_TOPGEN], 1u);
            else XB_SPIN(xb_ld(&bar[XB_TOPGEN]) == tg, bar);
            __builtin_amdgcn_fence(__ATOMIC_ACQUIRE, "agent");
            xb_add(&bar[XB_XGEN(b.x)], 1u);
            asm volatile("s_waitcnt vmcnt(0)" ::: "memory");
        } else {
            XB_SPIN(xb_ld(&bar[XB_XGEN(b.x)]) == gen, bar);
            __builtin_amdgcn_fence(__ATOMIC_ACQUIRE, "agent");
            asm volatile("s_waitcnt vmcnt(0)" ::: "memory");
        }
    }
    __syncthreads();
}

struct Args {
    const float* x; const float* c; const int* pos; const float* w_ada; const float* b_ada; const float* attn_pre_g; const float* w_in;
    const float* q_a_norm_g; const float* w_q_up; const float* kv_a_norm_g; const float* w_kv_up; const float* w_mla_o; const float* w_dil_o;
    const float* w_out; const float* attn_post_g; const float* ffn_pre_g; const float* w_router; const float* router_bias;
    const float* w_exp_gate; const float* w_exp_up; const float* w_exp_down; const float* w_sh_gate; const float* w_sh_up; const float* w_sh_down;
    const float* ffn_post_g;
    float* out; unsigned char* ws;
    float invf_d[16]; float invf_m[32];
    int ph_lo, ph_hi;
};

struct Frame {
    LAS unsigned char* lds;
    int tid, lane, wave, vcu, G;
    unsigned char* ws;
};
template <class T> __device__ __forceinline__ T* wsp(const Frame& F, size_t off) { return (T*)(F.ws + off); }

namespace pg8 {
constexpr int BM = 256, BK = 64, HALF = 128, HTB = HALF * BK * 2, STAGE_BYTES = 8 * HTB;
__device__ __forceinline__ int lds_byte(int r, int c) { const int st = (r >> 4) * 2 + (c >> 5), rr = r & 15, cc = c & 31, ob = rr * 64 + cc * 2; return st * 1024 + (ob ^ (((ob >> 9) & 1) << 5)); }
__device__ __forceinline__ void stage_rc(int b, int& R, int& C) { const int st = b / 1024, sb = b % 1024, swz = sb ^ (((sb >> 9) & 1) << 5); R = (st >> 1) * 16 + swz / 64; C = (st & 1) * 32 + (swz % 64) / 2; }
__device__ __forceinline__ int perm32(int rho) { const int n = rho >> 4, i = rho & 15; return 8 * (i >> 2) + 4 * n + (i & 3); }

struct Unit { const char* A; const char* B; int pm, pn, e, slot0, cnt, tag; };
typedef f32x4 Acc[2][2][4][2];

template <bool FP8> struct Frag;
template <> struct Frag<false> { h16x8 h[2]; };
template <> struct Frag<true> { i32x8 f8; };
template <class Epi, class Sched, bool GATHER, bool FP8 = false>
__device__ __forceinline__ void gemm_phase(LAS unsigned char* lds, const int K, const int lda, const Sched& S, const Epi& E) {
    const int tid = threadIdx.x, wid = __builtin_amdgcn_readfirstlane(tid >> 6), lane = tid & 63, wr = wid >> 2, wc = wid & 3, fr = lane & 15, fq = lane >> 4;
    int nt = K / BK; asm volatile("" : "+s"(nt));
    int sc1 = 0x7F7F7F7F; asm volatile("" : "+v"(sc1));
    int sR[2], sC[2];
    unsigned voffB[2], va[2][2], vn[2][2];
#pragma unroll
    for (int i = 0; i < 2; ++i) { int R, C; stage_rc(tid * 16 + i * 8192, R, C); sR[i] = R; sC[i] = C; const int Rb = (R & ~31) + perm32(R & 31);
        voffB[i] = (unsigned)(Rb * K + C) * 2u;
        if constexpr (Epi::PERM16) {
            const int wc_ = R >> 5, rho = R & 31, n_ = rho >> 4, fq_ = (rho & 15) >> 2, j_ = rho & 3;
            voffB[i] = (unsigned)((64 * wc_ + 16 * fq_ + 4 * n_ + j_) * K + C) * 2u; }
        va[0][i] = (unsigned)(R * lda + C) * 2u; va[1][i] = (unsigned)((R + HALF) * lda + C) * 2u; vn[0][i] = va[0][i]; vn[1][i] = va[1][i]; }
    const size_t kstep = (size_t)(BK * 2);
    const size_t hstepB = Epi::PERM16 ? (size_t)8 * K * 2 : (size_t)HALF * K * 2;
    const unsigned ldsw = (unsigned)wid * 1024u;
    const int aoff = lds_byte(wr * 64 + fr, fq * 8), boff = lds_byte(wc * 32 + fr, fq * 8);
#define PG8_SA(b, h) (((b) * 2 + (h)) * HTB)
#define PG8_SB(b, h) ((4 + (b) * 2 + (h)) * HTB)
#define PG8_STAGE(bufoff, gbase, voff) do { _Pragma("unroll") for (int _i = 0; _i < 2; ++_i) \
        __builtin_amdgcn_global_load_lds((const unsigned*)((const char*)(gbase) + (voff)[_i]), (LAS unsigned*)(lds + (bufoff) + ldsw + _i * 8192), 16, 0, 0); } while (0)
#define PG8_LD1(dst, addr) do { if constexpr (FP8) { const i32x4 lo_ = *(const LAS i32x4*)(addr), hi_ = *(const LAS i32x4*)((addr) + 1024); dst.f8 = __builtin_shufflevector(lo_, hi_, 0, 1, 2, 3, 4, 5, 6, 7); } \
        else { dst.h[0] = *(const LAS h16x8*)(addr); dst.h[1] = *(const LAS h16x8*)((addr) + 1024); } } while (0)
#define PG8_LDA(dst, b, h) do { _Pragma("unroll") for (int m = 0; m < 4; ++m) PG8_LD1(dst[m], lds + PG8_SA(b, h) + aoff + m * 2048); } while (0)
#define PG8_LDB(dst, b, h) do { _Pragma("unroll") for (int n = 0; n < 2; ++n) PG8_LD1(dst[n], lds + PG8_SB(b, h) + boff + n * 2048); } while (0)
#define PG8_MMA(ai, bj, At, Bt) do { __builtin_amdgcn_s_setprio(1); _Pragma("unroll") for (int m = 0; m < 4; ++m) _Pragma("unroll") for (int n = 0; n < 2; ++n) { \
        if constexpr (FP8) asm volatile("v_mfma_scale_f32_16x16x128_f8f6f4 %0, %1, %2, %0, %3, %3 op_sel_hi:[0,0,0]" : "+v"(acc[ai][bj][m][n]) : "v"(Bt[n].f8), "v"(At[m].f8), "v"(sc1)); \
        else { _Pragma("unroll") for (int k = 0; k < 2; ++k) acc[ai][bj][m][n] = __builtin_amdgcn_mfma_f32_16x16x32_f16(Bt[n].h[k], At[m].h[k], acc[ai][bj][m][n], 0, 0, 0); } } \
        __builtin_amdgcn_s_setprio(0); } while (0)
#define PG8_WAIT_V(n) asm volatile("s_waitcnt vmcnt(" #n ")" ::: "memory")
#define PG8_WAIT_L(n) asm volatile("s_waitcnt lgkmcnt(" #n ")" ::: "memory")
#define PG8_BAR __builtin_amdgcn_s_barrier()
#define PG8_SCHED __builtin_amdgcn_sched_barrier(0)
    Unit cur, nxt; int ui = 0;
    if (!S.next(0, cur)) return;
    Acc acc;
#pragma unroll
    for (int a = 0; a < 2; ++a)
#pragma unroll
        for (int b = 0; b < 2; ++b)
#pragma unroll
            for (int m = 0; m < 4; ++m)
#pragma unroll
                for (int n = 0; n < 2; ++n) acc[a][b][m][n] = (f32x4){0.f, 0.f, 0.f, 0.f};
    Frag<FP8> At[4], B0[2], B1[2];
    const char* cA = cur.A; const char* cB = cur.B;
    if constexpr (GATHER) {
#pragma unroll
        for (int h = 0; h < 2; ++h)
#pragma unroll
            for (int i = 0; i < 2; ++i) va[h][i] = S.voff(cur, h * HALF + sR[i], sC[i]);
    }
    PG8_STAGE(PG8_SB(0, 0), cB, voffB); PG8_STAGE(PG8_SB(0, 1), cB + hstepB, voffB); PG8_STAGE(PG8_SA(0, 0), cA, va[0]); PG8_STAGE(PG8_SA(0, 1), cA, va[1]);
    if (wr == 1) PG8_BAR;
    PG8_WAIT_V(2); PG8_BAR;
    PG8_STAGE(PG8_SB(1, 0), cB + kstep, voffB); PG8_STAGE(PG8_SA(1, 0), cA + kstep, va[0]); PG8_STAGE(PG8_SB(1, 1), cB + hstepB + kstep, voffB);
    PG8_WAIT_V(6); PG8_BAR;
    for (;;) {
        const bool has_next = S.next(ui + 1, nxt);
        const char* nA = has_next ? nxt.A : cA; const char* nB = has_next ? nxt.B : cB;
        if constexpr (GATHER) {
            if (has_next) {
#pragma unroll
                for (int h = 0; h < 2; ++h)
#pragma unroll
                    for (int i = 0; i < 2; ++i) vn[h][i] = S.voff(nxt, h * HALF + sR[i], sC[i]);
            } else {
#pragma unroll
                for (int h = 0; h < 2; ++h)
#pragma unroll
                    for (int i = 0; i < 2; ++i) vn[h][i] = va[h][i];
            }
        }
        for (int t = 0; t < nt; t += 2) {
            const bool last = (t == nt - 2);
            if constexpr (Epi::MID_T >= 0) { if (t == Epi::MID_T) E.mid(acc, cur, wr, wc, fr, fq); }
            const char* a1 = cA + (size_t)(t + 1) * kstep;
            const char* a2 = last ? nA : cA + (size_t)(t + 2) * kstep; const char* b2 = last ? nB : cB + (size_t)(t + 2) * kstep;
            const char* a3 = a2 + kstep; const char* b3 = b2 + kstep;
            unsigned v2[2][2];
#pragma unroll
            for (int h = 0; h < 2; ++h)
#pragma unroll
                for (int i = 0; i < 2; ++i) v2[h][i] = (GATHER && last) ? vn[h][i] : va[h][i];
            PG8_LDB(B0, 0, 0); PG8_LDB(B1, 0, 1); PG8_SCHED; PG8_LDA(At, 0, 0); PG8_STAGE(PG8_SA(1, 1), a1, va[1]);
            PG8_WAIT_V(8); PG8_WAIT_L(0); PG8_BAR; PG8_MMA(0, 0, At, B0); PG8_MMA(0, 1, At, B1); PG8_BAR; PG8_SCHED;
            PG8_LDA(At, 0, 1); PG8_STAGE(PG8_SB(0, 0), b2, voffB); PG8_STAGE(PG8_SB(0, 1), b2 + hstepB, voffB); PG8_STAGE(PG8_SA(0, 0), a2, v2[0]);
            PG8_WAIT_V(8); PG8_WAIT_L(0); PG8_BAR; PG8_MMA(1, 0, At, B0); PG8_MMA(1, 1, At, B1); PG8_BAR; PG8_SCHED;
            PG8_LDB(B0, 1, 0); PG8_LDB(B1, 1, 1); PG8_SCHED; PG8_LDA(At, 1, 0); PG8_STAGE(PG8_SA(0, 1), a2, v2[1]);
            PG8_WAIT_V(8); PG8_WAIT_L(0); PG8_BAR; PG8_MMA(0, 0, At, B0); PG8_MMA(0, 1, At, B1); PG8_BAR; PG8_SCHED;
            PG8_LDA(At, 1, 1); PG8_STAGE(PG8_SB(1, 0), b3, voffB); PG8_STAGE(PG8_SB(1, 1), b3 + hstepB, voffB); PG8_STAGE(PG8_SA(1, 0), a3, v2[0]);
            PG8_WAIT_V(8); PG8_WAIT_L(0); PG8_BAR; PG8_MMA(1, 0, At, B0); PG8_MMA(1, 1, At, B1); PG8_BAR; PG8_SCHED;
        }
        if (wr == 0) PG8_BAR;
        if constexpr (FP8) asm volatile("s_nop 15\n\ts_nop 15\n\ts_nop 15" ::: "memory");
        E(acc, cur, wr, wc, fr, fq);
        if (!has_next) break;
#pragma unroll
        for (int a = 0; a < 2; ++a)
#pragma unroll
            for (int b = 0; b < 2; ++b)
#pragma unroll
                for (int m = 0; m < 4; ++m)
#pragma unroll
                    for (int n = 0; n < 2; ++n) acc[a][b][m][n] = (f32x4){0.f, 0.f, 0.f, 0.f};
        cur = nxt; cA = nA; cB = nB; ++ui;
        if constexpr (GATHER) {
#pragma unroll
            for (int h = 0; h < 2; ++h)
#pragma unroll
                for (int i = 0; i < 2; ++i) va[h][i] = vn[h][i];
        }
        if (wr == 1) PG8_BAR;
    }
    PG8_WAIT_V(0);
    PG8_BAR;
#undef PG8_SA
#undef PG8_SB
#undef PG8_STAGE
#undef PG8_LDA
#undef PG8_LDB
#undef PG8_MMA
#undef PG8_LD1
#undef PG8_WAIT_V
#undef PG8_WAIT_L
#undef PG8_BAR
#undef PG8_SCHED
}

struct StaticOrder {
    const char* A; const char* B; size_t a_tile, b_tile;
    int nM, nN, nwg, G, c;
    __device__ __forceinline__ void init(const void* A_, int lda, const void* B_, int K, int N, int G_, int c_) {
        A = (const char*)A_; B = (const char*)B_; a_tile = (size_t)256 * lda * 2; b_tile = (size_t)256 * K * 2; nM = NTOK / BM; nN = N / BM; nwg = nM * nN; G = G_; c = c_; }
    __device__ __forceinline__ bool next(int i, Unit& u) const {
        const long L = (long)i * G + c; if (L >= nwg) return false;
        int wgid = (int)L; { const int q = nwg / 8, r = nwg % 8, xcd = wgid % 8, off = wgid / 8; wgid = (xcd < r ? xcd * (q + 1) : r * (q + 1) + (xcd - r) * q) + off; }
        const int nig = 8 * nN, gid = wgid / nig, fm = gid * 8, gsz = (nM - fm) < 8 ? (nM - fm) : 8;
        u.pm = fm + ((wgid % nig) % gsz); u.pn = (wgid % nig) / gsz; u.e = 0; u.slot0 = 0; u.cnt = 0; u.tag = 0;
        u.A = A + (size_t)u.pm * a_tile; u.B = B + (size_t)u.pn * b_tile; return true;
    }
    __device__ __forceinline__ unsigned voff(const Unit&, int, int) const { return 0u; }
};
}
using pg8::Unit; using pg8::Acc;

#define ACC8(acc, ai, bj, m, v0, v1) const f32x4 v0 = acc[ai][bj][m][0], v1 = acc[ai][bj][m][1]
#define EPI_ROWS(u, wr, fr) const int row0 = (u).pm * 256 + (wr) * 64 + (fr)
__device__ __forceinline__ void rope8(f32x4& v0, f32x4& v1, const f32x4 cs, const f32x4 sn) {
    const float a0 = v0[0] * cs[0] - v0[1] * sn[0], b0 = v0[1] * cs[0] + v0[0] * sn[0];
    const float a1 = v0[2] * cs[1] - v0[3] * sn[1], b1 = v0[3] * cs[1] + v0[2] * sn[1];
    const float a2 = v1[0] * cs[2] - v1[1] * sn[2], b2 = v1[1] * cs[2] + v1[0] * sn[2];
    const float a3 = v1[2] * cs[3] - v1[3] * sn[3], b3 = v1[3] * cs[3] + v1[2] * sn[3];
    v0 = (f32x4){a0, b0, a1, b1}; v1 = (f32x4){a2, b2, a3, b3};
}
struct EpiIn {
    static constexpr bool PERM16 = false; static constexpr int MID_T = -1;
    h16* qa; h16* krope; h16* dil; h16* gates; float* rowsq; const float* cosd; const float* sind; const float* cosm; const float* sinm;
    __device__ __forceinline__ void operator()(const Acc& acc, const Unit& u, int wr, int wc, int fr, int fq) const {
        asm volatile("" : "+v"(fr), "+v"(fq));
        EPI_ROWS(u, wr, fr); const int pn = u.pn, colin = wc * 32 + 8 * fq;
        constexpr float WS_ = 1.0f / SC_GU;
        if (pn < 4) {
#pragma unroll
            for (int ai = 0; ai < 2; ++ai)
#pragma unroll
                for (int m = 0; m < 4; ++m) { const int row = row0 + ai * 128 + m * 16; float ss = 0.f;
#pragma unroll
                    for (int bj = 0; bj < 2; ++bj) { const f32x4 v0 = acc[ai][bj][m][0] * WS_, v1 = acc[ai][bj][m][1] * WS_;
                        ss += (v0[0] * v0[0] + v0[1] * v0[1]) + (v0[2] * v0[2] + v0[3] * v0[3]) + (v1[0] * v1[0] + v1[1] * v1[1]) + (v1[2] * v1[2] + v1[3] * v1[3]);
                        *(u32x4*)(qa + (size_t)row * 1024 + pn * 256 + bj * 128 + colin) = pk8(v0, v1); }
                    ss += __shfl_xor(ss, 16); ss += __shfl_xor(ss, 32);
                    if (fq == 0) rowsq[(size_t)row * 16 + pn * 4 + wc] = ss; }
        } else if (pn == 4) {
            if (wc < 2) {
                u32x4 pk[2][4];
#pragma unroll
                for (int ai = 0; ai < 2; ++ai) {
                    f32x4 cs[4], sn[4];
#pragma unroll
                    for (int m = 0; m < 4; ++m) { const int row = row0 + ai * 128 + m * 16;
                        cs[m] = *(const f32x4*)(cosm + (size_t)row * 32 + 16 * wc + 4 * fq); sn[m] = *(const f32x4*)(sinm + (size_t)row * 32 + 16 * wc + 4 * fq); }
                    __builtin_amdgcn_sched_barrier(0);
#pragma unroll
                    for (int m = 0; m < 4; ++m) { f32x4 v0 = acc[ai][0][m][0] * WS_, v1 = acc[ai][0][m][1] * WS_; rope8(v0, v1, cs[m], sn[m]); pk[ai][m] = pk8(v0, v1); }
                    __builtin_amdgcn_sched_barrier(0);
                }
#pragma unroll
                for (int ai = 0; ai < 2; ++ai)
#pragma unroll
                    for (int m = 0; m < 4; ++m) { const int row = row0 + ai * 128 + m * 16; *(u32x4*)(krope + (size_t)row * 64 + colin) = pk[ai][m]; }
            }
        } else if (pn < 23) {
            const int part = (pn - 5) / 6; const bool rope = (part < 2 && wc == 0);
            const float sc_ = (part == 0) ? WS_ * QS_D : WS_;
            if (rope) {
                u32x4 pk[2][4][2];
#pragma unroll
                for (int ai = 0; ai < 2; ++ai) {
                    f32x4 cs[4], sn[4];
#pragma unroll
                    for (int m = 0; m < 4; ++m) { const int row = row0 + ai * 128 + m * 16;
                        cs[m] = *(const f32x4*)(cosd + (size_t)row * 16 + 4 * fq); sn[m] = *(const f32x4*)(sind + (size_t)row * 16 + 4 * fq); }
                    __builtin_amdgcn_sched_barrier(0);
#pragma unroll
                    for (int m = 0; m < 4; ++m)
#pragma unroll
                        for (int bj = 0; bj < 2; ++bj) { f32x4 v0 = acc[ai][bj][m][0] * sc_, v1 = acc[ai][bj][m][1] * sc_; rope8(v0, v1, cs[m], sn[m]); pk[ai][m][bj] = pk8(v0, v1); }
                    __builtin_amdgcn_sched_barrier(0);
                }
                __builtin_amdgcn_sched_barrier(0);
                int row0s = row0; asm volatile("" : "+v"(row0s));
#pragma unroll
                for (int ai = 0; ai < 2; ++ai)
#pragma unroll
                    for (int m = 0; m < 4; ++m) { const int row = row0s + ai * 128 + m * 16;
#pragma unroll
                        for (int bj = 0; bj < 2; ++bj) *(u32x4*)(dil + (size_t)row * 4608 + (pn - 5) * 256 + bj * 128 + colin) = pk[ai][m][bj]; }
            } else {
#pragma unroll
                for (int ai = 0; ai < 2; ++ai)
#pragma unroll
                    for (int m = 0; m < 4; ++m) { const int row = row0 + ai * 128 + m * 16;
#pragma unroll
                        for (int bj = 0; bj < 2; ++bj)
                            *(u32x4*)(dil + (size_t)row * 4608 + (pn - 5) * 256 + bj * 128 + colin) = pk8(acc[ai][bj][m][0] * sc_, acc[ai][bj][m][1] * sc_); }
            }
        } else {
#pragma unroll
            for (int ai = 0; ai < 2; ++ai)
#pragma unroll
                for (int m = 0; m < 4; ++m) { const int row = row0 + ai * 128 + m * 16;
#pragma unroll
                    for (int bj = 0; bj < 2; ++bj) { f32x4 v0 = acc[ai][bj][m][0] * WS_, v1 = acc[ai][bj][m][1] * WS_;
#pragma unroll
                        for (int j = 0; j < 4; ++j) { v0[j] = sigmoidf_(v0[j]); v1[j] = sigmoidf_(v1[j]); }
                        *(u32x4*)(gates + (size_t)row * 4096 + (pn - 23) * 256 + bj * 128 + colin) = pk8(v0, v1); } }
        }
    }
};
struct EpiUp {
    static constexpr bool PERM16 = false; static constexpr int MID_T = -1;
    h16* qm; h16* kv; const float* rowsq; const float* cosm; const float* sinm;
    __device__ __forceinline__ void operator()(const Acc& acc, const Unit& u, int wr, int wc, int fr, int fq) const {
        asm volatile("" : "+v"(fr), "+v"(fq));
        EPI_ROWS(u, wr, fr); const int pn = u.pn, colin = wc * 32 + 8 * fq; const bool rope = (u.tag == 0 && pn >= 4);
        float rs[2][4];
        {   f32x4 s0[2][4], s1[2][4];
#pragma unroll
            for (int ai = 0; ai < 2; ++ai)
#pragma unroll
                for (int m = 0; m < 4; ++m) { const int row = row0 + ai * 128 + m * 16;
                    s0[ai][m] = *(const f32x4*)(rowsq + (size_t)row * 16 + u.tag * 8); s1[ai][m] = *(const f32x4*)(rowsq + (size_t)row * 16 + u.tag * 8 + 4); }
            __builtin_amdgcn_sched_barrier(0);
#pragma unroll
            for (int ai = 0; ai < 2; ++ai)
#pragma unroll
                for (int m = 0; m < 4; ++m) { const float ss = ((s0[ai][m][0] + s0[ai][m][1]) + (s0[ai][m][2] + s0[ai][m][3])) + ((s1[ai][m][0] + s1[ai][m][1]) + (s1[ai][m][2] + s1[ai][m][3]));
                    rs[ai][m] = __builtin_amdgcn_rsqf(ss * (1.0f / 512.0f) + EPS) * (u.tag == 0 ? QS_M : 1.0f); } }
        u32x4 pk[2][4][2];
        if (rope) {
#pragma unroll
            for (int ai = 0; ai < 2; ++ai) {
                f32x4 cs[4], sn[4];
#pragma unroll
                for (int m = 0; m < 4; ++m) { const int row = row0 + ai * 128 + m * 16;
                    cs[m] = *(const f32x4*)(cosm + (size_t)row * 32 + 16 * (wc & 1) + 4 * fq); sn[m] = *(const f32x4*)(sinm + (size_t)row * 32 + 16 * (wc & 1) + 4 * fq); }
                __builtin_amdgcn_sched_barrier(0);
#pragma unroll
                for (int m = 0; m < 4; ++m)
#pragma unroll
                    for (int bj = 0; bj < 2; ++bj) { f32x4 v0 = acc[ai][bj][m][0] * rs[ai][m], v1 = acc[ai][bj][m][1] * rs[ai][m]; rope8(v0, v1, cs[m], sn[m]); pk[ai][m][bj] = pk8(v0, v1); }
                __builtin_amdgcn_sched_barrier(0);
            }
        } else {
#pragma unroll
            for (int ai = 0; ai < 2; ++ai)
#pragma unroll
                for (int m = 0; m < 4; ++m)
#pragma unroll
                    for (int bj = 0; bj < 2; ++bj) pk[ai][m][bj] = pk8(acc[ai][bj][m][0] * rs[ai][m], acc[ai][bj][m][1] * rs[ai][m]);
        }
        __builtin_amdgcn_sched_barrier(0);
        int row0s = row0; asm volatile("" : "+v"(row0s));
#pragma unroll
        for (int ai = 0; ai < 2; ++ai)
#pragma unroll
            for (int m = 0; m < 4; ++m) { const int row = row0s + ai * 128 + m * 16;
#pragma unroll
                for (int bj = 0; bj < 2; ++bj) {
                    if (u.tag == 0) *(u32x4*)(qm + (size_t)row * 1536 + pn * 256 + bj * 128 + colin) = pk[ai][m][bj];
                    else *(u32x4*)(kv + (size_t)row * 2048 + pn * 256 + bj * 128 + colin) = pk[ai][m][bj]; } }
    }
};
__device__ __forceinline__ void unpk8(const u32x4 w, f32x4& a, f32x4& b) {
    const h16x8 h = __builtin_bit_cast(h16x8, w);
    a = (f32x4){(float)h[0], (float)h[1], (float)h[2], (float)h[3]}; b = (f32x4){(float)h[4], (float)h[5], (float)h[6], (float)h[7]};
}
template <int MODE> struct EpiOut {
    static constexpr bool PERM16 = (MODE == 3); static constexpr int MID_T = -1;
    h16* out; int ldc; const h16* gate; int ldg; const h16* add; float scale;
    __device__ __forceinline__ void operator()(const Acc& acc, const Unit& u, int wr, int wc, int fr, int fq) const {
        asm volatile("" : "+v"(fr), "+v"(fq));
        EPI_ROWS(u, wr, fr); const int col0 = u.pn * 256 + wc * 32 + 8 * fq;
#pragma unroll
        for (int ai = 0; ai < 2; ++ai) {
            u32x4 gv[4][2], av[4][2];
            if (MODE == 1 || MODE == 2) {
#pragma unroll
                for (int m = 0; m < 4; ++m)
#pragma unroll
                    for (int bj = 0; bj < 2; ++bj) { const int row = row0 + ai * 128 + m * 16;
                        gv[m][bj] = *(const u32x4*)(gate + (size_t)row * ldg + col0 + bj * 128);
                        if (MODE == 2) av[m][bj] = *(const u32x4*)(add + (size_t)row * ldc + col0 + bj * 128); }
                __builtin_amdgcn_sched_barrier(0);
            }
#pragma unroll
            for (int m = 0; m < 4; ++m) { const int row = row0 + ai * 128 + m * 16;
                if (MODE == 3) {
                    const f32x4 a0 = acc[ai][0][m][0] * scale, a1 = acc[ai][0][m][1] * scale, b0 = acc[ai][1][m][0] * scale, b1 = acc[ai][1][m][1] * scale;
                    u32x4 w; w.x = pk4_fp8(a0[0], a0[1], a0[2], a0[3]); w.y = pk4_fp8(a1[0], a1[1], a1[2], a1[3]); w.z = pk4_fp8(b0[0], b0[1], b0[2], b0[3]); w.w = pk4_fp8(b1[0], b1[1], b1[2], b1[3]);
                    *(u32x4*)((unsigned char*)out + (size_t)row * ldc + u.pn * 256 + wc * 64 + 16 * fq) = w;
                    continue; }
#pragma unroll
                for (int bj = 0; bj < 2; ++bj) { f32x4 v0 = acc[ai][bj][m][0], v1 = acc[ai][bj][m][1];
                    if (MODE == 0) { v0 *= scale; v1 *= scale; }
                    if (MODE == 1 || MODE == 2) { f32x4 g0, g1; unpk8(gv[m][bj], g0, g1); v0 *= g0; v1 *= g1; }
                    if (MODE == 2) { f32x4 a0, a1; unpk8(av[m][bj], a0, a1); v0 += a0; v1 += a1; }
                    *(u32x4*)(out + (size_t)row * ldc + col0 + bj * 128) = pk8(v0, v1); } }
        }
    }
};
struct EpiMerge {
    static constexpr bool PERM16 = false; static constexpr int MID_T = 16;
    h16* out; const h16* gate;
    __device__ __forceinline__ void mid(Acc& acc, const Unit& u, int wr, int wc, int fr, int fq) const {
        asm volatile("" : "+v"(fr), "+v"(fq));
        EPI_ROWS(u, wr, fr); const int col0 = u.pn * 256 + wc * 32 + 8 * fq;
#pragma unroll
        for (int ai = 0; ai < 2; ++ai) {
            u32x4 ga[4][2], gb[4][2];
#pragma unroll
            for (int m = 0; m < 4; ++m)
#pragma unroll
                for (int bj = 0; bj < 2; ++bj) { const int row = row0 + ai * 128 + m * 16;
                    ga[m][bj] = *(const u32x4*)(gate + (size_t)row * 4096 + col0 + bj * 128); gb[m][bj] = *(const u32x4*)(gate + (size_t)row * 4096 + 2048 + col0 + bj * 128); }
            __builtin_amdgcn_sched_barrier(0);
#pragma unroll
            for (int m = 0; m < 4; ++m)
#pragma unroll
                for (int bj = 0; bj < 2; ++bj) { f32x4 a0, a1, b0, b1; unpk8(ga[m][bj], a0, a1); unpk8(gb[m][bj], b0, b1);
#pragma unroll
                    for (int j = 0; j < 4; ++j) { acc[ai][bj][m][0][j] *= a0[j] * __builtin_amdgcn_rcpf(fmaxf(b0[j], 6.2e-5f)); acc[ai][bj][m][1][j] *= a1[j] * __builtin_amdgcn_rcpf(fmaxf(b1[j], 6.2e-5f)); } }
        }
    }
    __device__ __forceinline__ void operator()(Acc& acc, const Unit& u, int wr, int wc, int fr, int fq) const {
        asm volatile("" : "+v"(fr), "+v"(fq));
        EPI_ROWS(u, wr, fr); const int col0 = u.pn * 256 + wc * 32 + 8 * fq;
#pragma unroll
        for (int ai = 0; ai < 2; ++ai) {
            u32x4 gb[4][2];
#pragma unroll
            for (int m = 0; m < 4; ++m)
#pragma unroll
                for (int bj = 0; bj < 2; ++bj) { const int row = row0 + ai * 128 + m * 16; gb[m][bj] = *(const u32x4*)(gate + (size_t)row * 4096 + 2048 + col0 + bj * 128); }
            __builtin_amdgcn_sched_barrier(0);
#pragma unroll
            for (int m = 0; m < 4; ++m)
#pragma unroll
                for (int bj = 0; bj < 2; ++bj) { f32x4 b0, b1; unpk8(gb[m][bj], b0, b1);
#pragma unroll
                    for (int j = 0; j < 4; ++j) { b0[j] = fmaxf(b0[j], 6.2e-5f); b1[j] = fmaxf(b1[j], 6.2e-5f); }
                    acc[ai][bj][m][0] *= b0; acc[ai][bj][m][1] *= b1; }
        }
        __builtin_amdgcn_sched_barrier(0);
#pragma unroll
        for (int ai = 0; ai < 2; ++ai)
#pragma unroll
            for (int m = 0; m < 4; ++m) { const int row = row0 + ai * 128 + m * 16;
#pragma unroll
                for (int bj = 0; bj < 2; ++bj) { const f32x4 r0 = acc[ai][bj][m][0], r1 = acc[ai][bj][m][1]; u32x2 w; w.x = pk4_fp8(r0[0], r0[1], r0[2], r0[3]); w.y = pk4_fp8(r1[0], r1[1], r1[2], r1[3]);
                    *(u32x2*)((unsigned char*)out + (size_t)row * DM + col0 + bj * 128) = w; } }
    }
};
struct EpiSwiglu {
    static constexpr bool PERM16 = false; static constexpr int MID_T = -1;
    unsigned char* act;
    __device__ __forceinline__ void operator()(const Acc& acc, const Unit& u, int wr, int wc, int fr, int fq) const {
        asm volatile("" : "+v"(fr), "+v"(fq));
        EPI_ROWS(u, wr, fr); const int col0 = u.pn * 128 + wc * 32 + 8 * fq;
#pragma unroll
        for (int ai = 0; ai < 2; ++ai)
#pragma unroll
            for (int m = 0; m < 4; ++m) { const int row = row0 + ai * 128 + m * 16;
                f32x4 g0 = acc[ai][0][m][0] * (1.0f / SC_GU), g1 = acc[ai][0][m][1] * (1.0f / SC_GU); const f32x4 u0 = acc[ai][1][m][0] * (1.0f / SC_GU), u1 = acc[ai][1][m][1] * (1.0f / SC_GU);
#pragma unroll
                for (int j = 0; j < 4; ++j) { g0[j] = g0[j] * sigmoidf_(g0[j]) * u0[j]; g1[j] = g1[j] * sigmoidf_(g1[j]) * u1[j]; }
                u32x2 w; w.x = pk4_fp8(g0[0], g0[1], g0[2], g0[3]); w.y = pk4_fp8(g1[0], g1[1], g1[2], g1[3]);
                *(u32x2*)(act + (size_t)row * 512 + col0) = w; }
    }
};

struct UpOrder {
    const char* qa; const char* wq; const char* wkv; int G, c;
    __device__ __forceinline__ bool next(int i, Unit& u) const {
        const int L = i * G + c; if (L >= 896) return false;
        u.e = 0; u.slot0 = 0; u.cnt = 0;
        if (L < 384) { u.pm = L / 6; u.pn = L % 6; u.tag = 0; u.A = qa + (size_t)u.pm * 256 * 2048; u.B = wq + (size_t)u.pn * 256 * 1024; }
        else { const int l = L - 384; u.pm = l >> 3; u.pn = l & 7; u.tag = 1; u.A = qa + (size_t)u.pm * 256 * 2048 + 1024; u.B = wkv + (size_t)u.pn * 256 * 1024; }
        return true;
    }
    __device__ __forceinline__ unsigned voff(const Unit&, int, int) const { return 0u; }
};
__device__ __forceinline__ void moe_tables(const Frame& F, const unsigned* cnt) {
    LAS int* tstart = (LAS int*)(F.lds + LDS_TAB); LAS int* cnts = (LAS int*)(F.lds + LDS_TAB + 512); LAS int* tmap = (LAS int*)(F.lds + LDS_TAB + 1024);
    __syncthreads();
    if (F.tid < 65) cnts[F.tid] = F.tid < 64 ? (int)__hip_atomic_load(cnt + 64 * F.tid, __ATOMIC_RELAXED, __HIP_MEMORY_SCOPE_AGENT) : NTOK;
    __syncthreads();
    if (F.tid == 0) { int s = 0; for (int e = 0; e < 65; ++e) { tstart[e] = s; s += (cnts[e] + 255) >> 8; } tstart[65] = s; }
    __syncthreads();
    { int e = 0; for (int j = 1; j < 65; ++j) e += (tstart[j] <= F.tid) ? 1 : 0; tmap[F.tid] = (F.tid < tstart[65]) ? e : 255; }
    __syncthreads();
}
template <int NPN, bool GU> struct MoeOrder {
    const LAS int* tstart; const LAS int* cnts; const LAS int* tmap; const char* A; const char* W; const unsigned* list; int G, c;
    __device__ __forceinline__ bool next(int i, Unit& u) const {
        const int T = __builtin_amdgcn_readfirstlane(tstart[65]); int L;
        if (G == 256) { const int U8 = (T * NPN + 7) >> 3, q = i * 32 + (c & 31); if (q >= U8) return false; L = (c >> 5) * U8 + q; }
        else L = i * G + c;
        const int mt = L / NPN;
        if (mt >= T) return false;
        const int e = __builtin_amdgcn_readfirstlane(tmap[mt]);
        u.pm = mt; u.pn = L % NPN; u.e = e; u.slot0 = (mt - __builtin_amdgcn_readfirstlane(tstart[e])) * 256; u.cnt = __builtin_amdgcn_readfirstlane(cnts[e]); u.tag = 0;
        if (GU) { u.A = A; u.B = W + (size_t)e * (1024 * 2048) + (size_t)u.pn * (256 * 2048); }
        else { u.A = A + (size_t)mt * (256 * 512); u.B = W + (size_t)e * (2048 * 512) + (size_t)u.pn * (256 * 512); }
        return true;
    }
    __device__ __forceinline__ unsigned voff(const Unit& u, int row, int col) const {
        const int slot = u.slot0 + row; unsigned tok;
        if (u.e == 64) tok = (unsigned)slot; else tok = slot < u.cnt ? list[(size_t)u.e * LISTCAP + slot] : 0u;
        return tok * 2048u + (unsigned)col * 2u;
    }
};

namespace att {
constexpr int KVBLK = 64, SHM_K = 16384, SHM_V = 16384, SHM_KR = 8192;
template <bool MLA> struct Lay { static constexpr int NB = MLA ? 2 : 4, OFF_V = 0, OFF_K = NB * SHM_V, OFF_KR = OFF_K + NB * SHM_K, OFF_WS = OFF_KR + (MLA ? NB * SHM_KR : 0), OFF_QR = OFF_WS + 2048; };
constexpr float THR2 = 11.5f;
#define KSWZ(row, colB) ((row) * 256 + ((colB) ^ (((row) & 7) << 4)))
#define RSWZ(row, colB) ((row) * 128 + ((colB) ^ (((row) & 7) << 4)))
#define SBAR() __builtin_amdgcn_sched_barrier(0)
__device__ __forceinline__ int v_st(int k, int c) { const int kk = (k & ~0xC) | ((k & 4) << 1) | ((k & 8) >> 1); return ((kk >> 3) * 4 + (c >> 5)) * 512 + ((kk & 7) * 32 + (c & 31)) * 2; }
__device__ __forceinline__ int v_rd_base(int lane) { return ((lane & 3) << 3) | (((lane >> 2) & 3) << 6) | (((lane >> 4) & 1) << 5) | (((lane >> 5) & 1) << 8); }
constexpr int v_rd_off(int d0, int ks, int half) { return d0 * 512 + ks * 4096 + half * 2048; }
__device__ __forceinline__ int crow(int r, int hi) { return (r & 3) + 8 * (r >> 2) + 4 * hi; }
__device__ __forceinline__ void mask_tile(f32x16& p0, f32x16& p1, int dq, unsigned W) {
    const float NEG = -__builtin_inff();
#pragma unroll
    for (int r = 0; r < 16; ++r) {
        const int c = (r & 3) + 8 * (r >> 2);
        if ((unsigned)(dq - c) >= W) p0[r] = NEG;
        if ((unsigned)(dq - c - 32) >= W) p1[r] = NEG;
    }
}
__device__ __forceinline__ void softmax_tile(f32x16& p0, f32x16& p1, float& m_reg, float& l_reg, float& alpha, h16x8& pa0, h16x8& pa1, h16x8& pa2, h16x8& pa3) {
    float pmax = p0[0];
#pragma unroll
    for (int r = 1; r < 16; ++r) pmax = fmaxf(pmax, p0[r]);
#pragma unroll
    for (int r = 0; r < 16; ++r) pmax = fmaxf(pmax, p1[r]);
    { auto rr = __builtin_amdgcn_permlane32_swap(__float_as_uint(pmax), __float_as_uint(pmax), false, false);
      pmax = fmaxf(__uint_as_float(rr[0]), __uint_as_float(rr[1])); }
    float mn;
    if (__all((pmax - m_reg) <= THR2)) { mn = m_reg; alpha = 1.f; }
    else { mn = fmaxf(m_reg, pmax); alpha = __builtin_amdgcn_exp2f(m_reg - mn); m_reg = mn; }
#pragma unroll
    for (int r = 0; r < 16; ++r) { p0[r] = __builtin_amdgcn_exp2f(p0[r] - mn); p1[r] = __builtin_amdgcn_exp2f(p1[r] - mn); }
    float ps = 0;
#pragma unroll
    for (int r = 0; r < 16; ++r) ps += p0[r];
#pragma unroll
    for (int r = 0; r < 16; ++r) ps += p1[r];
    { auto rr = __builtin_amdgcn_permlane32_swap(__float_as_uint(ps), __float_as_uint(ps), false, false);
      ps = __uint_as_float(rr[0]) + __uint_as_float(rr[1]); }
    l_reg = l_reg * alpha + ps;
#define PK4(P, B_, OUT) do { unsigned a0 = pkh(P[B_+0], P[B_+1]), a1 = pkh(P[B_+2], P[B_+3]);                          \
        unsigned b0 = pkh(P[B_+4], P[B_+5]), b1 = pkh(P[B_+6], P[B_+7]);                                             \
        auto r0 = __builtin_amdgcn_permlane32_swap(a0, b0, false, false); auto r1 = __builtin_amdgcn_permlane32_swap(a1, b1, false, false); \
        u32x4 w = {r0[0], r1[0], r0[1], r1[1]}; OUT = __builtin_bit_cast(h16x8, w); } while (0)
    PK4(p0, 0, pa0); PK4(p0, 8, pa1); PK4(p1, 0, pa2); PK4(p1, 8, pa3);
#undef PK4
}
struct AUnit {
    const char* Q; const char* QR;
    const char* K; const char* V;
    const char* KR;
    char* O;
    float* LSE;
    unsigned qs, kvs, krs, os, ls;
    int P0, jlo, jhi; unsigned W;
};
template <bool MLA>
__device__ __forceinline__ void attn_unit(LAS unsigned char* lds, const AUnit& u) {
    const int tid = threadIdx.x, wid = __builtin_amdgcn_readfirstlane(tid >> 6), lane = tid & 63, r32 = lane & 31, hi = lane >> 5;
    typedef Lay<MLA> L; constexpr int NB = L::NB, PER_TILE = MLA ? 5 : 4;
    LAS unsigned char* V_lds = lds + L::OFF_V; LAS unsigned char* K_lds = lds + L::OFF_K; LAS unsigned char* R_lds = lds + L::OFF_KR;
    LAS float* wsf = (LAS float*)(lds + L::OFF_WS) + wid * 64;
    LAS unsigned char* QRl = lds + L::OFF_QR + wid * 4096 + lane * 16;
    const int qlo = u.P0 + wid * 32, qm = qlo + r32 - 4 * hi;
    unsigned ko[2], vo[2], kro = 0u;
#pragma unroll
    for (int i = 0; i < 2; ++i) { const int p = (wid * 2 + i) * 64 + lane;
        { const int row = p >> 4, pc = p & 15; ko[i] = (unsigned)row * u.kvs + (unsigned)((pc ^ (row & 7)) << 4); }
        { const int cc = (p & 3) | (((p >> 5) & 3) << 2), kk = ((p >> 2) & 7) | ((p >> 7) << 3), k = (kk & ~0xC) | ((kk & 4) << 1) | ((kk & 8) >> 1);
          vo[i] = (unsigned)k * u.kvs + (unsigned)cc * 16u; } }
    if constexpr (MLA) { const int p = wid * 64 + lane, row = p >> 3, pc = p & 7; kro = (unsigned)row * u.krs + (unsigned)((pc ^ (row & 7)) << 4); }
#define ST_ISSUE(t, bf) do { const size_t tb_ = (size_t)(t) * KVBLK * u.kvs; const char* Kt_ = u.K + tb_; const char* Vt_ = u.V + tb_; \
        _Pragma("unroll") for (int i_ = 0; i_ < 2; ++i_) { \
            __builtin_amdgcn_global_load_lds((const unsigned*)(Kt_ + ko[i_]), (LAS unsigned*)(K_lds + (bf) * SHM_K + (wid * 2 + i_) * 1024), 16, 0, 0); \
            __builtin_amdgcn_global_load_lds((const unsigned*)(Vt_ + vo[i_]), (LAS unsigned*)(V_lds + (bf) * SHM_V + (wid * 2 + i_) * 1024), 16, 0, 0); } \
        if constexpr (MLA) __builtin_amdgcn_global_load_lds((const unsigned*)(u.KR + (size_t)(t) * KVBLK * u.krs + kro), (LAS unsigned*)(R_lds + (bf) * SHM_KR + wid * 1024), 16, 0, 0); } while (0)
    __syncthreads();
#pragma unroll
    for (int i = 0; i < NB - 1; ++i) if (u.jlo + i < u.jhi) ST_ISSUE(u.jlo + i, i);
    h16x8 qr[8];
    { const unsigned qo = (unsigned)(wid * 32 + r32) * u.qs + (unsigned)hi * 16u;
#pragma unroll
      for (int d0 = 0; d0 < 8; ++d0) qr[d0] = *(const h16x8*)(u.Q + d0 * 32 + qo);
      if constexpr (MLA) {
#pragma unroll
        for (int d0 = 0; d0 < 4; ++d0) *(LAS h16x8*)(QRl + d0 * 1024) = *(const h16x8*)(u.QR + d0 * 32 + qo); } }
    float m_reg = -1e30f, l_reg = 0.f; f32x16 o[4];
#pragma unroll
    for (int d = 0; d < 4; ++d)
#pragma unroll
        for (int r = 0; r < 16; ++r) o[d][r] = 0.f;
    const int vbb = (int)(uintptr_t)V_lds + v_rd_base(lane);
    for (int t = u.jlo; t < u.jhi; ++t) {
        const int bf = (t - u.jlo) & (NB - 1);
        if constexpr (NB == 4) { if (t + 2 < u.jhi) asm volatile("s_waitcnt vmcnt(8)" ::: "memory"); else if (t + 1 < u.jhi) asm volatile("s_waitcnt vmcnt(4)" ::: "memory"); else asm volatile("s_waitcnt vmcnt(0)" ::: "memory"); }
        else asm volatile("s_waitcnt vmcnt(0)" ::: "memory");
        __syncthreads();
        if (t + NB - 1 < u.jhi) ST_ISSUE(t + NB - 1, (bf + NB - 1) & (NB - 1));
        const int vb0 = vbb + bf * SHM_V;
        const int kb = t * KVBLK;
        const bool act = (kb <= qlo + 31) && ((long)kb + KVBLK - 1 >= (long)qlo - (long)(u.W - 1));
        if (act) {
            f32x16 p0, p1;
#pragma unroll
            for (int r = 0; r < 16; ++r) { p0[r] = 0.f; p1[r] = 0.f; }
            {   const LAS unsigned char* kbp[4];
#pragma unroll
                for (int dd = 0; dd < 4; ++dd) kbp[dd] = K_lds + bf * SHM_K + KSWZ(r32, (dd * 16 + hi * 8) * 2);
#pragma unroll
                for (int d0 = 0; d0 < 8; ++d0) { const LAS unsigned char* a = kbp[d0 & 3] + (d0 >> 2) * 128;
                    const h16x8 b0 = *(const LAS h16x8*)a, b1 = *(const LAS h16x8*)(a + 32 * 256);
                    p0 = __builtin_amdgcn_mfma_f32_32x32x16_f16(b0, qr[d0], p0, 0, 0, 0);
                    p1 = __builtin_amdgcn_mfma_f32_32x32x16_f16(b1, qr[d0], p1, 0, 0, 0); }
                if constexpr (MLA) {
#pragma unroll
                    for (int d0 = 0; d0 < 4; ++d0) { const LAS unsigned char* a = R_lds + bf * SHM_KR + RSWZ(r32, (d0 * 16 + hi * 8) * 2);
                        const h16x8 b0 = *(const LAS h16x8*)a, b1 = *(const LAS h16x8*)(a + 32 * 128); const h16x8 qf = *(const LAS h16x8*)(QRl + d0 * 1024);
                        p0 = __builtin_amdgcn_mfma_f32_32x32x16_f16(b0, qf, p0, 0, 0, 0);
                        p1 = __builtin_amdgcn_mfma_f32_32x32x16_f16(b1, qf, p1, 0, 0, 0); }
                }
            }
            if (kb + KVBLK - 1 > qlo || (long)kb <= (long)qlo + 31 - (long)u.W) mask_tile(p0, p1, qm - kb, u.W);
            float alpha; h16x8 pa0, pa1, pa2, pa3;
            softmax_tile(p0, p1, m_reg, l_reg, alpha, pa0, pa1, pa2, pa3);
            if (__any(alpha < 1.f)) {
                if (hi == 0) wsf[r32] = alpha;
                LDS_WAIT();
#pragma unroll
                for (int r = 0; r < 16; ++r) { const float a_ = wsf[crow(r, hi)];
#pragma unroll
                    for (int d = 0; d < 4; ++d) o[d][r] *= a_; }
            }
#define TRRD(dst, off) asm volatile("ds_read_b64_tr_b16 %0, %1 offset:%2" : "=&v"(dst) : "v"(vb0), "i"(off) : "memory")
#define PV_D0(VB, d0) do { s16x4 l0, l1, l2, l3, h0, h1, h2, h3; constexpr int b_ = (VB) * SHM_V + v_rd_off(d0, 0, 0); \
        TRRD(l0, b_); TRRD(h0, b_ + 2048); TRRD(l1, b_ + 4096); TRRD(h1, b_ + 6144); TRRD(l2, b_ + 8192); TRRD(h2, b_ + 10240); TRRD(l3, b_ + 12288); TRRD(h3, b_ + 14336); \
        asm volatile("s_waitcnt lgkmcnt(0)" ::: "memory"); SBAR(); \
        o[d0] = __builtin_amdgcn_mfma_f32_32x32x16_f16(pa0, __builtin_bit_cast(h16x8, (short __attribute__((ext_vector_type(8)))){l0[0], l0[1], l0[2], l0[3], h0[0], h0[1], h0[2], h0[3]}), o[d0], 0, 0, 0); \
        o[d0] = __builtin_amdgcn_mfma_f32_32x32x16_f16(pa1, __builtin_bit_cast(h16x8, (short __attribute__((ext_vector_type(8)))){l1[0], l1[1], l1[2], l1[3], h1[0], h1[1], h1[2], h1[3]}), o[d0], 0, 0, 0); \
        o[d0] = __builtin_amdgcn_mfma_f32_32x32x16_f16(pa2, __builtin_bit_cast(h16x8, (short __attribute__((ext_vector_type(8)))){l2[0], l2[1], l2[2], l2[3], h2[0], h2[1], h2[2], h2[3]}), o[d0], 0, 0, 0); \
        o[d0] = __builtin_amdgcn_mfma_f32_32x32x16_f16(pa3, __builtin_bit_cast(h16x8, (short __attribute__((ext_vector_type(8)))){l3[0], l3[1], l3[2], l3[3], h3[0], h3[1], h3[2], h3[3]}), o[d0], 0, 0, 0); } while (0)
            PV_D0(0, 0); PV_D0(0, 1); PV_D0(0, 2); PV_D0(0, 3);
#undef PV_D0
#undef TRRD
        }
    }
#undef ST_ISSUE
    if (hi == 0) wsf[32 + r32] = l_reg;
    LDS_WAIT();
    if (u.LSE && hi == 0) u.LSE[(unsigned)(wid * 32 + r32) * u.ls] = m_reg + __builtin_amdgcn_logf(l_reg);
    char* Ow = u.O + (size_t)(wid * 32) * u.os;
    unsigned loff = (unsigned)(4 * hi) * u.os + (unsigned)r32 * 2u;
    asm volatile("" : "+v"(loff));
#pragma unroll
    for (int r = 0; r < 16; ++r) { const int orow = crow(r, hi); const float rl = __builtin_amdgcn_rcpf(wsf[32 + orow]);
        char* rowp = Ow + (size_t)((r & 3) + 8 * (r >> 2)) * u.os;
#pragma unroll
        for (int d0 = 0; d0 < 4; ++d0) { const float v = o[d0][r] * rl; const float vn_ = __shfl_xor(v, 1);
            if ((r32 & 1) == 0) *(unsigned*)(rowp + d0 * 64 + loff) = pkh(v, vn_); } }
}
}

template <class RowOf>
__device__ __forceinline__ void cvt_item(const float* W, int K, int N, h16* WT, LAS float* scr, int item, int lane, const float* kscale, RowOf row_of, int ldo = 0, int ko = 0) {
    if (ldo == 0) ldo = K;
    const int nblk = N >> 6, kb = item / nblk, nb = item - kb * nblk, k0 = kb * 64, n0 = nb * 64;
    f32x4 v[16];
#pragma unroll
    for (int i = 0; i < 16; ++i) { const int kk = 4 * i + (lane >> 4); v[i] = *(const GAS f32x4*)(W + (size_t)(k0 + kk) * N + n0 + (lane & 15) * 4); }
#pragma unroll
    for (int i = 0; i < 16; ++i) { const int kk = 4 * i + (lane >> 4); f32x4 t = v[i]; if (kscale) t *= kscale[k0 + kk];
        LAS float* s = scr + kk * 65 + (lane & 15) * 4; s[0] = t[0]; s[1] = t[1]; s[2] = t[2]; s[3] = t[3]; }
    LDS_WAIT(); asm volatile("" ::: "memory");
    const int c = lane & 7;
#pragma unroll
    for (int j = 0; j < 8; ++j) { const int n = (lane >> 3) + 8 * j; const LAS float* s = scr + (8 * c) * 65 + n;
        u32x4 o; o.x = pkh(s[0 * 65], s[1 * 65]); o.y = pkh(s[2 * 65], s[3 * 65]); o.z = pkh(s[4 * 65], s[5 * 65]); o.w = pkh(s[6 * 65], s[7 * 65]);
        *(GAS u32x4*)(WT + (size_t)row_of(n0 + n) * ldo + ko + k0 + 8 * c) = o; }
    LDS_WAIT(); asm volatile("" ::: "memory");
}
template <class RowOf>
__device__ __forceinline__ void cvt_item8(const float* W, int K, int N, unsigned char* WT, LAS float* scr, int item, int lane, float scale, RowOf row_of) {
    const int nblk = N >> 6, kb = item / nblk, nb = item - kb * nblk, k0 = kb * 64, n0 = nb * 64;
    f32x4 v[16];
#pragma unroll
    for (int i = 0; i < 16; ++i) { const int kk = 4 * i + (lane >> 4); v[i] = *(const GAS f32x4*)(W + (size_t)(k0 + kk) * N + n0 + (lane & 15) * 4); }
#pragma unroll
    for (int i = 0; i < 16; ++i) { const int kk = 4 * i + (lane >> 4); const f32x4 t = v[i] * scale;
        LAS float* s = scr + kk * 65 + (lane & 15) * 4; s[0] = t[0]; s[1] = t[1]; s[2] = t[2]; s[3] = t[3]; }
    LDS_WAIT(); asm volatile("" ::: "memory");
    const int c = lane & 7;
#pragma unroll
    for (int j = 0; j < 8; ++j) { const int n = (lane >> 3) + 8 * j; const LAS float* s = scr + (8 * c) * 65 + n;
        u32x2 o; o.x = pk4_fp8(s[0 * 65], s[1 * 65], s[2 * 65], s[3 * 65]); o.y = pk4_fp8(s[4 * 65], s[5 * 65], s[6 * 65], s[7 * 65]);
        *(GAS u32x2*)(WT + (size_t)row_of(n0 + n) * K + k0 + 8 * c) = o; }
    LDS_WAIT(); asm volatile("" ::: "memory");
}
__device__ __forceinline__ int rope_perm(int i, int half) { return i < half ? 2 * i : 2 * (i - half) + 1; }
__device__ __forceinline__ int row_in(int c) {
    if (c < 1024) return c;
    if (c < 1088) return 1024 + rope_perm(c - 1024, 32);
    if (c < 5696) { const int dc = c - 1088, part = dc / 1536, dim = dc & 127;
        return 1280 + ((part < 2 && dim < 32) ? (dc - dim + rope_perm(dim, 16)) : dc); }
    return 5888 + (c - 5696);
}
__device__ __forceinline__ int row_qup(int c) { const int h = c / 192, j = c - h * 192; return j < 128 ? h * 128 + j : 1024 + h * 64 + rope_perm(j - 128, 32); }
__device__ __forceinline__ int row_gu(int n, int up) { return (n >> 7) * 256 + up * 128 + (n & 127); }
__device__ __forceinline__ void sincos_d(float angf, float& s, float& c) {
    const double a = (double)angf; const double k = __builtin_rint(a * 0.63661977236758134308);
    const double r = (a - k * 1.57079632679489655800) - k * 6.12323399573676603587e-17; const double r2 = r * r;
    double sp = -7.6471637318198164759e-13; sp = sp * r2 + 1.6059043836821614599e-10; sp = sp * r2 - 2.5052108385441718775e-08; sp = sp * r2 + 2.7557319223985890653e-06;
    sp = sp * r2 - 1.9841269841269841270e-04; sp = sp * r2 + 8.3333333333333333333e-03; sp = sp * r2 - 1.6666666666666666667e-01; const double sn = r + r * r2 * sp;
    double cp = 4.7794773323873852974e-14; cp = cp * r2 - 1.1470745597729724714e-11; cp = cp * r2 + 2.0876756987868098979e-09; cp = cp * r2 - 2.7557319223985890653e-07;
    cp = cp * r2 + 2.4801587301587301587e-05; cp = cp * r2 - 1.3888888888888888889e-03; cp = cp * r2 + 4.1666666666666666667e-02; cp = cp * r2 - 0.5; const double cn = 1.0 + r2 * cp;
    const int q = ((int)k) & 3;
    const double ss = (q == 0) ? sn : (q == 1) ? cn : (q == 2) ? -sn : -cn;
    const double cc = (q == 0) ? cn : (q == 1) ? -sn : (q == 2) ? -cn : sn;
    s = (float)ss; c = (float)cc;
}
__device__ __forceinline__ void p0_prologue(const Frame& F, const Args& a) {
    {
        LAS float* sc = (LAS float*)F.lds; LAS float* part = (LAS float*)(F.lds + 32768);
        float* mod = wsp<float>(F, WS_MOD);
        for (int i = F.tid; i < 4 * DM; i += NTHR) { const float v = a.c[i]; sc[i] = v / (1.0f + __expf(-v)); }
        __syncthreads();
        for (int un = F.vcu; un < 384; un += F.G) {
            const int j0 = un * 32, col4 = F.tid & 7, kg = F.tid >> 3;
            f32x4 ac[4];
#pragma unroll
            for (int b = 0; b < 4; ++b) ac[b] = (f32x4){0.f, 0.f, 0.f, 0.f};
#pragma unroll 8
            for (int i = 0; i < 32; ++i) { const int k = kg + 64 * i; const f32x4 w = *(const GAS f32x4*)(a.w_ada + (size_t)k * 12288 + j0 + col4 * 4);
#pragma unroll
                for (int b = 0; b < 4; ++b) ac[b] += w * sc[b * DM + k]; }
#pragma unroll
            for (int b = 0; b < 4; ++b) *(LAS f32x4*)(part + (kg * 4 + b) * 32 + col4 * 4) = ac[b];
            __syncthreads();
            if (F.tid < 128) { const int b = F.tid >> 5, col = F.tid & 31; float s = 0.f;
                for (int g = 0; g < 64; ++g) s += part[(g * 4 + b) * 32 + col];
                mod[b * 12288 + j0 + col] = s + a.b_ada[j0 + col]; }
            __syncthreads();
        }
    }
    const int gw = F.vcu * NWAVES + F.wave, NGW = F.G * NWAVES, gt = F.vcu * NTHR + F.tid, NGT = F.G * NTHR;
    {
        float* cosd = wsp<float>(F, WS_COSD); float* sind = wsp<float>(F, WS_SIND); float* cosm = wsp<float>(F, WS_COSM); float* sinm = wsp<float>(F, WS_SINM);
        for (int i = gt; i < NTOK * 48; i += NGT) { const int t = i / 48, j = i - t * 48; const float p = (float)a.pos[t];
            float s, c;
            if (j < 16) { sincos_d(p * a.invf_d[j], s, c); cosd[t * 16 + j] = c; sind[t * 16 + j] = s; }
            else { sincos_d(p * a.invf_m[j - 16], s, c); cosm[t * 32 + j - 16] = c; sinm[t * 32 + j - 16] = s; } }
    }
    { h16* wr = wsp<h16>(F, W_R);
      for (int i = gt; i < 64 * DM; i += NGT) { const int j = i & 7, lane = (i >> 3) & 63, kk = (i >> 9) & 63, et = i >> 15, fr = lane & 15, fq = lane >> 4;
          wr[i] = (h16)a.w_router[(size_t)(kk * 32 + fq * 8 + j) * 64 + et * 16 + fr]; } }
    { u32x4* z = (u32x4*)(wsp<unsigned char>(F, W_IN) + (size_t)1088 * DM); for (int i = gt; i < 192 * DM / 16; i += NGT) z[i] = (u32x4){0u, 0u, 0u, 0u}; }
    {
        __syncthreads();
        LAS float* scr = (LAS float*)(F.lds + F.wave * 16640);
        constexpr int I_IN = 32 * 153, I_QUP = 8 * 24, I_KVUP = 8 * 32, I_MO = 16 * 32, I_DO = 8 * 32, I_OUT = 32 * 32, I_R = 32, I_SH = 256, I_EX = 256;
        constexpr int NSMALL = I_IN + I_QUP + I_KVUP + I_MO + I_DO + I_OUT + I_R + 3 * I_SH;
        constexpr int NITEMS = NSMALL;
        for (int it = gw; it < NITEMS; it += NGW) {
            int r = it;
            if (r < I_IN) { cvt_item8(a.w_in, DM, 9792, wsp<unsigned char>(F, W_IN), scr, r, F.lane, SC_GU, [](int n) { return row_in(n); }); continue; } r -= I_IN;
            if (r < I_QUP) { cvt_item(a.w_q_up, 512, 1536, wsp<h16>(F, W_QUP), scr, r, F.lane, a.q_a_norm_g, [](int n) { return row_qup(n); }); continue; } r -= I_QUP;
            if (r < I_KVUP) { cvt_item(a.w_kv_up, 512, 2048, wsp<h16>(F, W_KVUP), scr, r, F.lane, a.kv_a_norm_g, [](int n) { return n; }); continue; } r -= I_KVUP;
            if (r < I_MO) { cvt_item(a.w_mla_o, 1024, 2048, wsp<h16>(F, W_MO), scr, r, F.lane, nullptr, [](int n) { return n; }, 1536, 0); continue; } r -= I_MO;
            if (r < I_DO) { cvt_item(a.w_dil_o, 512, 2048, wsp<h16>(F, W_MO), scr, r, F.lane, nullptr, [](int n) { return n; }, 1536, 1024); continue; } r -= I_DO;
            if (r < I_OUT) { cvt_item8(a.w_out, DM, DM, wsp<unsigned char>(F, W_OUT), scr, r, F.lane, SC_GU, [](int n) { return n; }); continue; } r -= I_OUT;
            if (r < I_R) { continue; } r -= I_R;
            if (r < I_SH) { cvt_item8(a.w_sh_gate, DM, 512, wsp<unsigned char>(F, W_GU) + (size_t)64 * 1024 * 2048, scr, r, F.lane, SC_GU, [](int n) { return row_gu(n, 0); }); continue; } r -= I_SH;
            if (r < I_SH) { cvt_item8(a.w_sh_up, DM, 512, wsp<unsigned char>(F, W_GU) + (size_t)64 * 1024 * 2048, scr, r, F.lane, SC_GU, [](int n) { return row_gu(n, 1); }); continue; } r -= I_SH;
            if (r < I_SH) { cvt_item8(a.w_sh_down, 512, DM, wsp<unsigned char>(F, W_DN) + (size_t)64 * 2048 * 512, scr, r, F.lane, SC_DN, [](int n) { return n; }); continue; } r -= I_SH;
        }
        __syncthreads();
    }
}

constexpr int NCONV = 29;
constexpr int N_EXP_ITEMS = 3 * 64 * 256;
struct ExpItem { const float* src; unsigned char* dst; int K, N, kb, nb, up; float scale; };
__device__ __forceinline__ ExpItem exp_item(const Frame& F, const Args& a, int r) {
    const int mat = r / (64 * 256), rr = r - mat * (64 * 256), e = rr >> 8, ii = rr & 255; ExpItem it;
    if (mat < 2) { it.src = (mat ? a.w_exp_up : a.w_exp_gate) + (size_t)e * DM * 512; it.dst = wsp<unsigned char>(F, W_GU) + (size_t)e * 1024 * 2048; it.K = DM; it.N = 512; it.up = mat; it.scale = SC_GU; it.kb = ii >> 3; it.nb = ii & 7; }
    else { it.src = a.w_exp_down + (size_t)e * 512 * DM; it.dst = wsp<unsigned char>(F, W_DN) + (size_t)e * 2048 * 512; it.K = 512; it.N = DM; it.up = -1; it.scale = SC_DN; it.kb = ii >> 5; it.nb = ii & 31; }
    return it;
}
#define EXP_LOAD(v, it) do { _Pragma("unroll") for (int i_ = 0; i_ < 16; ++i_) { const int kk_ = 4 * i_ + (F.lane >> 4); \
        v[i_] = __builtin_nontemporal_load((const GAS f32x4*)((it).src + (size_t)((it).kb * 64 + kk_) * (it).N + (it).nb * 64 + (F.lane & 15) * 4)); } } while (0)
#define EXP_STORE(v, it) do { _Pragma("unroll") for (int i_ = 0; i_ < 16; ++i_) { const int kk_ = 4 * i_ + (F.lane >> 4); const f32x4 t_ = v[i_] * (it).scale; \
            scr[kk_ * 17 + (F.lane & 15)] = pk4_fp8(t_[0], t_[1], t_[2], t_[3]); } \
        LDS_WAIT(); asm volatile("" ::: "memory"); \
        { const int c_ = F.lane & 7; _Pragma("unroll") for (int g_ = 0; g_ < 2; ++g_) { const int n4_ = (F.lane >> 3) + 8 * g_; unsigned d_[8]; \
            _Pragma("unroll") for (int j_ = 0; j_ < 8; ++j_) d_[j_] = scr[(8 * c_ + j_) * 17 + n4_]; \
            unsigned lo_[4], hi_[4]; \
            { const unsigned ta = __builtin_amdgcn_perm(d_[1], d_[0], 0x05010400u), tb = __builtin_amdgcn_perm(d_[1], d_[0], 0x07030602u), ua = __builtin_amdgcn_perm(d_[3], d_[2], 0x05010400u), ub = __builtin_amdgcn_perm(d_[3], d_[2], 0x07030602u); \
              lo_[0] = __builtin_amdgcn_perm(ua, ta, 0x05040100u); lo_[1] = __builtin_amdgcn_perm(ua, ta, 0x07060302u); lo_[2] = __builtin_amdgcn_perm(ub, tb, 0x05040100u); lo_[3] = __builtin_amdgcn_perm(ub, tb, 0x07060302u); } \
            { const unsigned ta = __builtin_amdgcn_perm(d_[5], d_[4], 0x05010400u), tb = __builtin_amdgcn_perm(d_[5], d_[4], 0x07030602u), ua = __builtin_amdgcn_perm(d_[7], d_[6], 0x05010400u), ub = __builtin_amdgcn_perm(d_[7], d_[6], 0x07030602u); \
              hi_[0] = __builtin_amdgcn_perm(ua, ta, 0x05040100u); hi_[1] = __builtin_amdgcn_perm(ua, ta, 0x07060302u); hi_[2] = __builtin_amdgcn_perm(ub, tb, 0x05040100u); hi_[3] = __builtin_amdgcn_perm(ub, tb, 0x07060302u); } \
            _Pragma("unroll") for (int q_ = 0; q_ < 4; ++q_) { const int n_ = (it).nb * 64 + 4 * n4_ + q_; const int row_ = (it).up < 0 ? n_ : row_gu(n_, (it).up); u32x2 o_; o_.x = lo_[q_]; o_.y = hi_[q_]; \
                __builtin_nontemporal_store(o_, (GAS u32x2*)((it).dst + (size_t)row_ * (it).K + (it).kb * 64 + 8 * c_)); } } } \
        LDS_WAIT(); asm volatile("" ::: "memory"); } while (0)
__device__ __forceinline__ void p_convert_experts(const Frame& F, const Args& a, int cw, int ncw, int i0, int i1) {
    __syncthreads();
    LAS unsigned* scr = (LAS unsigned*)(F.lds + F.wave * 4352);
    const int stride = ncw * NWAVES; int r = i0 + cw * NWAVES + F.wave;
    for (; r < i1; r += 2 * stride) {
        f32x4 v0[16], v1[16]; const int r1 = r + stride; const bool h1 = r1 < i1;
        const ExpItem it0 = exp_item(F, a, r), it1 = exp_item(F, a, h1 ? r1 : r);
        EXP_LOAD(v0, it0); if (h1) EXP_LOAD(v1, it1);
        __builtin_amdgcn_sched_barrier(0);
        EXP_STORE(v0, it0);
        if (h1) EXP_STORE(v1, it1);
    }
    __syncthreads();
}
#undef EXP_LOAD
#undef EXP_STORE

__device__ __forceinline__ void p1_h1(const Frame& F, const Args& a) {
    const int gw = F.vcu * NWAVES + F.wave, NGW = F.G * NWAVES;
    const float* mod = wsp<float>(F, WS_MOD); h16* h1 = wsp<h16>(F, A_H1);
    for (int t = gw; t < NTOK; t += NGW) {
        const int b = t >> 12; const GAS f32x4* xr = (const GAS f32x4*)(a.x + (size_t)t * DM) + F.lane;
        f32x4 v[8]; float ss = 0.f;
#pragma unroll
        for (int j = 0; j < 8; ++j) { v[j] = xr[64 * j]; ss += (v[j][0] * v[j][0] + v[j][1] * v[j][1]) + (v[j][2] * v[j][2] + v[j][3] * v[j][3]); }
        const float rstd = 1.0f / sqrtf(wave_sum(ss) * (1.0f / DM) + EPS);
#pragma unroll
        for (int j = 0; j < 8; ++j) { const int c = 4 * F.lane + 256 * j;
            const f32x4 g = *(const f32x4*)(a.attn_pre_g + c), sc = *(const f32x4*)(mod + b * 12288 + 2048 + c), sh = *(const f32x4*)(mod + b * 12288 + c);
            const f32x4 h = v[j] * rstd * g * (sc + 1.0f) + sh;
            *(GAS unsigned*)((unsigned char*)h1 + (size_t)t * DM + c) = pk4_fp8(h[0], h[1], h[2], h[3]); }
    }
}

__device__ __forceinline__ void p4_attention(const Frame& F) {
    const char* qm = (const char*)wsp<h16>(F, A_QM); const char* kv = (const char*)wsp<h16>(F, A_KV); const char* kr = (const char*)wsp<h16>(F, A_KR);
    const char* dil = (const char*)wsp<h16>(F, A_DIL); char* omla = (char*)wsp<h16>(F, A_OMLA); char* od = (char*)wsp<h16>(F, A_OD); float* lse = wsp<float>(F, WS_LSE);
#ifndef MK_REP4
#define MK_REP4 0
#endif
    _Pragma("unroll") for (int rep4a = 0; rep4a < (MK_REP4 == 1 ? 2 : 1); ++rep4a)
    for (int it = F.vcu; it < 256; it += F.G) {
        const int bh = it >> 3, x = it & 7, b = bh >> 3, h = bh & 7;
#pragma unroll 1
        for (int half = 0; half < 2; ++half) {
            const int qb = half ? 15 - x : x; const size_t tok0 = (size_t)b * SEQ;
            att::AUnit u;
            u.Q = qm + (tok0 + qb * 256) * 3072 + h * 256; u.qs = 3072; u.QR = qm + (tok0 + qb * 256) * 3072 + 2048 + h * 128;
            u.K = kv + tok0 * 4096 + h * 512; u.kvs = 4096; u.V = u.K + 256; u.KR = kr + tok0 * 128; u.krs = 128;
            u.O = omla + (tok0 + qb * 256) * 3072 + h * 256; u.os = 3072; u.LSE = nullptr; u.ls = 0;
            u.P0 = qb * 256; u.jlo = 0; u.jhi = qb * 4 + 4; u.W = 0x40000000u;
            att::attn_unit<true>(F.lds, u);
        }
    }
    _Pragma("unroll") for (int rep4b = 0; rep4b < (MK_REP4 == 2 ? 2 : 1); ++rep4b)
    for (int un = F.vcu; un < 768; un += F.G) {
        const int b = un / 192, rem = un - b * 192, head = rem >> 4, sub = rem & 15, g = head >> 2;
        const int d = (g == 0) ? 1 : (g == 1) ? 4 : 16; const int r = sub % d, jb = sub / d;
        const size_t tok0 = (size_t)b * SEQ + r; const unsigned rs = (unsigned)d * 9216u;
        att::AUnit u;
        u.Q = dil + (tok0 + (size_t)d * 256 * jb) * 9216 + head * 256; u.qs = rs; u.QR = nullptr;
        u.K = dil + tok0 * 9216 + 3072 + head * 256; u.kvs = rs; u.V = dil + tok0 * 9216 + 6144 + head * 256; u.KR = nullptr; u.krs = 0;
        u.O = od + (tok0 + (size_t)d * 256 * jb) * 3072 + head * 256; u.os = (unsigned)d * 3072u;
        u.LSE = lse + (tok0 + (size_t)d * 256 * jb) * 12 + head; u.ls = (unsigned)d * 12u;
        u.P0 = jb * 256; u.jlo = jb == 0 ? 0 : jb * 4 - 2; u.jhi = jb * 4 + 4; u.W = 129u;
        att::attn_unit<false>(F.lds, u);
    }
    __syncthreads();
}
__device__ __forceinline__ void p5_combine(const Frame& F) {
    const int gw = F.vcu * NWAVES + F.wave, NGW = F.G * NWAVES;
    const h16* od = wsp<h16>(F, A_OD); const float* lse = wsp<float>(F, WS_LSE); h16* odil = wsp<h16>(F, A_ODIL);
    for (int t = gw; t < NTOK; t += NGW) {
        const int hs = F.lane >> 4, dc = (F.lane & 15) * 8;
        const float l0 = lse[(size_t)t * 12 + hs], l1 = lse[(size_t)t * 12 + 4 + hs], l2 = lse[(size_t)t * 12 + 8 + hs];
        const float mx = fmaxf(l0, fmaxf(l1, l2));
        float w0 = __builtin_amdgcn_exp2f(l0 - mx), w1 = __builtin_amdgcn_exp2f(l1 - mx), w2 = __builtin_amdgcn_exp2f(l2 - mx);
        const float inv = 1.0f / (w0 + w1 + w2); w0 *= inv; w1 *= inv; w2 *= inv;
        f32x4 a0, a1, b0, b1, c0, c1;
        unpk8(*(const GAS u32x4*)(od + (size_t)t * 1536 + hs * 128 + dc), a0, a1);
        unpk8(*(const GAS u32x4*)(od + (size_t)t * 1536 + 512 + hs * 128 + dc), b0, b1);
        unpk8(*(const GAS u32x4*)(od + (size_t)t * 1536 + 1024 + hs * 128 + dc), c0, c1);
        const f32x4 r0 = a0 * w0 + b0 * w1 + c0 * w2, r1 = a1 * w0 + b1 * w1 + c1 * w2;
        *(GAS u32x4*)(odil + (size_t)t * 1536 + 1024 + hs * 128 + dc) = pk8(r0, r1);
    }
}

__device__ __forceinline__ void p8_router(const Frame& F, const Args& a) {
    constexpr int HP = 4128;
    LAS unsigned char* h2l = F.lds; LAS float* lg = (LAS float*)(F.lds + 32 * HP);
    LAS unsigned* lcnt = (LAS unsigned*)(F.lds + 32 * HP + 8192); LAS unsigned* lbase = lcnt + 64; LAS unsigned* rec = lbase + 64; LAS float* recw = (LAS float*)(rec + 192);
    if (F.tid < 64) lcnt[F.tid] = 0u;
    const float* mod = wsp<float>(F, WS_MOD); const h16* yat = wsp<h16>(F, A_YAT); unsigned char* h2 = wsp<unsigned char>(F, A_H2); const h16* wr_t = wsp<h16>(F, W_R);
    unsigned* cnt = wsp<unsigned>(F, WS_CTL) + CW_CNT; unsigned* list = wsp<unsigned>(F, WS_LIST); unsigned* tokpos = wsp<unsigned>(F, WS_TOKPOS); float* tokw = wsp<float>(F, WS_TOKW);
    h16* xmid = wsp<h16>(F, A_XMID);
    const int fr = F.lane & 15, fq = F.lane >> 4;
    for (int tb = F.vcu; tb < NTOK / 32; tb += F.G) {
        __syncthreads();
#ifndef MK_REP8
#define MK_REP8 0
#endif
#pragma unroll 1
        for (int q8 = 0; q8 < (MK_REP8 == 1 ? 8 : 4); q8 += 2) { const int q = q8 & 3;
            const int tl = F.wave * 4 + q, t = tb * 32 + tl, b = t >> 12;
            h16x4 yh[2][8]; f32x4 xv[2][8];
#pragma unroll
            for (int z = 0; z < 2; ++z)
#pragma unroll
                for (int j = 0; j < 8; ++j) { yh[z][j] = *(const GAS h16x4*)(yat + (size_t)(t + z) * DM + 4 * F.lane + 256 * j); xv[z][j] = *(const GAS f32x4*)(a.x + (size_t)(t + z) * DM + 4 * F.lane + 256 * j); }
            __builtin_amdgcn_sched_barrier(0);
            float ss[2] = {0.f, 0.f};
#pragma unroll
            for (int z = 0; z < 2; ++z)
#pragma unroll
                for (int j = 0; j < 8; ++j) { const float y0 = (float)yh[z][j][0], y1 = (float)yh[z][j][1], y2 = (float)yh[z][j][2], y3 = (float)yh[z][j][3]; ss[z] += (y0 * y0 + y1 * y1) + (y2 * y2 + y3 * y3); }
            const float r10 = 1.0f / sqrtf(wave_sum(ss[0]) * (1.0f / DM) + EPS), r11 = 1.0f / sqrtf(wave_sum(ss[1]) * (1.0f / DM) + EPS);
            float ss2[2] = {0.f, 0.f};
#pragma unroll
            for (int j = 0; j < 8; ++j) { const int c = 4 * F.lane + 256 * j; const f32x4 pg = *(const f32x4*)(a.attn_post_g + c), pa = *(const f32x4*)(mod + b * 12288 + 2 * 2048 + c);
#pragma unroll
                for (int z = 0; z < 2; ++z) { const float r1 = z ? r11 : r10;
                    const f32x4 yv = (f32x4){(float)yh[z][j][0], (float)yh[z][j][1], (float)yh[z][j][2], (float)yh[z][j][3]};
                    const f32x4 xm = xv[z][j] + pa * (yv * r1 * pg);
                    { u32x2 wx; wx.x = pkh(xm[0], xm[1]); wx.y = pkh(xm[2], xm[3]); *(GAS u32x2*)(xmid + (size_t)(t + z) * DM + c) = wx; } xv[z][j] = xm;
                    ss2[z] += (xm[0] * xm[0] + xm[1] * xm[1]) + (xm[2] * xm[2] + xm[3] * xm[3]); } }
            const float r20 = 1.0f / sqrtf(wave_sum(ss2[0]) * (1.0f / DM) + EPS), r21 = 1.0f / sqrtf(wave_sum(ss2[1]) * (1.0f / DM) + EPS);
#pragma unroll
            for (int j = 0; j < 8; ++j) { const int c = 4 * F.lane + 256 * j;
                const f32x4 pg = *(const f32x4*)(a.ffn_pre_g + c), sc = *(const f32x4*)(mod + b * 12288 + 4 * 2048 + c), sh = *(const f32x4*)(mod + b * 12288 + 3 * 2048 + c);
#pragma unroll
                for (int z = 0; z < 2; ++z) { const float r2 = z ? r21 : r20;
                    const f32x4 h = xv[z][j] * r2 * pg * (sc + 1.0f) + sh;
                    u32x2 w; w.x = pkh(h[0], h[1]); w.y = pkh(h[2], h[3]);
                    *(GAS unsigned*)(h2 + (size_t)(t + z) * DM + c) = pk4_fp8(h[0], h[1], h[2], h[3]);
                    *(LAS u32x2*)(h2l + (tl + z) * HP + c * 2) = w; } }
        }
        __syncthreads();
        {
            const int et = F.wave & 3, kh = F.wave >> 2; f32x4 acc0 = (f32x4){0.f, 0.f, 0.f, 0.f}, acc1 = acc0;
            const LAS unsigned char* ap = h2l + fr * HP + fq * 16 + kh * 2048; const h16* bp = wr_t + (size_t)(et * 64 + kh * 32) * 512 + F.lane * 8;
#pragma unroll 16
            for (int kk = 0; kk < 32; ++kk) { const h16x8 bv = *(const GAS h16x8*)(bp + kk * 512);
                const h16x8 a0 = *(const LAS h16x8*)(ap + kk * 64), a1 = *(const LAS h16x8*)(ap + 16 * HP + kk * 64);
                acc0 = __builtin_amdgcn_mfma_f32_16x16x32_f16(a0, bv, acc0, 0, 0, 0); acc1 = __builtin_amdgcn_mfma_f32_16x16x32_f16(a1, bv, acc1, 0, 0, 0); }
            __syncthreads();
            LAS float* pt = (LAS float*)h2l;
            if (kh == 1) {
#pragma unroll
                for (int j = 0; j < 4; ++j) { pt[(4 * fq + j) * 64 + et * 16 + fr] = acc0[j]; pt[(16 + 4 * fq + j) * 64 + et * 16 + fr] = acc1[j]; } }
            __syncthreads();
            if (kh == 0) {
#pragma unroll
                for (int j = 0; j < 4; ++j) { lg[(4 * fq + j) * 64 + et * 16 + fr] = acc0[j] + pt[(4 * fq + j) * 64 + et * 16 + fr]; lg[(16 + 4 * fq + j) * 64 + et * 16 + fr] = acc1[j] + pt[(16 + 4 * fq + j) * 64 + et * 16 + fr]; } }
        }
        __syncthreads();
#pragma unroll 1
        for (int q = 0; q < 4; ++q) {
            const int tl = F.wave * 4 + q, e = F.lane;
            const float score = sigmoidf_(lg[tl * 64 + e]); const float biased = score + a.router_bias[e];
            float m1 = biased;
            m1 = fmaxf(m1, __shfl_xor(m1, 1)); m1 = fmaxf(m1, __shfl_xor(m1, 2)); m1 = fmaxf(m1, __shfl_xor(m1, 4));
            const unsigned long long bal = __ballot(biased == m1); const unsigned gb = (unsigned)(bal >> (e & 56)) & 0xFFu; const int first = __builtin_ctz(gb);
            float v2 = ((e & 7) == first) ? -__builtin_inff() : biased;
            v2 = fmaxf(v2, __shfl_xor(v2, 1)); v2 = fmaxf(v2, __shfl_xor(v2, 2)); v2 = fmaxf(v2, __shfl_xor(v2, 4));
            const float gs = m1 + v2; const int g = e >> 3; int grank = 0;
#pragma unroll
            for (int g2 = 0; g2 < 8; ++g2) { const float s2 = __int_as_float(__builtin_amdgcn_readlane(__float_as_int(gs), g2 * 8)); grank += (s2 > gs || (s2 == gs && g2 < g)) ? 1 : 0; }
            const float sel = grank < 4 ? biased : -__builtin_inff(); int rank = 0;
#pragma unroll
            for (int e2 = 0; e2 < 64; ++e2) { const float s2 = __int_as_float(__builtin_amdgcn_readlane(__float_as_int(sel), e2)); rank += (s2 > sel || (s2 == sel && e2 < e)) ? 1 : 0; }
            const bool chosen = rank < TOPK;
            const float wsum = wave_sum(chosen ? score : 0.f);
            if (chosen) { const float w = score / (wsum + 1e-20f) * 2.5f;
                const unsigned sl = __hip_atomic_fetch_add(lcnt + e, 1u, __ATOMIC_RELAXED, __HIP_MEMORY_SCOPE_WORKGROUP);
                rec[tl * 6 + rank] = ((unsigned)e << 20) | sl; recw[tl * 6 + rank] = w; }
        }
        __syncthreads();
        if (F.tid < 64) { const unsigned n = lcnt[F.tid]; lbase[F.tid] = n ? __hip_atomic_fetch_add(cnt + 64 * F.tid, n, __ATOMIC_RELAXED, __HIP_MEMORY_SCOPE_AGENT) : 0u; lcnt[F.tid] = 0u; }
        __syncthreads();
        if (F.tid < 192) { const int tl = F.tid / 6, r = F.tid - tl * 6, t = tb * 32 + tl; const unsigned rc = rec[F.tid]; const unsigned e = rc >> 20, slot = lbase[e] + (rc & 0xFFFFFu);
            list[(size_t)e * LISTCAP + slot] = (unsigned)t; tokpos[(size_t)t * 6 + r] = (e << 20) | slot; tokw[(size_t)t * 6 + r] = recw[F.tid]; }
    }
}

__device__ __forceinline__ void p11_final(const Frame& F, const Args& a) {
    const int gw = F.vcu * NWAVES + F.wave, NGW = F.G * NWAVES;
    const LAS int* tstart = (const LAS int*)(F.lds + LDS_TAB);
    const h16* xmid = wsp<h16>(F, A_XMID);
    const float* mod = wsp<float>(F, WS_MOD); const unsigned char* ys = wsp<unsigned char>(F, A_YS); const unsigned* tokpos = wsp<unsigned>(F, WS_TOKPOS); const float* tokw = wsp<float>(F, WS_TOKW);
    for (int t = gw; t < NTOK; t += NGW) {
        const int b = t >> 12;
        unsigned prow = 0; float w = 0.f;
        if (F.lane < 6) { const unsigned p = tokpos[(size_t)t * 6 + F.lane]; prow = (unsigned)tstart[p >> 20] * 256u + (p & 0xFFFFFu); w = tokw[(size_t)t * 6 + F.lane]; }
        if (F.lane == 6) { prow = (unsigned)tstart[64] * 256u + (unsigned)t; w = 1.0f; }
        u32x2 raw[7][4]; f32x4 xm[8];
#pragma unroll
        for (int k = 0; k < 7; ++k) { const unsigned pr = __shfl(prow, k);
#pragma unroll
            for (int j = 0; j < 4; ++j) raw[k][j] = *(const GAS u32x2*)(ys + (size_t)pr * DM + 8 * F.lane + 512 * j); }
#pragma unroll
        for (int j = 0; j < 4; ++j) unpk8(*(const GAS u32x4*)(xmid + (size_t)t * DM + 8 * F.lane + 512 * j), xm[2 * j], xm[2 * j + 1]);
        __builtin_amdgcn_sched_barrier(0);
        f32x4 acc[8];
#pragma unroll
        for (int j = 0; j < 8; ++j) acc[j] = (f32x4){0.f, 0.f, 0.f, 0.f};
#pragma unroll
        for (int k = 0; k < 7; ++k) { const float wk = __shfl(w, k);
#pragma unroll
            for (int j = 0; j < 4; ++j) { const f32x2 a0 = __builtin_amdgcn_cvt_pk_f32_fp8((int)raw[k][j].x, false), a1 = __builtin_amdgcn_cvt_pk_f32_fp8((int)raw[k][j].x, true),
                                                      b0 = __builtin_amdgcn_cvt_pk_f32_fp8((int)raw[k][j].y, false), b1 = __builtin_amdgcn_cvt_pk_f32_fp8((int)raw[k][j].y, true);
                acc[2 * j] += (f32x4){a0[0], a0[1], a1[0], a1[1]} * wk; acc[2 * j + 1] += (f32x4){b0[0], b0[1], b1[0], b1[1]} * wk; } }
        float ss = 0.f;
#pragma unroll
        for (int j = 0; j < 8; ++j) ss += (acc[j][0] * acc[j][0] + acc[j][1] * acc[j][1]) + (acc[j][2] * acc[j][2] + acc[j][3] * acc[j][3]);
        f32x4 pg[8], pf[8];
#pragma unroll
        for (int j = 0; j < 8; ++j) { const int c = 8 * F.lane + 512 * (j >> 1) + 4 * (j & 1); pg[j] = *(const f32x4*)(a.ffn_post_g + c); pf[j] = *(const f32x4*)(mod + b * 12288 + 5 * 2048 + c); }
        const float rstd = 1.0f / sqrtf(wave_sum(ss) * (1.0f / DM) + EPS);
#pragma unroll
        for (int j = 0; j < 8; ++j) { const int c = 8 * F.lane + 512 * (j >> 1) + 4 * (j & 1);
            *(GAS f32x4*)(a.out + (size_t)t * DM + c) = xm[j] + pf[j] * (acc[j] * rstd * pg[j]); }
    }
}

constexpr int NPHASE = 12;
__global__ void __launch_bounds__(NTHR, 2) mk_fwd(Args args) {
    extern __shared__ __attribute__((aligned(16))) unsigned char lds_raw[];
    Frame F;
    F.lds = (LAS unsigned char*)lds_raw;
    F.tid = threadIdx.x; F.lane = F.tid & 63; F.wave = __builtin_amdgcn_readfirstlane(F.tid >> 6);
    F.G = gridDim.x; { const int bx = blockIdx.x; F.vcu = (F.G % 8 == 0) ? (bx % 8) * (F.G / 8) + bx / 8 : bx; }
    F.ws = args.ws;
    unsigned* ctl = (unsigned*)(args.ws + WS_CTL);
    const int lo = args.ph_lo, hi = args.ph_hi;
    if (F.tid < 16) ((LAS unsigned*)(F.lds + LDS_MISC))[F.tid] = 0u;
    __syncthreads();
    XcdBarrier bar; bar.bar = ctl + CW_BAR; bar.x = 0; bar.st = nullptr;
    if (hi - lo > 1) bar = xcd_barrier_post(ctl + CW_BAR, (volatile LAS unsigned*)(F.lds + LDS_MISC));
#ifndef MK_ONLY
#define MK_ONLY -1
#endif
#define IN(k) ((MK_ONLY < 0 || (k) == MK_ONLY) && lo <= (k) && (k) < hi)
#ifndef MK_TP
#define MK_TP -1
#endif
#ifndef MK_TK
#define MK_TK 8
#endif
    unsigned long long tp_prev = 0ull, tp_dt = 0ull;
    if (MK_TP >= 0 && blockIdx.x == 0 && F.tid == 0) tp_prev = wall_clock64();
    const unsigned long long tp_start = tp_prev;
#define SEAM(k) do { if (IN(k) && IN((k) + 1)) xcd_barrier(bar); \
        if (MK_TP >= 0 && blockIdx.x == 0 && F.tid == 0) { const unsigned long long now_ = wall_clock64(); if ((k) == MK_TP) tp_dt = now_ - tp_prev; tp_prev = now_; } } while (0)
#ifndef MK_REP
#define MK_REP -1
#endif
#define REPS(k) _Pragma("unroll") for (int rep_ = 0; rep_ < ((k) == MK_REP ? 2 : 1); ++rep_)

    if (IN(0)) REPS(0) { p0_prologue(F, args); } SEAM(0);
    if (IN(1)) REPS(1) { p1_h1(F, args); } SEAM(1);
    const bool split = F.G > 4 * NCONV; const int GG = split ? F.G - NCONV : F.G; const bool conv = split && (int)blockIdx.x >= GG; const int cw = (int)blockIdx.x - GG;
    constexpr int CONV_DEF = (N_EXP_ITEMS / 100) * 30, CONV_CUT = (N_EXP_ITEMS / 100) * 23;
    if (IN(0)) p_convert_experts(F, args, F.vcu, F.G, split ? CONV_DEF : 0, N_EXP_ITEMS);
    if (IN(2)) REPS(2) {
        if (conv) p_convert_experts(F, args, cw, NCONV, 0, CONV_CUT);
        else {
        pg8::StaticOrder S; S.init(wsp<h16>(F, A_H1), DM / 2, wsp<h16>(F, W_IN), DM / 2, NPROJ, GG, (int)blockIdx.x);
        EpiIn E{wsp<h16>(F, A_QA), wsp<h16>(F, A_KR), wsp<h16>(F, A_DIL), wsp<h16>(F, A_GATE), wsp<float>(F, WS_ROWSQ), wsp<float>(F, WS_COSD), wsp<float>(F, WS_SIND), wsp<float>(F, WS_COSM), wsp<float>(F, WS_SINM)};
        pg8::gemm_phase<EpiIn, pg8::StaticOrder, false, true>(F.lds, DM / 2, DM / 2, S, E);
        }
    } SEAM(2);
    if (IN(3)) REPS(3) {
        if (conv) p_convert_experts(F, args, cw, NCONV, CONV_CUT, CONV_DEF);
        else {
        UpOrder S{(const char*)wsp<h16>(F, A_QA), (const char*)wsp<h16>(F, W_QUP), (const char*)wsp<h16>(F, W_KVUP), GG, split ? (int)blockIdx.x : F.vcu};
        EpiUp E{wsp<h16>(F, A_QM), wsp<h16>(F, A_KV), wsp<float>(F, WS_ROWSQ), wsp<float>(F, WS_COSM), wsp<float>(F, WS_SINM)};
        pg8::gemm_phase<EpiUp, UpOrder, false>(F.lds, 512, 1024, S, E);
        }
    } SEAM(3);
    if (IN(4)) REPS(4) { p4_attention(F); } SEAM(4);
    if (IN(5)) REPS(5) { p5_combine(F); } SEAM(5);
    if (IN(6)) REPS(6) {
        pg8::StaticOrder S; S.init(wsp<h16>(F, A_CAT), 1536, wsp<h16>(F, W_MO), 1536, DM, F.G, (int)blockIdx.x);
        EpiMerge E{wsp<h16>(F, A_MRG), wsp<h16>(F, A_GATE)};
        pg8::gemm_phase<EpiMerge, pg8::StaticOrder, false>(F.lds, 1536, 1536, S, E);
    } SEAM(6);
    if (IN(7)) REPS(7) {
        pg8::StaticOrder S; S.init(wsp<h16>(F, A_MRG), DM / 2, wsp<h16>(F, W_OUT), DM / 2, DM, F.G, (int)blockIdx.x);
        EpiOut<0> E{wsp<h16>(F, A_YAT), DM, nullptr, 0, nullptr, 1.0f / SC_GU};
        pg8::gemm_phase<EpiOut<0>, pg8::StaticOrder, false, true>(F.lds, DM / 2, DM / 2, S, E);
    } SEAM(7);
    if (IN(8)) { p8_router(F, args);
        if (MK_REP == 8) { xcd_barrier(bar); if (blockIdx.x == 0 && F.tid < 64) (ctl + CW_CNT)[64 * F.tid] = 0u; xcd_barrier(bar); p8_router(F, args); }
        if (MK_REP == 100) { for (int i = 0; i < 10; ++i) xcd_barrier(bar); }
    } SEAM(8);
    if (IN(9)) REPS(9) {
        moe_tables(F, ctl + CW_CNT);
        MoeOrder<4, true> S{(const LAS int*)(F.lds + LDS_TAB), (const LAS int*)(F.lds + LDS_TAB + 512), (const LAS int*)(F.lds + LDS_TAB + 1024),
                            (const char*)wsp<h16>(F, A_H2), (const char*)wsp<h16>(F, W_GU), wsp<unsigned>(F, WS_LIST), F.G, F.vcu};
        EpiSwiglu E{wsp<unsigned char>(F, A_ACT)};
        pg8::gemm_phase<EpiSwiglu, MoeOrder<4, true>, true, true>(F.lds, DM / 2, DM / 2, S, E);
    } SEAM(9);
    if (IN(10)) REPS(10) {
        moe_tables(F, ctl + CW_CNT);
        MoeOrder<8, false> S{(const LAS int*)(F.lds + LDS_TAB), (const LAS int*)(F.lds + LDS_TAB + 512), (const LAS int*)(F.lds + LDS_TAB + 1024),
                             (const char*)wsp<h16>(F, A_ACT), (const char*)wsp<h16>(F, W_DN), wsp<unsigned>(F, WS_LIST), F.G, F.vcu};
        EpiOut<3> E{wsp<h16>(F, A_YS), DM, nullptr, 0, nullptr, 1.0f / SC_DN};
        pg8::gemm_phase<EpiOut<3>, MoeOrder<8, false>, false, true>(F.lds, 256, 256, S, E);
    } SEAM(10);
    if (IN(11)) REPS(11) { moe_tables(F, ctl + CW_CNT); p11_final(F, args); }
    if (MK_TP >= 12 && hi - lo > 1) xcd_barrier(bar);
    if (MK_TP >= 0 && blockIdx.x == 0 && F.tid == 0) {
        if (MK_TP == 11 || MK_TP == 12) { VM_WAIT(); tp_dt = wall_clock64() - tp_prev; }
        if (MK_TP == 13) { VM_WAIT(); tp_dt = wall_clock64() - tp_start; }
        const unsigned long long t0_ = wall_clock64();
        while (wall_clock64() - t0_ < tp_dt * MK_TK) __builtin_amdgcn_s_sleep(8);
    }
#undef IN
#undef SEAM
}

#if MK_DIAG
constexpr size_t WS_SAVE = 15 * MiB;
__device__ __forceinline__ unsigned hsh(unsigned a) { a ^= a >> 16; a *= 0x7feb352dU; a ^= a >> 15; a *= 0x846ca68bU; a ^= a >> 16; return a; }
__device__ __forceinline__ void dg_put(unsigned* ctl, int slot, float got, float want, float atol) {
    float e = fabsf(got - want) / (fabsf(want) + atol); if (!(e < 1e30f)) e = 1e30f;
    atomicMax(ctl + CW_DIAG + slot, __float_as_uint(e));
}
__device__ __forceinline__ float dg_dot(const h16* arow, const float* W, int K, int ldw, int col) { float s = 0.f; for (int k = 0; k < K; ++k) s += (float)arow[k] * W[(size_t)k * ldw + col]; return s; }
__device__ __forceinline__ void dg_cs(float ang, float& c, float& s_) { const double a = (double)ang; const double tw = 6.283185307179586476925; const double r = a - tw * floor(a / tw); c = cosf((float)r); s_ = sinf((float)r); }
__device__ __forceinline__ int dg_tstart(const unsigned* cnt, int e) { int s = 0; for (int j = 0; j < e; ++j) s += ((j < 64 ? (int)cnt[64 * j] : NTOK) + 255) >> 8; return s; }
__global__ void __launch_bounds__(256) diag_check(Args a, int phase) {
    unsigned char* ws = a.ws; unsigned* ctl = (unsigned*)(ws + WS_CTL);
    const int gid = blockIdx.x * 256 + threadIdx.x; const unsigned h0 = hsh(gid * 7919u + phase * 104729u + 12345u), h1v = hsh(h0 + 1u), h2v = hsh(h0 + 2u);
    const float* mod = (const float*)(ws + WS_MOD);
    __shared__ float red[256 * 6]; __shared__ float sc64[64]; __shared__ float bs64[64];
    if (phase == 0) {
        if (gid < 512) { const int b = h0 & 3, j = h1v % 12288; float s = 0.f; for (int k = 0; k < DM; ++k) { const float v = a.c[b * DM + k]; s += v / (1.f + expf(-v)) * a.w_ada[(size_t)k * 12288 + j]; }
            dg_put(ctl, 0, mod[b * 12288 + j], s + a.b_ada[j], 0.02f); }
        else if (gid < 4096) { const int which = h0 % 9; const int e = h1v & 63; float got, want;
            if (which == 0) { const int k = h2v % DM, n = hsh(h2v) % 9792; got = (float)((const h16*)(ws + W_IN))[(size_t)row_in(n) * DM + k]; want = a.w_in[(size_t)k * 9792 + n]; }
            else if (which == 1) { const int k = h2v % 512, n = hsh(h2v) % 1536; got = (float)((const h16*)(ws + W_QUP))[(size_t)row_qup(n) * 512 + k]; want = a.w_q_up[(size_t)k * 1536 + n] * a.q_a_norm_g[k]; }
            else if (which == 2) { const int k = h2v % 512, n = hsh(h2v) % 2048; got = (float)((const h16*)(ws + W_KVUP))[(size_t)n * 512 + k]; want = a.w_kv_up[(size_t)k * 2048 + n] * a.kv_a_norm_g[k]; }
            else if (which == 3) { const int k = h2v % 1024, n = hsh(h2v) % 2048; got = (float)((const h16*)(ws + W_MO))[(size_t)n * 1024 + k]; want = a.w_mla_o[(size_t)k * 2048 + n]; }
            else if (which == 4) { const int k = h2v % 512, n = hsh(h2v) % 2048; got = (float)((const h16*)(ws + W_DO))[(size_t)n * 512 + k]; want = a.w_dil_o[(size_t)k * 2048 + n]; }
            else if (which == 5) { const int k = h2v % DM, n = hsh(h2v) % 2048; got = (float)((const h16*)(ws + W_OUT))[(size_t)n * DM + k]; want = a.w_out[(size_t)k * DM + n]; }
            else if (which == 6) { const int k = h2v % DM, n = hsh(h2v) % 64; got = (float)((const h16*)(ws + W_R))[(size_t)n * DM + k]; want = a.w_router[(size_t)k * 64 + n]; }
            else if (which == 7) { const int k = h2v % DM, n = hsh(h2v) % 512, up = (h2v >> 20) & 1; const int ee = (h1v % 65);
                got = (float)((const h16*)(ws + W_GU))[((size_t)ee * 1024 + (n >> 7) * 256 + up * 128 + (n & 127)) * DM + k];
                const float* src = ee < 64 ? (up ? a.w_exp_up : a.w_exp_gate) + (size_t)ee * DM * 512 : (up ? a.w_sh_up : a.w_sh_gate); want = src[(size_t)k * 512 + n]; }
            else { const int k = h2v % 512, n = hsh(h2v) % DM; const int ee = (h1v % 65);
                got = (float)((const h16*)(ws + W_DN))[((size_t)ee * 2048 + n) * 512 + k]; const float* src = ee < 64 ? a.w_exp_down + (size_t)ee * 512 * DM : a.w_sh_down; want = src[(size_t)k * DM + n]; }
            (void)e; dg_put(ctl, 0, got, want, 1e-3f); }
        else if (gid < 8192) { const int t = h0 % NTOK, j = h1v % 48; const float pf = (float)a.pos[t]; float c, s_;
            if (j < 16) { dg_cs(pf * a.invf_d[j], c, s_); dg_put(ctl, 0, ((const float*)(ws + WS_COSD))[t * 16 + j], c, 0.05f); dg_put(ctl, 0, ((const float*)(ws + WS_SIND))[t * 16 + j], s_, 0.05f); }
            else { dg_cs(pf * a.invf_m[j - 16], c, s_); dg_put(ctl, 0, ((const float*)(ws + WS_COSM))[t * 32 + j - 16], c, 0.05f); dg_put(ctl, 0, ((const float*)(ws + WS_SINM))[t * 32 + j - 16], s_, 0.05f); } }
    } else if (phase == 1) {
        if (gid < 2048) { const int t = h0 % NTOK, c = h1v % DM, b = t >> 12; float ss = 0.f; for (int k = 0; k < DM; ++k) { const float v = a.x[(size_t)t * DM + k]; ss += v * v; }
            const float rstd = 1.f / sqrtf(ss / DM + EPS); const float want = a.x[(size_t)t * DM + c] * rstd * a.attn_pre_g[c] * (1.f + mod[b * 12288 + 2048 + c]) + mod[b * 12288 + c];
            dg_put(ctl, 1, (float)((const h16*)(ws + A_H1))[(size_t)t * DM + c], want, 0.05f); }
    } else if (phase == 2) {
        const h16* h1 = (const h16*)(ws + A_H1);
        if (gid < 4096) { const int t = h0 % NTOK; int c = h1v % 9792; const h16* ar = h1 + (size_t)t * DM; const float pf = (float)a.pos[t]; float got, want;
            if (c < 1024) { want = dg_dot(ar, a.w_in, DM, 9792, c); got = (float)((const h16*)(ws + A_QA))[(size_t)t * 1024 + c]; }
            else if (c < 1088) { const int i = (c - 1024) & 31, second = (c - 1024) >> 5; const float t1 = dg_dot(ar, a.w_in, DM, 9792, 1024 + i), t2 = dg_dot(ar, a.w_in, DM, 9792, 1024 + 32 + i);
                float cs, sn; dg_cs(pf * a.invf_m[i], cs, sn); want = second ? t2 * cs + t1 * sn : t1 * cs - t2 * sn; got = (float)((const h16*)(ws + A_KR))[(size_t)t * 64 + 2 * i + second]; }
            else if (c < 5696) { const int dc = c - 1088, part = dc / 1536, hd = (dc % 1536) >> 7, dim = dc & 127;
                if (part < 2 && dim < 32) { const int i = dim & 15, second = dim >> 4; const int cb = c - dim; const float t1 = dg_dot(ar, a.w_in, DM, 9792, cb + i), t2 = dg_dot(ar, a.w_in, DM, 9792, cb + 16 + i);
                    float cs, sn; dg_cs(pf * a.invf_d[i], cs, sn); want = second ? t2 * cs + t1 * sn : t1 * cs - t2 * sn; if (part == 0) want *= QS_D;
                    got = (float)((const h16*)(ws + A_DIL))[(size_t)t * 4608 + part * 1536 + hd * 128 + 2 * i + second]; }
                else { want = dg_dot(ar, a.w_in, DM, 9792, c); if (part == 0) want *= QS_D; got = (float)((const h16*)(ws + A_DIL))[(size_t)t * 4608 + dc]; } }
            else { want = 1.f / (1.f + expf(-dg_dot(ar, a.w_in, DM, 9792, c))); got = (float)((const h16*)(ws + A_GATE))[(size_t)t * 4096 + (c - 5696)]; }
            dg_put(ctl, 2, got, want, 0.05f); }
        else if (gid < 4608) { const int t = h0 % NTOK, which = h1v & 1; const h16* qa = (const h16*)(ws + A_QA) + (size_t)t * 1024 + which * 512; float ss = 0.f; for (int k = 0; k < 512; ++k) ss += (float)qa[k] * (float)qa[k];
            const float* rq = (const float*)(ws + WS_ROWSQ) + (size_t)t * 16 + which * 8; float g = 0.f; for (int k = 0; k < 8; ++k) g += rq[k]; dg_put(ctl, 2, g, ss, 1.0f); }
    } else if (phase == 3) {
        if (gid < 4096) { const int t = h0 % NTOK, which = h1v & 1; const h16* qa = (const h16*)(ws + A_QA) + (size_t)t * 1024 + which * 512; const float pf = (float)a.pos[t];
            float ss = 0.f; for (int k = 0; k < 512; ++k) ss += (float)qa[k] * (float)qa[k]; const float rstd = 1.f / sqrtf(ss / 512.f + EPS); float got, want;
            if (which == 0) { const int cq = h2v % 1536, hd = cq / 192, j = cq % 192;
                if (j < 128) { float s_ = 0.f; for (int k = 0; k < 512; ++k) s_ += (float)qa[k] * rstd * a.q_a_norm_g[k] * a.w_q_up[(size_t)k * 1536 + cq]; want = s_ * QS_M; got = (float)((const h16*)(ws + A_QM))[(size_t)t * 1536 + hd * 128 + j]; }
                else { const int i = (j - 128) & 31, second = (j - 128) >> 5; float t1 = 0.f, t2 = 0.f;
                    for (int k = 0; k < 512; ++k) { const float nv = (float)qa[k] * rstd * a.q_a_norm_g[k]; t1 += nv * a.w_q_up[(size_t)k * 1536 + hd * 192 + 128 + i]; t2 += nv * a.w_q_up[(size_t)k * 1536 + hd * 192 + 160 + i]; }
                    float cs, sn; dg_cs(pf * a.invf_m[i], cs, sn); want = (second ? t2 * cs + t1 * sn : t1 * cs - t2 * sn) * QS_M; got = (float)((const h16*)(ws + A_QM))[(size_t)t * 1536 + 1024 + hd * 64 + 2 * i + second]; } }
            else { const int c = h2v % 2048; float s_ = 0.f; for (int k = 0; k < 512; ++k) s_ += (float)qa[k] * rstd * a.kv_a_norm_g[k] * a.w_kv_up[(size_t)k * 2048 + c]; want = s_; got = (float)((const h16*)(ws + A_KV))[(size_t)t * 2048 + c]; }
            dg_put(ctl, 3, got, want, 0.05f); }
    } else if (phase == 4) {
        const unsigned hb = hsh(blockIdx.x * 2654435761u + 777u); const int t = hb % NTOK, b = t >> 12, sp = t & 4095; const int tid = threadIdx.x;
        float m = -1e30f, l = 0.f, o0 = 0.f, o1 = 0.f, o2 = 0.f, o3 = 0.f; const int dsel = (hb >> 16) & 31;
        if (blockIdx.x < 96) { const int hd = (hb >> 21) & 7; const h16* q = (const h16*)(ws + A_QM) + (size_t)t * 1536;
            for (int kp = tid; kp <= sp; kp += 256) { const size_t tk = (size_t)b * SEQ + kp; const h16* kk = (const h16*)(ws + A_KV) + tk * 2048 + hd * 256; const h16* kr = (const h16*)(ws + A_KR) + tk * 64;
                float s_ = 0.f; for (int d = 0; d < 128; ++d) s_ += (float)q[hd * 128 + d] * (float)kk[d]; for (int d = 0; d < 64; ++d) s_ += (float)q[1024 + hd * 64 + d] * (float)kr[d];
                const float mn = fmaxf(m, s_), al = exp2f(m - mn), pp = exp2f(s_ - mn); l = l * al + pp; o0 = o0 * al + pp * (float)kk[128 + dsel]; o1 = o1 * al + pp * (float)kk[128 + dsel + 32]; o2 = o2 * al + pp * (float)kk[128 + dsel + 64]; o3 = o3 * al + pp * (float)kk[128 + dsel + 96]; m = mn; }
        } else { const int head = (hb >> 21) % 12, g = head >> 2, dd = g == 0 ? 1 : g == 1 ? 4 : 16; const h16* q = (const h16*)(ws + A_DIL) + (size_t)t * 4608 + head * 128;
            for (int j = tid; j <= 128; j += 256) { const int kp = sp - dd * j; if (kp < 0) continue; const size_t tk = (size_t)b * SEQ + kp; const h16* kk = (const h16*)(ws + A_DIL) + tk * 4608 + 1536 + head * 128; const h16* vv = (const h16*)(ws + A_DIL) + tk * 4608 + 3072 + head * 128;
                float s_ = 0.f; for (int d = 0; d < 128; ++d) s_ += (float)q[d] * (float)kk[d];
                const float mn = fmaxf(m, s_), al = exp2f(m - mn), pp = exp2f(s_ - mn); l = l * al + pp; o0 = o0 * al + pp * (float)vv[dsel]; o1 = o1 * al + pp * (float)vv[dsel + 32]; o2 = o2 * al + pp * (float)vv[dsel + 64]; o3 = o3 * al + pp * (float)vv[dsel + 96]; m = mn; } }
        red[tid * 6 + 0] = m; red[tid * 6 + 1] = l; red[tid * 6 + 2] = o0; red[tid * 6 + 3] = o1; red[tid * 6 + 4] = o2; red[tid * 6 + 5] = o3; __syncthreads();
        if (tid == 0) { float M = -1e30f; for (int i = 0; i < 256; ++i) M = fmaxf(M, red[i * 6]); float L = 0.f, O0 = 0.f, O1 = 0.f, O2 = 0.f, O3 = 0.f;
            for (int i = 0; i < 256; ++i) { const float w = exp2f(red[i * 6] - M); L += red[i * 6 + 1] * w; O0 += red[i * 6 + 2] * w; O1 += red[i * 6 + 3] * w; O2 += red[i * 6 + 4] * w; O3 += red[i * 6 + 5] * w; }
            if (blockIdx.x < 96) { const int hd = (hb >> 21) & 7; const h16* og = (const h16*)(ws + A_OMLA) + (size_t)t * 1024 + hd * 128;
                dg_put(ctl, 4, (float)og[dsel], O0 / L, 0.02f); dg_put(ctl, 4, (float)og[dsel + 32], O1 / L, 0.02f); dg_put(ctl, 4, (float)og[dsel + 64], O2 / L, 0.02f); dg_put(ctl, 4, (float)og[dsel + 96], O3 / L, 0.02f); }
            else { const int head = (hb >> 21) % 12; const h16* og = (const h16*)(ws + A_OD) + (size_t)t * 1536 + head * 128;
                dg_put(ctl, 5, (float)og[dsel], O0 / L, 0.02f); dg_put(ctl, 5, (float)og[dsel + 32], O1 / L, 0.02f); dg_put(ctl, 5, (float)og[dsel + 64], O2 / L, 0.02f); dg_put(ctl, 5, (float)og[dsel + 96], O3 / L, 0.02f);
                dg_put(ctl, 5, ((const float*)(ws + WS_LSE))[(size_t)t * 12 + head], M + log2f(L), 0.5f); } }
    } else if (phase == 5) {
        if (gid < 2048) { const int t = h0 % NTOK, n = h1v % DM; const float want = dg_dot((const h16*)(ws + A_OMLA) + (size_t)t * 1024, a.w_mla_o, 1024, DM, n) * (float)((const h16*)(ws + A_GATE))[(size_t)t * 4096 + n];
            dg_put(ctl, 6, (float)((const h16*)(ws + A_M1))[(size_t)t * DM + n], want, 0.05f); }
        else if (gid < 4096) { const int t = h0 % NTOK, hs = h1v & 3, d = h2v & 127; const float* ls = (const float*)(ws + WS_LSE) + (size_t)t * 12; const h16* od = (const h16*)(ws + A_OD) + (size_t)t * 1536;
            const float mx = fmaxf(ls[hs], fmaxf(ls[4 + hs], ls[8 + hs])); const float w0 = exp2f(ls[hs] - mx), w1 = exp2f(ls[4 + hs] - mx), w2 = exp2f(ls[8 + hs] - mx);
            const float want = (w0 * (float)od[hs * 128 + d] + w1 * (float)od[512 + hs * 128 + d] + w2 * (float)od[1024 + hs * 128 + d]) / (w0 + w1 + w2);
            dg_put(ctl, 7, (float)((const h16*)(ws + A_ODIL))[(size_t)t * 512 + hs * 128 + d], want, 0.02f); }
    } else if (phase == 6) {
        if (gid < 2048) { const int t = h0 % NTOK, n = h1v % DM; const float want = (float)((const h16*)(ws + A_M1))[(size_t)t * DM + n] + dg_dot((const h16*)(ws + A_ODIL) + (size_t)t * 512, a.w_dil_o, 512, DM, n) * (float)((const h16*)(ws + A_GATE))[(size_t)t * 4096 + 2048 + n];
            dg_put(ctl, 8, (float)((const h16*)(ws + A_MRG))[(size_t)t * DM + n], want, 0.05f); }
    } else if (phase == 7) {
        if (gid < 2048) { const int t = h0 % NTOK, n = h1v % DM; const float want = dg_dot((const h16*)(ws + A_MRG) + (size_t)t * DM, a.w_out, DM, DM, n);
            dg_put(ctl, 9, (float)((const h16*)(ws + A_YAT))[(size_t)t * DM + n], want, 0.05f); }
    } else if (phase == 8) {
        if (gid < 1024) { const int t = h0 % NTOK, c = h1v % DM, b = t >> 12; const h16* y = (const h16*)(ws + A_YAT) + (size_t)t * DM; float ss = 0.f; for (int k = 0; k < DM; ++k) ss += (float)y[k] * (float)y[k];
            const float r1 = 1.f / sqrtf(ss / DM + EPS); float ss2 = 0.f, xc = 0.f;
            for (int k = 0; k < DM; ++k) { const float xm = a.x[(size_t)t * DM + k] + mod[b * 12288 + 4096 + k] * ((float)y[k] * r1 * a.attn_post_g[k]); ss2 += xm * xm; if (k == c) xc = xm; }
            const float r2 = 1.f / sqrtf(ss2 / DM + EPS);
            dg_put(ctl, 10, a.out[(size_t)t * DM + c], xc, 0.05f);
            dg_put(ctl, 10, (float)((const h16*)(ws + A_H2))[(size_t)t * DM + c], xc * r2 * a.ffn_pre_g[c] * (1.f + mod[b * 12288 + 4 * 2048 + c]) + mod[b * 12288 + 3 * 2048 + c], 0.05f); }
        if (blockIdx.x >= 8 && blockIdx.x < 72) {
            const unsigned hb = hsh(blockIdx.x * 2654435761u + 99u); const int t = hb % NTOK; const int tid = threadIdx.x;
            if (tid < 64) { const float lgt = dg_dot((const h16*)(ws + A_H2) + (size_t)t * DM, a.w_router, DM, 64, tid); const float sc = 1.f / (1.f + expf(-lgt)); sc64[tid] = sc; bs64[tid] = sc + a.router_bias[tid]; }
            __syncthreads();
            if (tid == 0) { unsigned gsel = 0u; float bad = 0.f;
                for (int r = 0; r < 4; ++r) { int best = -1; float bv = -1e30f; for (int g = 0; g < 8; ++g) { if (gsel >> g & 1u) continue; float m1 = -1e30f, m2 = -1e30f; for (int j = 0; j < 8; ++j) { const float v = bs64[g * 8 + j]; if (v > m1) { m2 = m1; m1 = v; } else if (v > m2) m2 = v; } if (m1 + m2 > bv) { bv = m1 + m2; best = g; } } gsel |= 1u << best; }
                unsigned long long esel = 0ull; float wsum = 0.f;
                for (int r = 0; r < 6; ++r) { int best = -1; float bv = -1e30f; for (int e = 0; e < 64; ++e) { if (!(gsel >> (e >> 3) & 1u) || (esel >> e & 1ull)) continue; if (bs64[e] > bv) { bv = bs64[e]; best = e; } } esel |= 1ull << best; wsum += sc64[best];
                    const unsigned pk = ((const unsigned*)(ws + WS_TOKPOS))[(size_t)t * 6 + r]; const int ge = pk >> 20, slot = pk & 0xFFFFF; if (ge != best) bad += 1.f; else if (((const unsigned*)(ws + WS_LIST))[(size_t)ge * LISTCAP + slot] != (unsigned)t) bad += 1.f; }
                for (int r = 0; r < 6; ++r) { const unsigned pk = ((const unsigned*)(ws + WS_TOKPOS))[(size_t)t * 6 + r]; const int ge = pk >> 20; const float w = ((const float*)(ws + WS_TOKW))[(size_t)t * 6 + r]; if (fabsf(w - sc64[ge] / (wsum + 1e-20f) * 2.5f) > 0.01f) bad += 1.f; }
                atomicAdd((float*)(ctl + CW_DIAG + 11), bad / (64.f * 12.f)); }
        }
        if (gid == 0) { unsigned tot = 0; for (int e = 0; e < 64; ++e) tot += ctl[CW_CNT + 64 * e]; dg_put(ctl, 10, (float)tot, (float)(NTOK * 6), 1.0f); }
    } else if (phase == 9 || phase == 10) {
        const unsigned* cnt = ctl + CW_CNT;
        if (gid < 2048) { const int t = h0 % NTOK, k = h1v % 7; int e, slot; if (k == 6) { e = 64; slot = t; } else { const unsigned pk = ((const unsigned*)(ws + WS_TOKPOS))[(size_t)t * 6 + k]; e = pk >> 20; slot = pk & 0xFFFFF; }
            const size_t prow = (size_t)dg_tstart(cnt, e) * 256 + slot;
            if (phase == 9) { const int n = h2v % 512; const float* wg = e < 64 ? a.w_exp_gate + (size_t)e * DM * 512 : a.w_sh_gate; const float* wu = e < 64 ? a.w_exp_up + (size_t)e * DM * 512 : a.w_sh_up;
                const h16* hr = (const h16*)(ws + A_H2) + (size_t)t * DM; const float g = dg_dot(hr, wg, DM, 512, n), u = dg_dot(hr, wu, DM, 512, n);
                dg_put(ctl, 12, (float)((const h16*)(ws + A_ACT))[prow * 512 + n], g / (1.f + expf(-g)) * u, 0.05f); }
            else { const int n = h2v % DM; const float* wd = e < 64 ? a.w_exp_down + (size_t)e * 512 * DM : a.w_sh_down;
                dg_put(ctl, 13, (float)((const h16*)(ws + A_YS))[prow * DM + n], dg_dot((const h16*)(ws + A_ACT) + prow * 512, wd, 512, DM, n), 0.05f); } }
    } else if (phase == 100) {
        const int si = blockIdx.x; if (si < 64) { const int t = hsh(si * 31337u + 5u) % NTOK; float* sv = (float*)(ws + WS_SAVE) + (size_t)si * DM; for (int c = threadIdx.x; c < DM; c += 256) sv[c] = a.out[(size_t)t * DM + c]; }
    } else if (phase == 11) {
        const int si = blockIdx.x; if (si < 64) { const int t = hsh(si * 31337u + 5u) % NTOK, b = t >> 12; const unsigned* cnt = ctl + CW_CNT; const float* sv = (const float*)(ws + WS_SAVE) + (size_t)si * DM; const int tid = threadIdx.x;
            float vals[8]; float ss = 0.f;
#pragma unroll
            for (int q = 0; q < 8; ++q) { const int c = tid + 256 * q; float s_ = (float)((const h16*)(ws + A_YS))[((size_t)dg_tstart(cnt, 64) * 256 + t) * DM + c];
                for (int k = 0; k < 6; ++k) { const unsigned pk = ((const unsigned*)(ws + WS_TOKPOS))[(size_t)t * 6 + k]; const int e = pk >> 20, slot = pk & 0xFFFFF;
                    s_ += ((const float*)(ws + WS_TOKW))[(size_t)t * 6 + k] * (float)((const h16*)(ws + A_YS))[((size_t)dg_tstart(cnt, e) * 256 + slot) * DM + c]; }
                vals[q] = s_; ss += s_ * s_; }
            red[tid] = ss; __syncthreads(); if (tid == 0) { float tot = 0.f; for (int i = 0; i < 256; ++i) tot += red[i]; red[256] = tot; } __syncthreads();
            const float rstd = 1.f / sqrtf(red[256] / DM + EPS);
#pragma unroll
            for (int q = 0; q < 8; ++q) { const int c = tid + 256 * q; dg_put(ctl, 14, a.out[(size_t)t * DM + c], sv[c] + mod[b * 12288 + 5 * 2048 + c] * (vals[q] * rstd * a.ffn_post_g[c]), 0.05f); } }
    }
}
__global__ void __launch_bounds__(256) diag_final(Args a) {
    unsigned* ctl = (unsigned*)(a.ws + WS_CTL); int code = 0;
    for (int sl = 14; sl >= 0; --sl) { const float e = __uint_as_float(ctl[CW_DIAG + sl]); const float thr = (sl == 11) ? 0.08f : 0.03f; if (!(e <= thr)) code = sl + 1; }
    if (code == 0) return;
    const float f = 1.0f + 0.5f * (float)code;
    for (size_t i = (size_t)blockIdx.x * 256 + threadIdx.x; i < (size_t)NTOK * DM; i += (size_t)gridDim.x * 256) a.out[i] = a.x[i] * f;
}
#endif

extern "C" void kernel_launch(void* const* d_in, const int* in_sizes, int n_in, void* d_out, int out_size, void* d_ws, size_t ws_size, hipStream_t stream) {
    static int grid = 0;
    if (grid == 0) {
        if (n_in != 25 || in_sizes[0] != NTOK * DM || out_size != NTOK * DM || ws_size < WS_END) {
            fprintf(stderr, "kernel_launch: unexpected shapes / workspace (n_in %d, ws %zu, need %zu); nothing launched\n", n_in, ws_size, (size_t)WS_END); grid = -1; return; }
        int dev = 0, cus = 0, per_cu = 0;
        if (hipGetDevice(&dev) != hipSuccess || hipDeviceGetAttribute(&cus, hipDeviceAttributeMultiprocessorCount, dev) != hipSuccess) { grid = -1; return; }
        if (hipFuncSetAttribute((const void*)mk_fwd, hipFuncAttributeMaxDynamicSharedMemorySize, LDS_BYTES) != hipSuccess) { fprintf(stderr, "kernel_launch: hipFuncSetAttribute failed\n"); grid = -1; return; }
        if (hipOccupancyMaxActiveBlocksPerMultiprocessor(&per_cu, (const void*)mk_fwd, NTHR, LDS_BYTES) != hipSuccess || per_cu < 1)
            fprintf(stderr, "kernel_launch: note: occupancy query reports %d workgroups per CU\n", per_cu);
        (void)hipGetLastError();
        grid = cus;
    }
    if (grid < 0) return;
    if (hipMemsetAsync((char*)d_ws + WS_CTL, 0, CTL_ZERO_BYTES, stream) != hipSuccess) return;
    Args a{};
    a.x = (const float*)d_in[0]; a.c = (const float*)d_in[1]; a.pos = (const int*)d_in[2]; a.w_ada = (const float*)d_in[3]; a.b_ada = (const float*)d_in[4];
    a.attn_pre_g = (const float*)d_in[5]; a.w_in = (const float*)d_in[6]; a.q_a_norm_g = (const float*)d_in[7]; a.w_q_up = (const float*)d_in[8];
    a.kv_a_norm_g = (const float*)d_in[9]; a.w_kv_up = (const float*)d_in[10]; a.w_mla_o = (const float*)d_in[11]; a.w_dil_o = (const float*)d_in[12];
    a.w_out = (const float*)d_in[13]; a.attn_post_g = (const float*)d_in[14]; a.ffn_pre_g = (const float*)d_in[15]; a.w_router = (const float*)d_in[16];
    a.router_bias = (const float*)d_in[17]; a.w_exp_gate = (const float*)d_in[18]; a.w_exp_up = (const float*)d_in[19]; a.w_exp_down = (const float*)d_in[20];
    a.w_sh_gate = (const float*)d_in[21]; a.w_sh_up = (const float*)d_in[22]; a.w_sh_down = (const float*)d_in[23]; a.ffn_post_g = (const float*)d_in[24];
    a.out = (float*)d_out; a.ws = (unsigned char*)d_ws;
    for (int i = 0; i < 16; ++i) a.invf_d[i] = 1.0f / powf(500000.0f, (float)(2 * i) / 32.0f);
    for (int i = 0; i < 32; ++i) a.invf_m[i] = 1.0f / powf(500000.0f, (float)(2 * i) / 64.0f);
#if MK_LAUNCHES == 1
    a.ph_lo = 0; a.ph_hi = NPHASE;
    hipLaunchKernelGGL(mk_fwd, dim3(grid), dim3(NTHR), LDS_BYTES, stream, a);
#else
#ifndef MK_STOP
#define MK_STOP NPHASE
#endif
    for (int p = 0; p < MK_STOP; ++p) { a.ph_lo = p; a.ph_hi = p + 1;
#if MK_DIAG
        if (p == 11) hipLaunchKernelGGL(diag_check, dim3(256), dim3(256), 0, stream, a, 100);
#endif
        hipLaunchKernelGGL(mk_fwd, dim3(grid), dim3(NTHR), LDS_BYTES, stream, a);
#if MK_DIAG
        hipLaunchKernelGGL(diag_check, dim3(256), dim3(256), 0, stream, a, p);
#endif
    }
#if MK_DIAG
    hipLaunchKernelGGL(diag_final, dim3(1024), dim3(256), 0, stream, a);
#endif
#endif
}
```

```cpp
#include <hip/hip_runtime.h>
#include <cstdio>
#include <cstdint>
#include <cmath>

#ifndef MK_LAUNCHES
#define MK_LAUNCHES 1
#endif
#ifndef MK_DIAG
#define MK_DIAG 0
#endif

#define GAS __attribute__((address_space(1)))
#define LAS __attribute__((address_space(3)))
typedef _Float16 h16;
typedef _Float16 h16x8 __attribute__((ext_vector_type(8)));
typedef _Float16 h16x4 __attribute__((ext_vector_type(4)));
typedef _Float16 h16x2 __attribute__((ext_vector_type(2)));
typedef short s16x4 __attribute__((ext_vector_type(4)));
typedef float f32x4 __attribute__((ext_vector_type(4)));
typedef float f32x2 __attribute__((ext_vector_type(2)));
typedef float f32x16 __attribute__((ext_vector_type(16)));
typedef unsigned u32x4 __attribute__((ext_vector_type(4)));
typedef unsigned u32x2 __attribute__((ext_vector_type(2)));
typedef int i32x8 __attribute__((ext_vector_type(8)));
typedef int i32x4 __attribute__((ext_vector_type(4)));

constexpr int NB = 4, SEQ = 4096, NTOK = NB * SEQ, DM = 2048;
constexpr int NPROJ = 9984;
constexpr int NEXP = 64, TOPK = 6, EDIM = 512;
constexpr int LISTCAP = 16384;
constexpr int MAXTILES = 512;
constexpr float EPS = 1e-6f;
constexpr float LOG2E = 1.4426950408889634f;
constexpr float QS_M = 0.07216878364870322f * LOG2E;
constexpr float QS_D = 0.08838834764831845f * LOG2E;
constexpr float SC_GU = 64.0f, SC_DN = 64.0f;

constexpr size_t MiB = 1u << 20;
constexpr size_t WS_CTL = 0, CTL_ZERO_BYTES = 1 * MiB;
constexpr size_t WS_ROWSQ = 1 * MiB;
constexpr size_t WS_MOD = 2 * MiB;
constexpr size_t WS_GPA = WS_MOD + 256 * 1024, WS_GS = WS_MOD + 320 * 1024, WS_GPF = WS_MOD + 384 * 1024;
constexpr size_t WS_COSD = 3 * MiB, WS_SIND = 4 * MiB;
constexpr size_t WS_COSM = 5 * MiB, WS_SINM = 7 * MiB;
constexpr size_t WS_LSE = 9 * MiB;
constexpr size_t WS_TOKPOS = 10 * MiB;
constexpr size_t WS_TOKW = 10 * MiB + 512 * 1024;
constexpr size_t WS_LIST = 11 * MiB;
constexpr size_t WS_W = 16 * MiB;
constexpr size_t W_IN = WS_W;
constexpr size_t W_QUP = W_IN + 39 * MiB;
constexpr size_t W_KVUP = W_QUP + 3 * MiB / 2;
constexpr size_t W_MO = W_KVUP + 2 * MiB;
constexpr size_t W_DO = W_MO + 4 * MiB;
constexpr size_t W_OUT = W_DO + 2 * MiB;
constexpr size_t W_R = W_OUT + 8 * MiB;
constexpr size_t W_GU = W_R + MiB / 4;
constexpr size_t W_DN = W_GU + 260 * MiB;
constexpr size_t WS_AR = W_DN + 130 * MiB;
static_assert(WS_AR == (16 + 447) * MiB - MiB / 4, "weights");
constexpr size_t AR = ((WS_AR + MiB - 1) / MiB) * MiB;
constexpr size_t A_YS = AR + 0 * MiB;
constexpr size_t A_ACT = AR + 512 * MiB;
constexpr size_t A_H2 = AR + 0 * MiB;
constexpr size_t A_YAT = AR + 64 * MiB;
constexpr size_t A_MRG = AR + 128 * MiB;
constexpr size_t A_GATE = AR + 192 * MiB;
constexpr size_t A_M1 = AR + 320 * MiB;
constexpr size_t A_XMID = AR + 320 * MiB;
constexpr size_t A_CAT = AR + 384 * MiB;
constexpr size_t A_ODIL = A_CAT, A_OMLA = A_CAT;
constexpr size_t A_OD = AR + 432 * MiB;
constexpr size_t A_DIL = AR + 0 * MiB;
constexpr size_t A_QM = AR + 144 * MiB;
constexpr size_t A_KV = AR + 480 * MiB;
constexpr size_t A_KR = AR + 544 * MiB;
constexpr size_t A_QA = AR + 546 * MiB;
constexpr size_t A_H1 = AR + 480 * MiB;
constexpr size_t WS_END = AR + 640 * MiB;

constexpr int CW_BAR = 0;
constexpr int CW_CNT = 16384;
constexpr int CW_DIAG = 32768;

constexpr int LDS_BYTES = 147456;
constexpr int LDS_TAB = 131072;
constexpr int LDS_MISC = LDS_BYTES - 64;
constexpr int NWAVES = 8, NTHR = 512;

#define LDS_WAIT() asm volatile("s_waitcnt lgkmcnt(0)" ::: "memory")
#define VM_WAIT() asm volatile("s_waitcnt vmcnt(0)" ::: "memory")

__device__ __forceinline__ unsigned pkh(float a, float b) { h16x2 r; r.x = (h16)a; r.y = (h16)b; return __builtin_bit_cast(unsigned, r); }
__device__ __forceinline__ u32x4 pk8(f32x4 a, f32x4 b) { u32x4 w; w.x = pkh(a[0], a[1]); w.y = pkh(a[2], a[3]); w.z = pkh(b[0], b[1]); w.w = pkh(b[2], b[3]); return w; }
__device__ __forceinline__ unsigned pk4_fp8(float a, float b, float c, float d) { int w = 0; w = __builtin_amdgcn_cvt_pk_fp8_f32(a, b, w, false); w = __builtin_amdgcn_cvt_pk_fp8_f32(c, d, w, true); return (unsigned)w; }
__device__ __forceinline__ float wave_sum(float v) {
#pragma unroll
    for (int o = 1; o < 64; o <<= 1) v += __shfl_xor(v, o);
    return v;
}
__device__ __forceinline__ float sigmoidf_(float x) { return __builtin_amdgcn_rcpf(1.0f + __builtin_amdgcn_exp2f(x * -1.4426950408889634f)); }

#define XB_TMO      128
#define XB_XCNT(j)  (256  + 64 * (j))
#define XB_XSUB(j)  (1280 + 64 * (j))
#define XB_XGEN(j)  (2304 + 64 * (j))
#define XB_TOP      3328
#define XB_TOPGEN   3392
#define XCD_BAR_WORDS 3456
#define XB_SPIN_CAP (1u << 18)
__device__ __forceinline__ unsigned xb_ld(unsigned* p)              { return __hip_atomic_load(p, __ATOMIC_RELAXED, __HIP_MEMORY_SCOPE_AGENT); }
__device__ __forceinline__ unsigned xb_add(unsigned* p, unsigned v) { return __hip_atomic_fetch_add(p, v, __ATOMIC_RELAXED, __HIP_MEMORY_SCOPE_AGENT); }
__device__ __forceinline__ unsigned xb_xcc_id() { return (unsigned)__builtin_amdgcn_s_getreg((3 << 11) | 20) & 0xFu; }
#define XB_SPIN(cond, bar) do { unsigned _sp = 0; while (cond) { __builtin_amdgcn_s_sleep(1); \
    if ((++_sp & 255u) == 0u) { if (xb_ld(&(bar)[XB_TMO])) break; if (_sp > XB_SPIN_CAP) { atomicAdd(&(bar)[XB_TMO], 1u); break; } } } } while (0)
struct XcdBarrier { unsigned* bar; unsigned x; volatile LAS unsigned* st; };
__device__ __forceinline__ XcdBarrier xcd_barrier_post(unsigned* bar, volatile LAS unsigned* st) {
    XcdBarrier b; b.bar = bar; b.x = xb_xcc_id(); b.st = st;
    if (threadIdx.x == 0) (void)xb_add(&bar[XB_XCNT(b.x)], 1u);
    return b;
}
__device__ __forceinline__ void xcd_barrier_complete(unsigned* bar, unsigned x, unsigned& nloc, unsigned& nx) {
    const unsigned G = gridDim.x * gridDim.y * gridDim.z;
    unsigned sum, cnt, mine, sp = 0u;
    for (;;) {
        sum = 0u; cnt = 0u; mine = 0u;
#pragma unroll
        for (unsigned j = 0; j < 16; ++j) { const unsigned c = xb_ld(&bar[XB_XCNT(j)]); sum += c; cnt += (c > 0u) ? 1u : 0u; mine = (j == x) ? c : mine; }
        if (sum == G) break;
        __builtin_amdgcn_s_sleep(1);
        if ((++sp & 255u) == 0u) { if (xb_ld(&bar[XB_TMO])) break; if (sp > XB_SPIN_CAP) { atomicAdd(&bar[XB_TMO], 1u); break; } }
    }
    nloc = mine > 0u ? mine : 1u; nx = cnt > 0u ? cnt : 1u;
}
__device__ __forceinline__ void xcd_barrier(const XcdBarrier& b) {
    asm volatile("s_waitcnt vmcnt(0)" ::: "memory");
    __syncthreads();
    if (threadIdx.x == 0) {
        unsigned* bar = b.bar;
        __builtin_amdgcn_s_waitcnt(0);
        unsigned nloc = b.st[0], nx = b.st[1];
        if (nloc == 0u) { xcd_barrier_complete(bar, b.x, nloc, nx); b.st[0] = nloc; b.st[1] = nx; }
        const unsigned old = xb_add(&bar[XB_XSUB(b.x)], 1u);
        const unsigned gen = old / nloc;
        if (old + 1u == (gen + 1u) * nloc) {
            __builtin_amdgcn_fence(__ATOMIC_RELEASE, "agent");
            asm volatile("s_waitcnt vmcnt(0)" ::: "memory");
            const unsigned og = xb_add(&bar[XB_TOP], 1u);
            const unsigned tg = og / nx;
            if (og + 1u == (tg + 1u) * nx) xb_add(&bar[XB_TOPGEN], 1u);
            else XB_SPIN(xb_ld(&bar[XB_TOPGEN]) == tg, bar);
            __builtin_amdgcn_fence(__ATOMIC_ACQUIRE, "agent");
            xb_add(&bar[XB_XGEN(b.x)], 1u);
            asm volatile("s_waitcnt vmcnt(0)" ::: "memory");
        } else {
            XB_SPIN(xb_ld(&bar[XB_XGEN(b.x)]) == gen, bar);
            __builtin_amdgcn_fence(__ATOMIC_ACQUIRE, "agent");
            asm volatile("s_waitcnt vmcnt(0)" ::: "memory");
        }
    }
    __syncthreads();
}

struct Args {
    const float* x; const float* c; const int* pos; const float* w_ada; const float* b_ada; const float* attn_pre_g; const float* w_in;
    const float* q_a_norm_g; const float* w_q_up; const float* kv_a_norm_g; const float* w_kv_up; const float* w_mla_o; const float* w_dil_o;
    const float* w_out; const float* attn_post_g; const float* ffn_pre_g; const float* w_router; const float* router_bias;
    const float* w_exp_gate; const float* w_exp_up; const float* w_exp_down; const float* w_sh_gate; const float* w_sh_up; const float* w_sh_down;
    const float* ffn_post_g;
    float* out; unsigned char* ws;
    float invf_d[16]; float invf_m[32];
    int ph_lo, ph_hi;
};

struct Frame {
    LAS unsigned char* lds;
    int tid, lane, wave, vcu, G;
    unsigned char* ws;
};
template <class T> __device__ __forceinline__ T* wsp(const Frame& F, size_t off) { return (T*)(F.ws + off); }

namespace pg8 {
constexpr int BM = 256, BK = 64, HALF = 128, HTB = HALF * BK * 2, STAGE_BYTES = 8 * HTB;
__device__ __forceinline__ int lds_byte(int r, int c) { const int st = (r >> 4) * 2 + (c >> 5), rr = r & 15, cc = c & 31, ob = rr * 64 + cc * 2; return st * 1024 + (ob ^ (((ob >> 9) & 1) << 5)); }
__device__ __forceinline__ void stage_rc(int b, int& R, int& C) { const int st = b / 1024, sb = b % 1024, swz = sb ^ (((sb >> 9) & 1) << 5); R = (st >> 1) * 16 + swz / 64; C = (st & 1) * 32 + (swz % 64) / 2; }
__device__ __forceinline__ int perm32(int rho) { const int n = rho >> 4, i = rho & 15; return 8 * (i >> 2) + 4 * n + (i & 3); }

struct Unit { const char* A; const char* B; int pm, pn, e, slot0, cnt, tag; };
typedef f32x4 Acc[2][2][4][2];

template <bool FP8> struct Frag;
template <> struct Frag<false> { h16x8 h[2]; };
template <> struct Frag<true> { i32x8 f8; };
template <class Epi, class Sched, bool GATHER, bool FP8 = false>
__device__ __forceinline__ void gemm_phase(LAS unsigned char* lds, const int K, const int lda, const Sched& S, const Epi& E) {
    const int tid = threadIdx.x, wid = __builtin_amdgcn_readfirstlane(tid >> 6), lane = tid & 63, wr = wid >> 2, wc = wid & 3, fr = lane & 15, fq = lane >> 4;
    int nt = K / BK; asm volatile("" : "+s"(nt));
    int sc1 = 0x7C7C7C7C; asm volatile("" : "+v"(sc1));
    int sR[2], sC[2];
    unsigned voffB[2], va[2][2], vn[2][2];
#pragma unroll
    for (int i = 0; i < 2; ++i) { int R, C; stage_rc(tid * 16 + i * 8192, R, C); sR[i] = R; sC[i] = C; const int Rb = (R & ~31) + perm32(R & 31);
        voffB[i] = (unsigned)(Rb * K + C) * 2u;
        if constexpr (Epi::PERM16) {
            const int wc_ = R >> 5, rho = R & 31, n_ = rho >> 4, fq_ = (rho & 15) >> 2, j_ = rho & 3;
            voffB[i] = (unsigned)((64 * wc_ + 16 * fq_ + 4 * n_ + j_) * K + C) * 2u; }
        va[0][i] = (unsigned)(R * lda + C) * 2u; va[1][i] = (unsigned)((R + HALF) * lda + C) * 2u; vn[0][i] = va[0][i]; vn[1][i] = va[1][i]; }
    const size_t kstep = (size_t)(BK * 2);
    const size_t hstepB = Epi::PERM16 ? (size_t)8 * K * 2 : (size_t)HALF * K * 2;
    const unsigned ldsw = (unsigned)wid * 1024u;
    const int aoff = lds_byte(wr * 64 + fr, fq * 8), boff = lds_byte(wc * 32 + fr, fq * 8);
#define PG8_SA(b, h) (((b) * 2 + (h)) * HTB)
#define PG8_SB(b, h) ((4 + (b) * 2 + (h)) * HTB)
#define PG8_STAGE(bufoff, gbase, voff) do { _Pragma("unroll") for (int _i = 0; _i < 2; ++_i) \
        __builtin_amdgcn_global_load_lds((const unsigned*)((const char*)(gbase) + (voff)[_i]), (LAS unsigned*)(lds + (bufoff) + ldsw + _i * 8192), 16, 0, 0); } while (0)
#define PG8_LD1(dst, addr) do { if constexpr (FP8) { const i32x4 lo_ = *(const LAS i32x4*)(addr), hi_ = *(const LAS i32x4*)((addr) + 1024); dst.f8 = __builtin_shufflevector(lo_, hi_, 0, 1, 2, 3, 4, 5, 6, 7); } \
        else { dst.h[0] = *(const LAS h16x8*)(addr); dst.h[1] = *(const LAS h16x8*)((addr) + 1024); } } while (0)
#define PG8_LDA(dst, b, h) do { _Pragma("unroll") for (int m = 0; m < 4; ++m) PG8_LD1(dst[m], lds + PG8_SA(b, h) + aoff + m * 2048); } while (0)
#define PG8_LDB(dst, b, h) do { _Pragma("unroll") for (int n = 0; n < 2; ++n) PG8_LD1(dst[n], lds + PG8_SB(b, h) + boff + n * 2048); } while (0)
#define PG8_MMA(ai, bj, At, Bt) do { __builtin_amdgcn_s_setprio(1); _Pragma("unroll") for (int m = 0; m < 4; ++m) _Pragma("unroll") for (int n = 0; n < 2; ++n) { \
        if constexpr (FP8) asm volatile("v_mfma_scale_f32_16x16x128_f8f6f4 %0, %1, %2, %0, %3, %3 op_sel_hi:[0,0,0]" : "+v"(acc[ai][bj][m][n]) : "v"(Bt[n].f8), "v"(At[m].f8), "v"(sc1)); \
        else { _Pragma("unroll") for (int k = 0; k < 2; ++k) acc[ai][bj][m][n] = __builtin_amdgcn_mfma_f32_16x16x32_f16(Bt[n].h[k], At[m].h[k], acc[ai][bj][m][n], 0, 0, 0); } } \
        __builtin_amdgcn_s_setprio(0); } while (0)
#define PG8_WAIT_V(n) asm volatile("s_waitcnt vmcnt(" #n ")" ::: "memory")
#define PG8_WAIT_L(n) asm volatile("s_waitcnt lgkmcnt(" #n ")" ::: "memory")
#define PG8_BAR __builtin_amdgcn_s_barrier()
#define PG8_SCHED __builtin_amdgcn_sched_barrier(0)
    Unit cur, nxt; int ui = 0; bool prev_ok = false;
    if (!S.next(0, cur)) return;
    Acc acc;
#pragma unroll
    for (int a = 0; a < 2; ++a)
#pragma unroll
        for (int b = 0; b < 2; ++b)
#pragma unroll
            for (int m = 0; m < 4; ++m)
#pragma unroll
                for (int n = 0; n < 2; ++n) acc[a][b][m][n] = (f32x4){0.f, 0.f, 0.f, 0.f};
    Frag<FP8> At[4], B0[2], B1[2];
    const char* cA = cur.A; const char* cB = cur.B;
    if constexpr (GATHER) {
#pragma unroll
        for (int h = 0; h < 2; ++h)
#pragma unroll
            for (int i = 0; i < 2; ++i) va[h][i] = S.vraw(cur, h * HALF + sR[i]);
        __builtin_amdgcn_sched_barrier(0);
#pragma unroll
        for (int h = 0; h < 2; ++h)
#pragma unroll
            for (int i = 0; i < 2; ++i) va[h][i] = S.vfin(cur, h * HALF + sR[i], sC[i], va[h][i]);
    }
    PG8_STAGE(PG8_SB(0, 0), cB, voffB); PG8_STAGE(PG8_SB(0, 1), cB + hstepB, voffB); PG8_STAGE(PG8_SA(0, 0), cA, va[0]); PG8_STAGE(PG8_SA(0, 1), cA, va[1]);
    if (wr == 1) PG8_BAR;
    PG8_WAIT_V(2); PG8_BAR;
    PG8_STAGE(PG8_SB(1, 0), cB + kstep, voffB); PG8_STAGE(PG8_SA(1, 0), cA + kstep, va[0]); PG8_STAGE(PG8_SB(1, 1), cB + hstepB + kstep, voffB);
    PG8_WAIT_V(6); PG8_BAR;
    for (;;) {
        const bool has_next = S.next(ui + 1, nxt);
        const char* nA = has_next ? nxt.A : cA; const char* nB = has_next ? nxt.B : cB;
        if constexpr (GATHER) {
            if (has_next) {
#pragma unroll
                for (int h = 0; h < 2; ++h)
#pragma unroll
                    for (int i = 0; i < 2; ++i) vn[h][i] = S.vraw(nxt, h * HALF + sR[i]);
                __builtin_amdgcn_sched_barrier(0);
#pragma unroll
                for (int h = 0; h < 2; ++h)
#pragma unroll
                    for (int i = 0; i < 2; ++i) vn[h][i] = S.vfin(nxt, h * HALF + sR[i], sC[i], vn[h][i]);
            } else {
#pragma unroll
                for (int h = 0; h < 2; ++h)
#pragma unroll
                    for (int i = 0; i < 2; ++i) vn[h][i] = va[h][i];
            }
        }
        for (int t = 0; t < nt; t += 2) {
            const bool last = (t == nt - 2);
            if constexpr (Epi::MID_T >= 0) { if (t == Epi::MID_T) E.mid(acc, cur, wr, wc, fr, fq); }
            const char* a1 = cA + (size_t)(t + 1) * kstep;
            const char* a2 = last ? nA : cA + (size_t)(t + 2) * kstep; const char* b2 = last ? nB : cB + (size_t)(t + 2) * kstep;
            const char* a3 = a2 + kstep; const char* b3 = b2 + kstep;
            unsigned v2[2][2];
#pragma unroll
            for (int h = 0; h < 2; ++h)
#pragma unroll
                for (int i = 0; i < 2; ++i) v2[h][i] = (GATHER && last) ? vn[h][i] : va[h][i];
            const bool relax = (Epi::NST > 0) && (t == 0) && (ui > 0) && prev_ok;
            PG8_LDB(B0, 0, 0); PG8_LDB(B1, 0, 1); PG8_SCHED; PG8_LDA(At, 0, 0); PG8_STAGE(PG8_SA(1, 1), a1, va[1]);
            if (relax) { if constexpr (Epi::NST == 16) PG8_WAIT_V(24); else PG8_WAIT_V(16); } else PG8_WAIT_V(8);
            PG8_WAIT_L(0); PG8_BAR; PG8_MMA(0, 0, At, B0); PG8_MMA(0, 1, At, B1); PG8_BAR; PG8_SCHED;
            PG8_LDA(At, 0, 1); PG8_STAGE(PG8_SB(0, 0), b2, voffB); PG8_STAGE(PG8_SB(0, 1), b2 + hstepB, voffB); PG8_STAGE(PG8_SA(0, 0), a2, v2[0]);
            if (relax) { if constexpr (Epi::NST == 16) PG8_WAIT_V(24); else PG8_WAIT_V(16); } else PG8_WAIT_V(8);
            PG8_WAIT_L(0); PG8_BAR; PG8_MMA(1, 0, At, B0); PG8_MMA(1, 1, At, B1); PG8_BAR; PG8_SCHED;
            PG8_LDB(B0, 1, 0); PG8_LDB(B1, 1, 1); PG8_SCHED; PG8_LDA(At, 1, 0); PG8_STAGE(PG8_SA(0, 1), a2, v2[1]);
            PG8_WAIT_V(8); PG8_WAIT_L(0); PG8_BAR; PG8_MMA(0, 0, At, B0); PG8_MMA(0, 1, At, B1); PG8_BAR; PG8_SCHED;
            PG8_LDA(At, 1, 1); PG8_STAGE(PG8_SB(1, 0), b3, voffB); PG8_STAGE(PG8_SB(1, 1), b3 + hstepB, voffB); PG8_STAGE(PG8_SA(1, 0), a3, v2[0]);
            PG8_WAIT_V(8); PG8_WAIT_L(0); PG8_BAR; PG8_MMA(1, 0, At, B0); PG8_MMA(1, 1, At, B1); PG8_BAR; PG8_SCHED;
        }
        if (wr == 0) PG8_BAR;
        if constexpr (FP8) asm volatile("s_nop 15\n\ts_nop 15\n\ts_nop 15" ::: "memory");
        E(acc, cur, wr, wc, fr, fq);
        if (!has_next) break;
#pragma unroll
        for (int a = 0; a < 2; ++a)
#pragma unroll
            for (int b = 0; b < 2; ++b)
#pragma unroll
                for (int m = 0; m < 4; ++m)
#pragma unroll
                    for (int n = 0; n < 2; ++n) acc[a][b][m][n] = (f32x4){0.f, 0.f, 0.f, 0.f};
        prev_ok = Epi::nst_ok(cur); cur = nxt; cA = nA; cB = nB; ++ui;
        if constexpr (GATHER) {
#pragma unroll
            for (int h = 0; h < 2; ++h)
#pragma unroll
                for (int i = 0; i < 2; ++i) va[h][i] = vn[h][i];
        }
        if (wr == 1) PG8_BAR;
    }
    PG8_WAIT_V(0);
    PG8_BAR;
#undef PG8_SA
#undef PG8_SB
#undef PG8_STAGE
#undef PG8_LDA
#undef PG8_LDB
#undef PG8_MMA
#undef PG8_LD1
#undef PG8_WAIT_V
#undef PG8_WAIT_L
#undef PG8_BAR
#undef PG8_SCHED
}

struct StaticOrder {
    const char* A; const char* B; size_t a_tile, b_tile;
    int nM, nN, nwg, G, c;
    __device__ __forceinline__ void init(const void* A_, int lda, const void* B_, int K, int N, int G_, int c_) {
        A = (const char*)A_; B = (const char*)B_; a_tile = (size_t)256 * lda * 2; b_tile = (size_t)256 * K * 2; nM = NTOK / BM; nN = N / BM; nwg = nM * nN; G = G_; c = c_; }
    __device__ __forceinline__ bool next(int i, Unit& u) const {
        const long L = (long)i * G + c; if (L >= nwg) return false;
        int wgid = (int)L; { const int q = nwg / 8, r = nwg % 8, xcd = wgid % 8, off = wgid / 8; wgid = (xcd < r ? xcd * (q + 1) : r * (q + 1) + (xcd - r) * q) + off; }
        const int nig = 8 * nN, gid = wgid / nig, fm = gid * 8, gsz = (nM - fm) < 8 ? (nM - fm) : 8;
        u.pm = fm + ((wgid % nig) % gsz); u.pn = (wgid % nig) / gsz; u.e = 0; u.slot0 = 0; u.cnt = 0; u.tag = 0;
        u.A = A + (size_t)u.pm * a_tile; u.B = B + (size_t)u.pn * b_tile; return true;
    }
    __device__ __forceinline__ unsigned voff(const Unit&, int, int) const { return 0u; }
    __device__ __forceinline__ unsigned vraw(const Unit&, int) const { return 0u; }
    __device__ __forceinline__ unsigned vfin(const Unit&, int, int, unsigned) const { return 0u; }
};
}
using pg8::Unit; using pg8::Acc;

#define ACC8(acc, ai, bj, m, v0, v1) const f32x4 v0 = acc[ai][bj][m][0], v1 = acc[ai][bj][m][1]
#define EPI_ROWS(u, wr, fr) const int row0 = (u).pm * 256 + (wr) * 64 + (fr)
__device__ __forceinline__ void rope8(f32x4& v0, f32x4& v1, const f32x4 cs, const f32x4 sn) {
    const float a0 = v0[0] * cs[0] - v0[1] * sn[0], b0 = v0[1] * cs[0] + v0[0] * sn[0];
    const float a1 = v0[2] * cs[1] - v0[3] * sn[1], b1 = v0[3] * cs[1] + v0[2] * sn[1];
    const float a2 = v1[0] * cs[2] - v1[1] * sn[2], b2 = v1[1] * cs[2] + v1[0] * sn[2];
    const float a3 = v1[2] * cs[3] - v1[3] * sn[3], b3 = v1[3] * cs[3] + v1[2] * sn[3];
    v0 = (f32x4){a0, b0, a1, b1}; v1 = (f32x4){a2, b2, a3, b3};
}
struct EpiIn {
    static constexpr bool PERM16 = false; static constexpr int MID_T = -1, NST = 16;
    __device__ static __forceinline__ bool nst_ok(const Unit& u) { return u.pn != 4; }
    h16* qa; h16* krope; h16* dil; h16* gates; float* rowsq; const float* cosd; const float* sind; const float* cosm; const float* sinm;
    __device__ __forceinline__ void operator()(const Acc& acc, const Unit& u, int wr, int wc, int fr, int fq) const {
        asm volatile("" : "+v"(fr), "+v"(fq));
        EPI_ROWS(u, wr, fr); const int pn = u.pn, colin = wc * 32 + 8 * fq;
        constexpr float WS_ = 1.0f;
        if (pn < 4) {
#pragma unroll
            for (int ai = 0; ai < 2; ++ai)
#pragma unroll
                for (int m = 0; m < 4; ++m) { const int row = row0 + ai * 128 + m * 16; float ss = 0.f;
#pragma unroll
                    for (int bj = 0; bj < 2; ++bj) { const f32x4 v0 = acc[ai][bj][m][0] * WS_, v1 = acc[ai][bj][m][1] * WS_;
                        ss += (v0[0] * v0[0] + v0[1] * v0[1]) + (v0[2] * v0[2] + v0[3] * v0[3]) + (v1[0] * v1[0] + v1[1] * v1[1]) + (v1[2] * v1[2] + v1[3] * v1[3]);
                        *(u32x4*)(qa + (size_t)row * 1024 + pn * 256 + bj * 128 + colin) = pk8(v0, v1); }
                    ss += __shfl_xor(ss, 16); ss += __shfl_xor(ss, 32);
                    if (fq == 0) rowsq[(size_t)row * 16 + pn * 4 + wc] = ss; }
        } else if (pn == 4) {
            if (wc < 2) {
                u32x4 pk[2][4];
#pragma unroll
                for (int ai = 0; ai < 2; ++ai) {
                    f32x4 cs[4], sn[4];
#pragma unroll
                    for (int m = 0; m < 4; ++m) { const int row = row0 + ai * 128 + m * 16;
                        cs[m] = *(const f32x4*)(cosm + (size_t)row * 32 + 16 * wc + 4 * fq); sn[m] = *(const f32x4*)(sinm + (size_t)row * 32 + 16 * wc + 4 * fq); }
                    __builtin_amdgcn_sched_barrier(0);
#pragma unroll
                    for (int m = 0; m < 4; ++m) { f32x4 v0 = acc[ai][0][m][0] * WS_, v1 = acc[ai][0][m][1] * WS_; rope8(v0, v1, cs[m], sn[m]); pk[ai][m] = pk8(v0, v1); }
                    __builtin_amdgcn_sched_barrier(0);
                }
#pragma unroll
                for (int ai = 0; ai < 2; ++ai)
#pragma unroll
                    for (int m = 0; m < 4; ++m) { const int row = row0 + ai * 128 + m * 16; *(u32x4*)(krope + (size_t)row * 64 + colin) = pk[ai][m]; }
            }
        } else if (pn < 23) {
            const int part = (pn - 5) / 6; const bool rope = (part < 2 && wc == 0);
            const float sc_ = (part == 0) ? WS_ * QS_D : WS_;
            if (rope) {
                u32x4 pk[2][4][2];
#pragma unroll
                for (int ai = 0; ai < 2; ++ai) {
                    f32x4 cs[4], sn[4];
#pragma unroll
                    for (int m = 0; m < 4; ++m) { const int row = row0 + ai * 128 + m * 16;
                        cs[m] = *(const f32x4*)(cosd + (size_t)row * 16 + 4 * fq); sn[m] = *(const f32x4*)(sind + (size_t)row * 16 + 4 * fq); }
                    __builtin_amdgcn_sched_barrier(0);
#pragma unroll
                    for (int m = 0; m < 4; ++m)
#pragma unroll
                        for (int bj = 0; bj < 2; ++bj) { f32x4 v0 = acc[ai][bj][m][0] * sc_, v1 = acc[ai][bj][m][1] * sc_; rope8(v0, v1, cs[m], sn[m]); pk[ai][m][bj] = pk8(v0, v1); }
                    __builtin_amdgcn_sched_barrier(0);
                }
                __builtin_amdgcn_sched_barrier(0);
                int row0s = row0; asm volatile("" : "+v"(row0s));
#pragma unroll
                for (int ai = 0; ai < 2; ++ai)
#pragma unroll
                    for (int m = 0; m < 4; ++m) { const int row = row0s + ai * 128 + m * 16;
#pragma unroll
                        for (int bj = 0; bj < 2; ++bj) *(u32x4*)(dil + (size_t)row * 4608 + (pn - 5) * 256 + bj * 128 + colin) = pk[ai][m][bj]; }
            } else {
#pragma unroll
                for (int ai = 0; ai < 2; ++ai)
#pragma unroll
                    for (int m = 0; m < 4; ++m) { const int row = row0 + ai * 128 + m * 16;
#pragma unroll
                        for (int bj = 0; bj < 2; ++bj)
                            *(u32x4*)(dil + (size_t)row * 4608 + (pn - 5) * 256 + bj * 128 + colin) = pk8(acc[ai][bj][m][0] * sc_, acc[ai][bj][m][1] * sc_); }
            }
        } else {
#pragma unroll
            for (int ai = 0; ai < 2; ++ai)
#pragma unroll
                for (int m = 0; m < 4; ++m) { const int row = row0 + ai * 128 + m * 16;
                    u32x4 wr_, wb_; constexpr float NL2E = -WS_ * 1.4426950408889634f;
#pragma unroll
                    for (int n = 0; n < 2; ++n)
#pragma unroll
                        for (int jj = 0; jj < 2; ++jj) {
                            const float ea0 = __builtin_amdgcn_exp2f(acc[ai][0][m][n][2 * jj] * NL2E), ea1 = __builtin_amdgcn_exp2f(acc[ai][0][m][n][2 * jj + 1] * NL2E);
                            const float eb0 = 1.f + __builtin_amdgcn_exp2f(acc[ai][1][m][n][2 * jj] * NL2E), eb1 = 1.f + __builtin_amdgcn_exp2f(acc[ai][1][m][n][2 * jj + 1] * NL2E);
                            wb_[2 * n + jj] = pkh(__builtin_amdgcn_rcpf(eb0), __builtin_amdgcn_rcpf(eb1));
                            wr_[2 * n + jj] = pkh(fminf(eb0 * __builtin_amdgcn_rcpf(1.f + ea0), 60000.f), fminf(eb1 * __builtin_amdgcn_rcpf(1.f + ea1), 60000.f)); }
                    *(u32x4*)(gates + (size_t)row * 4096 + (pn - 23) * 128 + colin) = wr_;
                    *(u32x4*)(gates + (size_t)row * 4096 + 2048 + (pn - 23) * 128 + colin) = wb_; }
        }
    }
};
struct EpiUp {
    static constexpr bool PERM16 = false; static constexpr int MID_T = -1, NST = 0;
    __device__ static __forceinline__ bool nst_ok(const Unit&) { return true; }
    h16* qm; h16* kv; const float* rowsq; const float* cosm; const float* sinm;
    __device__ __forceinline__ void operator()(const Acc& acc, const Unit& u, int wr, int wc, int fr, int fq) const {
        asm volatile("" : "+v"(fr), "+v"(fq));
        EPI_ROWS(u, wr, fr); const int pn = u.pn, colin = wc * 32 + 8 * fq; const bool rope = (u.tag == 0 && pn >= 4);
        float rs[2][4];
        {   f32x4 s0[2][4], s1[2][4];
#pragma unroll
            for (int ai = 0; ai < 2; ++ai)
#pragma unroll
                for (int m = 0; m < 4; ++m) { const int row = row0 + ai * 128 + m * 16;
                    s0[ai][m] = *(const f32x4*)(rowsq + (size_t)row * 16 + u.tag * 8); s1[ai][m] = *(const f32x4*)(rowsq + (size_t)row * 16 + u.tag * 8 + 4); }
            __builtin_amdgcn_sched_barrier(0);
#pragma unroll
            for (int ai = 0; ai < 2; ++ai)
#pragma unroll
                for (int m = 0; m < 4; ++m) { const float ss = ((s0[ai][m][0] + s0[ai][m][1]) + (s0[ai][m][2] + s0[ai][m][3])) + ((s1[ai][m][0] + s1[ai][m][1]) + (s1[ai][m][2] + s1[ai][m][3]));
                    rs[ai][m] = __builtin_amdgcn_rsqf(ss * (1.0f / 512.0f) + EPS) * (u.tag == 0 ? QS_M : 1.0f); } }
        u32x4 pk[2][4][2];
        if (rope) {
#pragma unroll
            for (int ai = 0; ai < 2; ++ai) {
                f32x4 cs[4], sn[4];
#pragma unroll
                for (int m = 0; m < 4; ++m) { const int row = row0 + ai * 128 + m * 16;
                    cs[m] = *(const f32x4*)(cosm + (size_t)row * 32 + 16 * (wc & 1) + 4 * fq); sn[m] = *(const f32x4*)(sinm + (size_t)row * 32 + 16 * (wc & 1) + 4 * fq); }
                __builtin_amdgcn_sched_barrier(0);
#pragma unroll
                for (int m = 0; m < 4; ++m)
#pragma unroll
                    for (int bj = 0; bj < 2; ++bj) { f32x4 v0 = acc[ai][bj][m][0] * rs[ai][m], v1 = acc[ai][bj][m][1] * rs[ai][m]; rope8(v0, v1, cs[m], sn[m]); pk[ai][m][bj] = pk8(v0, v1); }
                __builtin_amdgcn_sched_barrier(0);
            }
        } else {
#pragma unroll
            for (int ai = 0; ai < 2; ++ai)
#pragma unroll
                for (int m = 0; m < 4; ++m)
#pragma unroll
                    for (int bj = 0; bj < 2; ++bj) pk[ai][m][bj] = pk8(acc[ai][bj][m][0] * rs[ai][m], acc[ai][bj][m][1] * rs[ai][m]);
        }
        __builtin_amdgcn_sched_barrier(0);
        int row0s = row0; asm volatile("" : "+v"(row0s));
#pragma unroll
        for (int ai = 0; ai < 2; ++ai)
#pragma unroll
            for (int m = 0; m < 4; ++m) { const int row = row0s + ai * 128 + m * 16;
#pragma unroll
                for (int bj = 0; bj < 2; ++bj) {
                    if (u.tag == 0) *(u32x4*)(qm + (size_t)row * 1536 + pn * 256 + bj * 128 + colin) = pk[ai][m][bj];
                    else *(u32x4*)(kv + (size_t)row * 2048 + pn * 256 + bj * 128 + colin) = pk[ai][m][bj]; } }
    }
};
__device__ __forceinline__ void unpk8(const u32x4 w, f32x4& a, f32x4& b) {
    const h16x8 h = __builtin_bit_cast(h16x8, w);
    a = (f32x4){(float)h[0], (float)h[1], (float)h[2], (float)h[3]}; b = (f32x4){(float)h[4], (float)h[5], (float)h[6], (float)h[7]};
}
template <int MODE> struct EpiOut {
    static constexpr bool PERM16 = (MODE == 3); static constexpr int MID_T = -1, NST = (MODE == 3) ? 8 : 16;
    __device__ static __forceinline__ bool nst_ok(const Unit&) { return true; }
    h16* out; int ldc; const h16* gate; int ldg; const h16* add; float scale;
    __device__ __forceinline__ void operator()(const Acc& acc, const Unit& u, int wr, int wc, int fr, int fq) const {
        asm volatile("" : "+v"(fr), "+v"(fq));
        EPI_ROWS(u, wr, fr); const int col0 = u.pn * 256 + wc * 32 + 8 * fq;
#pragma unroll
        for (int ai = 0; ai < 2; ++ai) {
            u32x4 gv[4][2], av[4][2];
            if (MODE == 1 || MODE == 2) {
#pragma unroll
                for (int m = 0; m < 4; ++m)
#pragma unroll
                    for (int bj = 0; bj < 2; ++bj) { const int row = row0 + ai * 128 + m * 16;
                        gv[m][bj] = *(const u32x4*)(gate + (size_t)row * ldg + col0 + bj * 128);
                        if (MODE == 2) av[m][bj] = *(const u32x4*)(add + (size_t)row * ldc + col0 + bj * 128); }
                __builtin_amdgcn_sched_barrier(0);
            }
#pragma unroll
            for (int m = 0; m < 4; ++m) { const int row = row0 + ai * 128 + m * 16;
                if (MODE == 3) {
                    const f32x4 a0 = acc[ai][0][m][0], a1 = acc[ai][0][m][1], b0 = acc[ai][1][m][0], b1 = acc[ai][1][m][1];
                    u32x4 w; w.x = pk4_fp8(a0[0], a0[1], a0[2], a0[3]); w.y = pk4_fp8(a1[0], a1[1], a1[2], a1[3]); w.z = pk4_fp8(b0[0], b0[1], b0[2], b0[3]); w.w = pk4_fp8(b1[0], b1[1], b1[2], b1[3]);
                    *(u32x4*)((unsigned char*)out + (size_t)row * ldc + u.pn * 256 + wc * 64 + 16 * fq) = w;
                    continue; }
#pragma unroll
                for (int bj = 0; bj < 2; ++bj) { f32x4 v0 = acc[ai][bj][m][0], v1 = acc[ai][bj][m][1];
                    if (MODE == 1 || MODE == 2) { f32x4 g0, g1; unpk8(gv[m][bj], g0, g1); v0 *= g0; v1 *= g1; }
                    if (MODE == 2) { f32x4 a0, a1; unpk8(av[m][bj], a0, a1); v0 += a0; v1 += a1; }
                    *(u32x4*)(out + (size_t)row * ldc + col0 + bj * 128) = pk8(v0, v1); } }
        }
    }
};
struct EpiMerge {
    static constexpr bool PERM16 = true; static constexpr int MID_T = 16, NST = 0;
    __device__ static __forceinline__ bool nst_ok(const Unit&) { return true; }
    h16* out; const h16* gate;
    __device__ __forceinline__ void mid(Acc& acc, const Unit& u, int wr, int wc, int fr, int fq) const {
        asm volatile("" : "+v"(fr), "+v"(fq));
        EPI_ROWS(u, wr, fr); const int col0 = u.pn * 256 + wc * 64 + 16 * fq;
        u32x4 gr[2][4][2];
#pragma unroll
        for (int ai = 0; ai < 2; ++ai)
#pragma unroll
            for (int m = 0; m < 4; ++m)
#pragma unroll
                for (int bj = 0; bj < 2; ++bj) gr[ai][m][bj] = *(const u32x4*)((const char*)gate + (unsigned)(((row0 + ai * 128 + m * 16) * 4096 + col0 + bj * 8) * 2));
        __builtin_amdgcn_sched_barrier(0);
#pragma unroll
        for (int ai = 0; ai < 2; ++ai)
#pragma unroll
            for (int m = 0; m < 4; ++m)
#pragma unroll
                for (int bj = 0; bj < 2; ++bj) { f32x4 a0, a1; unpk8(gr[ai][m][bj], a0, a1); acc[ai][bj][m][0] *= a0; acc[ai][bj][m][1] *= a1; }
    }
    __device__ __forceinline__ void operator()(Acc& acc, const Unit& u, int wr, int wc, int fr, int fq) const {
        asm volatile("" : "+v"(fr), "+v"(fq));
        EPI_ROWS(u, wr, fr); const int col0 = u.pn * 256 + wc * 64 + 16 * fq;
        u32x4 gb[2][4][2];
#pragma unroll
        for (int ai = 0; ai < 2; ++ai)
#pragma unroll
            for (int m = 0; m < 4; ++m)
#pragma unroll
                for (int bj = 0; bj < 2; ++bj) gb[ai][m][bj] = *(const u32x4*)((const char*)gate + (unsigned)(((row0 + ai * 128 + m * 16) * 4096 + 2048 + col0 + bj * 8) * 2));
        __builtin_amdgcn_sched_barrier(0);
#pragma unroll
        for (int ai = 0; ai < 2; ++ai)
#pragma unroll
            for (int m = 0; m < 4; ++m)
#pragma unroll
                for (int bj = 0; bj < 2; ++bj) { f32x4 b0, b1; unpk8(gb[ai][m][bj], b0, b1); acc[ai][bj][m][0] *= b0; acc[ai][bj][m][1] *= b1; }
        __builtin_amdgcn_sched_barrier(0);
#pragma unroll
        for (int ai = 0; ai < 2; ++ai)
#pragma unroll
            for (int m = 0; m < 4; ++m) { const int row = row0 + ai * 128 + m * 16;
                const f32x4 a0 = acc[ai][0][m][0], a1 = acc[ai][0][m][1], b0 = acc[ai][1][m][0], b1 = acc[ai][1][m][1];
                u32x4 w; w.x = pk4_fp8(a0[0], a0[1], a0[2], a0[3]); w.y = pk4_fp8(a1[0], a1[1], a1[2], a1[3]); w.z = pk4_fp8(b0[0], b0[1], b0[2], b0[3]); w.w = pk4_fp8(b1[0], b1[1], b1[2], b1[3]);
                *(u32x4*)((unsigned char*)out + (size_t)row * DM + col0) = w; }
    }
};
struct EpiSwiglu {
    static constexpr bool PERM16 = false; static constexpr int MID_T = -1, NST = 8;
    __device__ static __forceinline__ bool nst_ok(const Unit&) { return true; }
    unsigned char* act;
    __device__ __forceinline__ void operator()(const Acc& acc, const Unit& u, int wr, int wc, int fr, int fq) const {
        asm volatile("" : "+v"(fr), "+v"(fq));
        EPI_ROWS(u, wr, fr); const int col0 = u.pn * 128 + wc * 32 + 8 * fq;
#pragma unroll
        for (int ai = 0; ai < 2; ++ai)
#pragma unroll
            for (int m = 0; m < 4; ++m) { const int row = row0 + ai * 128 + m * 16;
                f32x4 g0 = acc[ai][0][m][0], g1 = acc[ai][0][m][1]; const f32x4 u0 = acc[ai][1][m][0], u1 = acc[ai][1][m][1];
#pragma unroll
                for (int j = 0; j < 4; ++j) { g0[j] = g0[j] * sigmoidf_(g0[j]) * u0[j]; g1[j] = g1[j] * sigmoidf_(g1[j]) * u1[j]; }
                u32x2 w; w.x = pk4_fp8(g0[0], g0[1], g0[2], g0[3]); w.y = pk4_fp8(g1[0], g1[1], g1[2], g1[3]);
                *(u32x2*)(act + (size_t)row * 512 + col0) = w; }
    }
};

struct UpOrder {
    const char* qa; const char* wq; const char* wkv; int G, c;
    __device__ __forceinline__ bool next(int i, Unit& u) const {
        const int L = i * G + c; if (L >= 896) return false;
        u.e = 0; u.slot0 = 0; u.cnt = 0;
        if (L < 384) { u.pm = L / 6; u.pn = L % 6; u.tag = 0; u.A = qa + (size_t)u.pm * 256 * 2048; u.B = wq + (size_t)u.pn * 256 * 1024; }
        else { const int l = L - 384; u.pm = l >> 3; u.pn = l & 7; u.tag = 1; u.A = qa + (size_t)u.pm * 256 * 2048 + 1024; u.B = wkv + (size_t)u.pn * 256 * 1024; }
        return true;
    }
    __device__ __forceinline__ unsigned voff(const Unit&, int, int) const { return 0u; }
    __device__ __forceinline__ unsigned vraw(const Unit&, int) const { return 0u; }
    __device__ __forceinline__ unsigned vfin(const Unit&, int, int, unsigned) const { return 0u; }
};
__device__ __forceinline__ void moe_tables(const Frame& F, const unsigned* cnt) {
    LAS int* tstart = (LAS int*)(F.lds + LDS_TAB); LAS int* cnts = (LAS int*)(F.lds + LDS_TAB + 512); LAS int* tmap = (LAS int*)(F.lds + LDS_TAB + 1024);
    __syncthreads();
    if (F.tid < 65) cnts[F.tid] = F.tid < 64 ? (int)__hip_atomic_load(cnt + 64 * F.tid, __ATOMIC_RELAXED, __HIP_MEMORY_SCOPE_AGENT) : NTOK;
    __syncthreads();
    if (F.tid == 0) { int s = 0; for (int e = 0; e < 65; ++e) { tstart[e] = s; s += (cnts[e] + 255) >> 8; } tstart[65] = s; }
    __syncthreads();
    { int e = 0; for (int j = 1; j < 65; ++j) e += (tstart[j] <= F.tid) ? 1 : 0; tmap[F.tid] = (F.tid < tstart[65]) ? e : 255; }
    __syncthreads();
}
template <int NPN, bool GU> struct MoeOrder {
    const LAS int* tstart; const LAS int* cnts; const LAS int* tmap; const char* A; const char* W; const unsigned* list; int G, c;
    __device__ __forceinline__ bool next(int i, Unit& u) const {
        const int T = __builtin_amdgcn_readfirstlane(tstart[65]); int L;
        if (G == 256) { const int U8 = (T * NPN + 7) >> 3, q = i * 32 + (c & 31); if (q >= U8) return false; L = (c >> 5) * U8 + q; }
        else L = i * G + c;
        const int mt = L / NPN;
        if (mt >= T) return false;
        const int e = __builtin_amdgcn_readfirstlane(tmap[mt]);
        u.pm = mt; u.pn = L % NPN; u.e = e; u.slot0 = (mt - __builtin_amdgcn_readfirstlane(tstart[e])) * 256; u.cnt = __builtin_amdgcn_readfirstlane(cnts[e]); u.tag = i;
        if (GU) { u.A = A; u.B = W + (size_t)e * (1024 * 2048) + (size_t)u.pn * (256 * 2048); }
        else { u.A = A + (size_t)mt * (256 * 512); u.B = W + (size_t)e * (2048 * 512) + (size_t)u.pn * (256 * 512); }
        return true;
    }
    __device__ __forceinline__ unsigned voff(const Unit& u, int row, int col) const {
        return vfin(u, row, col, vraw(u, row));
    }
    __device__ __forceinline__ unsigned vraw(const Unit& u, int row) const { return ((const LAS unsigned*)(tstart + 1024))[(u.tag < 11 ? u.tag : 10) * 256 + row]; }
    __device__ __forceinline__ unsigned vfin(const Unit&, int, int col, unsigned tok) const { return tok * 2048u + (unsigned)col * 2u; }
    __device__ __forceinline__ void fill_rows(int tid) const {
        LAS unsigned* tab = (LAS unsigned*)(tstart + 1024);
        for (int i = 0; i < 11; ++i) { Unit u; if (!next(i, u)) break;
            if (tid < 256) { const int slot = u.slot0 + tid; unsigned tok;
                if (u.e == 64) tok = (unsigned)slot; else tok = slot < u.cnt ? list[(size_t)u.e * LISTCAP + slot] : 0u;
                tab[i * 256 + tid] = tok; } }
        __syncthreads();
    }
};

namespace att {
constexpr int KVBLK = 64, SHM_K = 16384, SHM_V = 16384, SHM_KR = 8192;
template <bool MLA> struct Lay { static constexpr int NB = MLA ? 2 : 4, OFF_V = 0, OFF_K = NB * SHM_V, OFF_KR = OFF_K + NB * SHM_K, OFF_WS = OFF_KR + (MLA ? NB * SHM_KR : 0), OFF_QR = OFF_WS + 2048; };
constexpr float THR2 = 11.5f;
#define KSWZ(row, colB) ((row) * 256 + ((colB) ^ (((row) & 7) << 4)))
#define RSWZ(row, colB) ((row) * 128 + ((colB) ^ (((row) & 7) << 4)))
#define SBAR() __builtin_amdgcn_sched_barrier(0)
__device__ __forceinline__ int v_st(int k, int c) { const int kk = (k & ~0xC) | ((k & 4) << 1) | ((k & 8) >> 1); return ((kk >> 3) * 4 + (c >> 5)) * 512 + ((kk & 7) * 32 + (c & 31)) * 2; }
__device__ __forceinline__ int v_rd_base(int lane) { return ((lane & 3) << 3) | (((lane >> 2) & 3) << 6) | (((lane >> 4) & 1) << 5) | (((lane >> 5) & 1) << 8); }
constexpr int v_rd_off(int d0, int ks, int half) { return d0 * 512 + ks * 4096 + half * 2048; }
__device__ __forceinline__ int crow(int r, int hi) { return (r & 3) + 8 * (r >> 2) + 4 * hi; }
__device__ __forceinline__ void mask_tile(f32x16& p0, f32x16& p1, int dq, unsigned W) {
    const float NEG = -__builtin_inff();
#pragma unroll
    for (int r = 0; r < 16; ++r) {
        const int c = (r & 3) + 8 * (r >> 2);
        if ((unsigned)(dq - c) >= W) p0[r] = NEG;
        if ((unsigned)(dq - c - 32) >= W) p1[r] = NEG;
    }
}
__device__ __forceinline__ void softmax_tile(f32x16& p0, f32x16& p1, float& m_reg, float& l_reg, float& alpha, h16x8& pa0, h16x8& pa1, h16x8& pa2, h16x8& pa3) {
    float pmax = p0[0];
#pragma unroll
    for (int r = 1; r < 16; ++r) pmax = fmaxf(pmax, p0[r]);
#pragma unroll
    for (int r = 0; r < 16; ++r) pmax = fmaxf(pmax, p1[r]);
    { auto rr = __builtin_amdgcn_permlane32_swap(__float_as_uint(pmax), __float_as_uint(pmax), false, false);
      pmax = fmaxf(__uint_as_float(rr[0]), __uint_as_float(rr[1])); }
    float mn;
    if (__all((pmax - m_reg) <= THR2)) { mn = m_reg; alpha = 1.f; }
    else { mn = fmaxf(m_reg, pmax); alpha = __builtin_amdgcn_exp2f(m_reg - mn); m_reg = mn; }
#pragma unroll
    for (int r = 0; r < 16; ++r) { p0[r] = __builtin_amdgcn_exp2f(p0[r] - mn); p1[r] = __builtin_amdgcn_exp2f(p1[r] - mn); }
    float ps = 0;
#pragma unroll
    for (int r = 0; r < 16; ++r) ps += p0[r];
#pragma unroll
    for (int r = 0; r < 16; ++r) ps += p1[r];
    { auto rr = __builtin_amdgcn_permlane32_swap(__float_as_uint(ps), __float_as_uint(ps), false, false);
      ps = __uint_as_float(rr[0]) + __uint_as_float(rr[1]); }
    l_reg = l_reg * alpha + ps;
#define PK4(P, B_, OUT) do { unsigned a0 = pkh(P[B_+0], P[B_+1]), a1 = pkh(P[B_+2], P[B_+3]);                          \
        unsigned b0 = pkh(P[B_+4], P[B_+5]), b1 = pkh(P[B_+6], P[B_+7]);                                             \
        auto r0 = __builtin_amdgcn_permlane32_swap(a0, b0, false, false); auto r1 = __builtin_amdgcn_permlane32_swap(a1, b1, false, false); \
        u32x4 w = {r0[0], r1[0], r0[1], r1[1]}; OUT = __builtin_bit_cast(h16x8, w); } while (0)
    PK4(p0, 0, pa0); PK4(p0, 8, pa1); PK4(p1, 0, pa2); PK4(p1, 8, pa3);
#undef PK4
}
struct AUnit {
    const char* Q; const char* QR;
    const char* K; const char* V;
    const char* KR;
    char* O;
    float* LSE;
    unsigned qs, kvs, krs, os, ls;
    int P0, jlo, jhi; unsigned W;
};
template <bool MLA>
__device__ __forceinline__ void attn_unit(LAS unsigned char* lds, const AUnit& u) {
    const int tid = threadIdx.x, wid = __builtin_amdgcn_readfirstlane(tid >> 6), lane = tid & 63, r32 = lane & 31, hi = lane >> 5;
    typedef Lay<MLA> L; constexpr int NB = L::NB, PER_TILE = MLA ? 5 : 4;
    LAS unsigned char* V_lds = lds + L::OFF_V; LAS unsigned char* K_lds = lds + L::OFF_K; LAS unsigned char* R_lds = lds + L::OFF_KR;
    LAS float* wsf = (LAS float*)(lds + L::OFF_WS) + wid * 64;
    LAS unsigned char* QRl = lds + L::OFF_QR + wid * 4096 + lane * 16;
    const int qlo = u.P0 + wid * 32, qm = qlo + r32 - 4 * hi;
    unsigned ko[2], vo[2], kro = 0u;
#pragma unroll
    for (int i = 0; i < 2; ++i) { const int p = (wid * 2 + i) * 64 + lane;
        { const int row = p >> 4, pc = p & 15; ko[i] = (unsigned)row * u.kvs + (unsigned)((pc ^ (row & 7)) << 4); }
        { const int cc = (p & 3) | (((p >> 5) & 3) << 2), kk = ((p >> 2) & 7) | ((p >> 7) << 3), k = (kk & ~0xC) | ((kk & 4) << 1) | ((kk & 8) >> 1);
          vo[i] = (unsigned)k * u.kvs + (unsigned)cc * 16u; } }
    if constexpr (MLA) { const int p = wid * 64 + lane, row = p >> 3, pc = p & 7; kro = (unsigned)row * u.krs + (unsigned)((pc ^ (row & 7)) << 4); }
#define ST_ISSUE(t, bf) do { const size_t tb_ = (size_t)(t) * KVBLK * u.kvs; const char* Kt_ = u.K + tb_; const char* Vt_ = u.V + tb_; \
        _Pragma("unroll") for (int i_ = 0; i_ < 2; ++i_) { \
            __builtin_amdgcn_global_load_lds((const unsigned*)(Kt_ + ko[i_]), (LAS unsigned*)(K_lds + (bf) * SHM_K + (wid * 2 + i_) * 1024), 16, 0, 0); \
            __builtin_amdgcn_global_load_lds((const unsigned*)(Vt_ + vo[i_]), (LAS unsigned*)(V_lds + (bf) * SHM_V + (wid * 2 + i_) * 1024), 16, 0, 0); } \
        if constexpr (MLA) __builtin_amdgcn_global_load_lds((const unsigned*)(u.KR + (size_t)(t) * KVBLK * u.krs + kro), (LAS unsigned*)(R_lds + (bf) * SHM_KR + wid * 1024), 16, 0, 0); } while (0)
    __syncthreads();
#pragma unroll
    for (int i = 0; i < NB - 1; ++i) if (u.jlo + i < u.jhi) ST_ISSUE(u.jlo + i, i);
    h16x8 qr[8];
    { const unsigned qo = (unsigned)(wid * 32 + r32) * u.qs + (unsigned)hi * 16u;
#pragma unroll
      for (int d0 = 0; d0 < 8; ++d0) qr[d0] = *(const h16x8*)(u.Q + d0 * 32 + qo);
      if constexpr (MLA) {
#pragma unroll
        for (int d0 = 0; d0 < 4; ++d0) *(LAS h16x8*)(QRl + d0 * 1024) = *(const h16x8*)(u.QR + d0 * 32 + qo); } }
    float m_reg = -1e30f, l_reg = 0.f; f32x16 o[4];
#pragma unroll
    for (int d = 0; d < 4; ++d)
#pragma unroll
        for (int r = 0; r < 16; ++r) o[d][r] = 0.f;
    const int vbb = (int)(uintptr_t)V_lds + v_rd_base(lane);
    for (int t = u.jlo; t < u.jhi; ++t) {
        const int bf = (t - u.jlo) & (NB - 1);
        if constexpr (NB == 4) { if (t + 2 < u.jhi) asm volatile("s_waitcnt vmcnt(8)" ::: "memory"); else if (t + 1 < u.jhi) asm volatile("s_waitcnt vmcnt(4)" ::: "memory"); else asm volatile("s_waitcnt vmcnt(0)" ::: "memory"); }
        else asm volatile("s_waitcnt vmcnt(0)" ::: "memory");
        __syncthreads();
        if (t + NB - 1 < u.jhi) ST_ISSUE(t + NB - 1, (bf + NB - 1) & (NB - 1));
        const int vb0 = vbb + bf * SHM_V;
        const int kb = t * KVBLK;
        const bool act = (kb <= qlo + 31) && ((long)kb + KVBLK - 1 >= (long)qlo - (long)(u.W - 1));
        if (act) {
            f32x16 p0, p1;
#pragma unroll
            for (int r = 0; r < 16; ++r) { p0[r] = 0.f; p1[r] = 0.f; }
            {   const LAS unsigned char* kbp[4];
#pragma unroll
                for (int dd = 0; dd < 4; ++dd) kbp[dd] = K_lds + bf * SHM_K + KSWZ(r32, (dd * 16 + hi * 8) * 2);
#pragma unroll
                for (int d0 = 0; d0 < 8; ++d0) { const LAS unsigned char* a = kbp[d0 & 3] + (d0 >> 2) * 128;
                    const h16x8 b0 = *(const LAS h16x8*)a, b1 = *(const LAS h16x8*)(a + 32 * 256);
                    p0 = __builtin_amdgcn_mfma_f32_32x32x16_f16(b0, qr[d0], p0, 0, 0, 0);
                    p1 = __builtin_amdgcn_mfma_f32_32x32x16_f16(b1, qr[d0], p1, 0, 0, 0); }
                if constexpr (MLA) {
#pragma unroll
                    for (int d0 = 0; d0 < 4; ++d0) { const LAS unsigned char* a = R_lds + bf * SHM_KR + RSWZ(r32, (d0 * 16 + hi * 8) * 2);
                        const h16x8 b0 = *(const LAS h16x8*)a, b1 = *(const LAS h16x8*)(a + 32 * 128); const h16x8 qf = *(const LAS h16x8*)(QRl + d0 * 1024);
                        p0 = __builtin_amdgcn_mfma_f32_32x32x16_f16(b0, qf, p0, 0, 0, 0);
                        p1 = __builtin_amdgcn_mfma_f32_32x32x16_f16(b1, qf, p1, 0, 0, 0); }
                }
            }
            if (kb + KVBLK - 1 > qlo || (long)kb <= (long)qlo + 31 - (long)u.W) mask_tile(p0, p1, qm - kb, u.W);
            float alpha; h16x8 pa0, pa1, pa2, pa3;
            softmax_tile(p0, p1, m_reg, l_reg, alpha, pa0, pa1, pa2, pa3);
            if (__any(alpha < 1.f)) {
#pragma unroll
                for (int r = 0; r < 16; ++r)
#pragma unroll
                    for (int d = 0; d < 4; ++d) o[d][r] *= alpha;
            }
#define TRRD(dst, off) asm volatile("ds_read_b64_tr_b16 %0, %1 offset:%2" : "=&v"(dst) : "v"(vb0), "i"(off) : "memory")
#define PV_D0(VB, d0) do { s16x4 l0, l1, l2, l3, h0, h1, h2, h3; constexpr int b_ = (VB) * SHM_V + v_rd_off(d0, 0, 0); \
        TRRD(l0, b_); TRRD(h0, b_ + 2048); TRRD(l1, b_ + 4096); TRRD(h1, b_ + 6144); TRRD(l2, b_ + 8192); TRRD(h2, b_ + 10240); TRRD(l3, b_ + 12288); TRRD(h3, b_ + 14336); \
        asm volatile("s_waitcnt lgkmcnt(0)" ::: "memory"); SBAR(); \
        o[d0] = __builtin_amdgcn_mfma_f32_32x32x16_f16(__builtin_bit_cast(h16x8, (short __attribute__((ext_vector_type(8)))){l0[0], l0[1], l0[2], l0[3], h0[0], h0[1], h0[2], h0[3]}), pa0, o[d0], 0, 0, 0); \
        o[d0] = __builtin_amdgcn_mfma_f32_32x32x16_f16(__builtin_bit_cast(h16x8, (short __attribute__((ext_vector_type(8)))){l1[0], l1[1], l1[2], l1[3], h1[0], h1[1], h1[2], h1[3]}), pa1, o[d0], 0, 0, 0); \
        o[d0] = __builtin_amdgcn_mfma_f32_32x32x16_f16(__builtin_bit_cast(h16x8, (short __attribute__((ext_vector_type(8)))){l2[0], l2[1], l2[2], l2[3], h2[0], h2[1], h2[2], h2[3]}), pa2, o[d0], 0, 0, 0); \
        o[d0] = __builtin_amdgcn_mfma_f32_32x32x16_f16(__builtin_bit_cast(h16x8, (short __attribute__((ext_vector_type(8)))){l3[0], l3[1], l3[2], l3[3], h3[0], h3[1], h3[2], h3[3]}), pa3, o[d0], 0, 0, 0); } while (0)
            PV_D0(0, 0); PV_D0(0, 1); PV_D0(0, 2); PV_D0(0, 3);
#undef PV_D0
#undef TRRD
        }
    }
#undef ST_ISSUE
    if (u.LSE && hi == 0) u.LSE[(unsigned)(wid * 32 + r32) * u.ls] = m_reg + __builtin_amdgcn_logf(l_reg);
    const float rl = __builtin_amdgcn_rcpf(l_reg);
    unsigned loff = (unsigned)(wid * 32 + r32) * u.os + (unsigned)hi * 16u;
    asm volatile("" : "+v"(loff));
#pragma unroll
    for (int d0 = 0; d0 < 4; ++d0)
#pragma unroll
        for (int gp = 0; gp < 2; ++gp) {
            const unsigned a_lo = pkh(o[d0][8 * gp + 0] * rl, o[d0][8 * gp + 1] * rl), a_hi = pkh(o[d0][8 * gp + 2] * rl, o[d0][8 * gp + 3] * rl);
            const unsigned b_lo = pkh(o[d0][8 * gp + 4] * rl, o[d0][8 * gp + 5] * rl), b_hi = pkh(o[d0][8 * gp + 6] * rl, o[d0][8 * gp + 7] * rl);
            const auto s_lo = __builtin_amdgcn_permlane32_swap(a_lo, b_lo, false, false); const auto s_hi = __builtin_amdgcn_permlane32_swap(a_hi, b_hi, false, false);
            u32x4 w; w.x = s_lo[0]; w.y = s_hi[0]; w.z = s_lo[1]; w.w = s_hi[1];
            *(u32x4*)(u.O + (d0 * 64 + gp * 32) + loff) = w; }
}
}

template <class RowOf>
__device__ __forceinline__ void cvt_item(const float* W, int K, int N, h16* WT, LAS float* scr, int item, int lane, const float* kscale, RowOf row_of, int ldo = 0, int ko = 0) {
    if (ldo == 0) ldo = K;
    const int nblk = N >> 6, kb = item / nblk, nb = item - kb * nblk, k0 = kb * 64, n0 = nb * 64;
    f32x4 v[16];
#pragma unroll
    for (int i = 0; i < 16; ++i) { const int kk = 4 * i + (lane >> 4); v[i] = *(const GAS f32x4*)(W + (size_t)(k0 + kk) * N + n0 + (lane & 15) * 4); }
#pragma unroll
    for (int i = 0; i < 16; ++i) { const int kk = 4 * i + (lane >> 4); f32x4 t = v[i]; if (kscale) t *= kscale[k0 + kk];
        LAS float* s = scr + kk * 65 + (lane & 15) * 4; s[0] = t[0]; s[1] = t[1]; s[2] = t[2]; s[3] = t[3]; }
    LDS_WAIT(); asm volatile("" ::: "memory");
    const int c = lane & 7;
#pragma unroll
    for (int j = 0; j < 8; ++j) { const int n = (lane >> 3) + 8 * j; const LAS float* s = scr + (8 * c) * 65 + n;
        u32x4 o; o.x = pkh(s[0 * 65], s[1 * 65]); o.y = pkh(s[2 * 65], s[3 * 65]); o.z = pkh(s[4 * 65], s[5 * 65]); o.w = pkh(s[6 * 65], s[7 * 65]);
        *(GAS u32x4*)(WT + (size_t)row_of(n0 + n) * ldo + ko + k0 + 8 * c) = o; }
    LDS_WAIT(); asm volatile("" ::: "memory");
}
template <class RowOf>
__device__ __forceinline__ void cvt_item8(const float* W, int K, int N, unsigned char* WT, LAS float* scr, int item, int lane, float scale, RowOf row_of) {
    const int nblk = N >> 6, kb = item / nblk, nb = item - kb * nblk, k0 = kb * 64, n0 = nb * 64;
    f32x4 v[16];
#pragma unroll
    for (int i = 0; i < 16; ++i) { const int kk = 4 * i + (lane >> 4); v[i] = *(const GAS f32x4*)(W + (size_t)(k0 + kk) * N + n0 + (lane & 15) * 4); }
#pragma unroll
    for (int i = 0; i < 16; ++i) { const int kk = 4 * i + (lane >> 4); const f32x4 t = v[i] * scale;
        LAS float* s = scr + kk * 65 + (lane & 15) * 4; s[0] = t[0]; s[1] = t[1]; s[2] = t[2]; s[3] = t[3]; }
    LDS_WAIT(); asm volatile("" ::: "memory");
    const int c = lane & 7;
#pragma unroll
    for (int j = 0; j < 8; ++j) { const int n = (lane >> 3) + 8 * j; const LAS float* s = scr + (8 * c) * 65 + n;
        u32x2 o; o.x = pk4_fp8(s[0 * 65], s[1 * 65], s[2 * 65], s[3 * 65]); o.y = pk4_fp8(s[4 * 65], s[5 * 65], s[6 * 65], s[7 * 65]);
        *(GAS u32x2*)(WT + (size_t)row_of(n0 + n) * K + k0 + 8 * c) = o; }
    LDS_WAIT(); asm volatile("" ::: "memory");
}
__device__ __forceinline__ int rope_perm(int i, int half) { return i < half ? 2 * i : 2 * (i - half) + 1; }
__device__ __forceinline__ int row_in(int c) {
    if (c < 1024) return c;
    if (c < 1088) return 1024 + rope_perm(c - 1024, 32);
    if (c < 5696) { const int dc = c - 1088, part = dc / 1536, dim = dc & 127;
        return 1280 + ((part < 2 && dim < 32) ? (dc - dim + rope_perm(dim, 16)) : dc); }
    { const int g = c - 5696, which = g >> 11, ch = g & 2047; return 5888 + (ch >> 7) * 256 + which * 128 + (ch & 127); }
}
__device__ __forceinline__ int row_qup(int c) { const int h = c / 192, j = c - h * 192; return j < 128 ? h * 128 + j : 1024 + h * 64 + rope_perm(j - 128, 32); }
__device__ __forceinline__ int row_gu(int n, int up) { return (n >> 7) * 256 + up * 128 + (n & 127); }
__device__ __forceinline__ void sincos_d(float angf, float& s, float& c) {
    const double a = (double)angf; const double k = __builtin_rint(a * 0.63661977236758134308);
    const double r = (a - k * 1.57079632679489655800) - k * 6.12323399573676603587e-17; const double r2 = r * r;
    double sp = -7.6471637318198164759e-13; sp = sp * r2 + 1.6059043836821614599e-10; sp = sp * r2 - 2.5052108385441718775e-08; sp = sp * r2 + 2.7557319223985890653e-06;
    sp = sp * r2 - 1.9841269841269841270e-04; sp = sp * r2 + 8.3333333333333333333e-03; sp = sp * r2 - 1.6666666666666666667e-01; const double sn = r + r * r2 * sp;
    double cp = 4.7794773323873852974e-14; cp = cp * r2 - 1.1470745597729724714e-11; cp = cp * r2 + 2.0876756987868098979e-09; cp = cp * r2 - 2.7557319223985890653e-07;
    cp = cp * r2 + 2.4801587301587301587e-05; cp = cp * r2 - 1.3888888888888888889e-03; cp = cp * r2 + 4.1666666666666666667e-02; cp = cp * r2 - 0.5; const double cn = 1.0 + r2 * cp;
    const int q = ((int)k) & 3;
    const double ss = (q == 0) ? sn : (q == 1) ? cn : (q == 2) ? -sn : -cn;
    const double cc = (q == 0) ? cn : (q == 1) ? -sn : (q == 2) ? -cn : sn;
    s = (float)ss; c = (float)cc;
}
__device__ __forceinline__ void p0_prologue(const Frame& F, const Args& a) {
    {
        LAS float* sc = (LAS float*)F.lds; LAS float* part = (LAS float*)(F.lds + 32768);
        float* mod = wsp<float>(F, WS_MOD);
        for (int i = F.tid; i < 4 * DM; i += NTHR) { const float v = a.c[i]; sc[i] = v / (1.0f + __expf(-v)); }
        __syncthreads();
        for (int un = F.vcu; un < 192; un += F.G) {
            const int j0 = un * 64, col4 = F.tid & 15, kg = F.tid >> 4;
            f32x4 ac[4];
#pragma unroll
            for (int b = 0; b < 4; ++b) ac[b] = (f32x4){0.f, 0.f, 0.f, 0.f};
#pragma unroll 16
            for (int i = 0; i < 64; ++i) { const int k = kg + 32 * i; const f32x4 w = __builtin_nontemporal_load((const GAS f32x4*)(a.w_ada + (size_t)k * 12288 + j0 + col4 * 4));
#pragma unroll
                for (int b = 0; b < 4; ++b) ac[b] += w * sc[b * DM + k]; }
#pragma unroll
            for (int b = 0; b < 4; ++b) *(LAS f32x4*)(part + (kg * 4 + b) * 64 + col4 * 4) = ac[b];
            __syncthreads();
            if (F.tid < 256) { const int b = F.tid >> 6, col = F.tid & 63; float s = 0.f;
                for (int g = 0; g < 32; ++g) s += part[(g * 4 + b) * 64 + col];
                mod[b * 12288 + j0 + col] = s + a.b_ada[j0 + col]; }
            __syncthreads();
        }
    }
    const int gw = F.vcu * NWAVES + F.wave, NGW = F.G * NWAVES, gt = F.vcu * NTHR + F.tid, NGT = F.G * NTHR;
    {
        float* cosd = wsp<float>(F, WS_COSD); float* sind = wsp<float>(F, WS_SIND); float* cosm = wsp<float>(F, WS_COSM); float* sinm = wsp<float>(F, WS_SINM);
        for (int i = gt; i < NTOK * 48; i += NGT) { const int t = i / 48, j = i - t * 48; const float p = (float)a.pos[t];
            float s, c;
            if (j < 16) { sincos_d(p * a.invf_d[j], s, c); cosd[t * 16 + j] = c; sind[t * 16 + j] = s; }
            else { sincos_d(p * a.invf_m[j - 16], s, c); cosm[t * 32 + j - 16] = c; sinm[t * 32 + j - 16] = s; } }
    }
    { h16* wr = wsp<h16>(F, W_R);
      for (int i = gt; i < 64 * DM; i += NGT) { const int j = i & 7, lane = (i >> 3) & 63, kk = (i >> 9) & 63, et = i >> 15, fr = lane & 15, fq = lane >> 4;
          wr[i] = (h16)a.w_router[(size_t)(kk * 32 + fq * 8 + j) * 64 + et * 16 + fr]; } }
    { u32x4* z = (u32x4*)(wsp<unsigned char>(F, W_IN) + (size_t)1088 * DM); for (int i = gt; i < 192 * DM / 16; i += NGT) z[i] = (u32x4){0u, 0u, 0u, 0u}; }
    {
        __syncthreads();
        LAS float* scr = (LAS float*)(F.lds + F.wave * 16640);
        constexpr int I_IN = 32 * 153, I_QUP = 8 * 24, I_KVUP = 8 * 32, I_MO = 16 * 32, I_DO = 8 * 32, I_OUT = 32 * 32, I_R = 32, I_SH = 256, I_EX = 256;
        constexpr int NSMALL = I_IN + I_QUP + I_KVUP + I_MO + I_DO + I_OUT + I_R + 3 * I_SH;
        constexpr int NITEMS = NSMALL;
        for (int it = gw; it < NITEMS; it += NGW) {
            int r = it;
            if (r < I_IN) { cvt_item8(a.w_in, DM, 9792, wsp<unsigned char>(F, W_IN), scr, r, F.lane, SC_GU, [](int n) { return row_in(n); }); continue; } r -= I_IN;
            if (r < I_QUP) { cvt_item(a.w_q_up, 512, 1536, wsp<h16>(F, W_QUP), scr, r, F.lane, a.q_a_norm_g, [](int n) { return row_qup(n); }); continue; } r -= I_QUP;
            if (r < I_KVUP) { cvt_item(a.w_kv_up, 512, 2048, wsp<h16>(F, W_KVUP), scr, r, F.lane, a.kv_a_norm_g, [](int n) { return n; }); continue; } r -= I_KVUP;
            if (r < I_MO) { cvt_item(a.w_mla_o, 1024, 2048, wsp<h16>(F, W_MO), scr, r, F.lane, nullptr, [](int n) { return n; }, 1536, 0); continue; } r -= I_MO;
            if (r < I_DO) { cvt_item(a.w_dil_o, 512, 2048, wsp<h16>(F, W_MO), scr, r, F.lane, nullptr, [](int n) { return n; }, 1536, 1024); continue; } r -= I_DO;
            if (r < I_OUT) { cvt_item8(a.w_out, DM, DM, wsp<unsigned char>(F, W_OUT), scr, r, F.lane, SC_GU, [](int n) { return n; }); continue; } r -= I_OUT;
            if (r < I_R) { continue; } r -= I_R;
            if (r < I_SH) { cvt_item8(a.w_sh_gate, DM, 512, wsp<unsigned char>(F, W_GU) + (size_t)64 * 1024 * 2048, scr, r, F.lane, SC_GU, [](int n) { return row_gu(n, 0); }); continue; } r -= I_SH;
            if (r < I_SH) { cvt_item8(a.w_sh_up, DM, 512, wsp<unsigned char>(F, W_GU) + (size_t)64 * 1024 * 2048, scr, r, F.lane, SC_GU, [](int n) { return row_gu(n, 1); }); continue; } r -= I_SH;
            if (r < I_SH) { cvt_item8(a.w_sh_down, 512, DM, wsp<unsigned char>(F, W_DN) + (size_t)64 * 2048 * 512, scr, r, F.lane, SC_DN, [](int n) { return n; }); continue; } r -= I_SH;
        }
        __syncthreads();
    }
}

constexpr int NCONV = 29;
constexpr int N_EXP_ITEMS = 3 * 64 * 256;
struct ExpItem { const float* src; unsigned char* dst; int K, N, kb, nb, up; float scale; };
__device__ __forceinline__ ExpItem exp_item(const Frame& F, const Args& a, int r) {
    const int mat = r / (64 * 256), rr = r - mat * (64 * 256), e = rr >> 8, ii = rr & 255; ExpItem it;
    if (mat < 2) { it.src = (mat ? a.w_exp_up : a.w_exp_gate) + (size_t)e * DM * 512; it.dst = wsp<unsigned char>(F, W_GU) + (size_t)e * 1024 * 2048; it.K = DM; it.N = 512; it.up = mat; it.scale = SC_GU; it.kb = ii >> 3; it.nb = ii & 7; }
    else { it.src = a.w_exp_down + (size_t)e * 512 * DM; it.dst = wsp<unsigned char>(F, W_DN) + (size_t)e * 2048 * 512; it.K = 512; it.N = DM; it.up = -1; it.scale = SC_DN; it.kb = ii >> 5; it.nb = ii & 31; }
    return it;
}
#define EXP_LOAD(v, it) do { _Pragma("unroll") for (int i_ = 0; i_ < 16; ++i_) { const int kk_ = 4 * i_ + (F.lane >> 4); \
        v[i_] = __builtin_nontemporal_load((const GAS f32x4*)((it).src + (size_t)((it).kb * 64 + kk_) * (it).N + (it).nb * 64 + (F.lane & 15) * 4)); } } while (0)
#define EXP_STORE(v, it) do { _Pragma("unroll") for (int i_ = 0; i_ < 16; ++i_) { const int kk_ = 4 * i_ + (F.lane >> 4); const f32x4 t_ = v[i_] * (it).scale; \
            scr[kk_ * 17 + (F.lane & 15)] = pk4_fp8(t_[0], t_[1], t_[2], t_[3]); } \
        LDS_WAIT(); asm volatile("" ::: "memory"); \
        { const int c_ = F.lane & 7; _Pragma("unroll") for (int g_ = 0; g_ < 2; ++g_) { const int n4_ = (F.lane >> 3) + 8 * g_; unsigned d_[8]; \
            _Pragma("unroll") for (int j_ = 0; j_ < 8; ++j_) d_[j_] = scr[(8 * c_ + j_) * 17 + n4_]; \
            unsigned lo_[4], hi_[4]; \
            { const unsigned ta = __builtin_amdgcn_perm(d_[1], d_[0], 0x05010400u), tb = __builtin_amdgcn_perm(d_[1], d_[0], 0x07030602u), ua = __builtin_amdgcn_perm(d_[3], d_[2], 0x05010400u), ub = __builtin_amdgcn_perm(d_[3], d_[2], 0x07030602u); \
              lo_[0] = __builtin_amdgcn_perm(ua, ta, 0x05040100u); lo_[1] = __builtin_amdgcn_perm(ua, ta, 0x07060302u); lo_[2] = __builtin_amdgcn_perm(ub, tb, 0x05040100u); lo_[3] = __builtin_amdgcn_perm(ub, tb, 0x07060302u); } \
            { const unsigned ta = __builtin_amdgcn_perm(d_[5], d_[4], 0x05010400u), tb = __builtin_amdgcn_perm(d_[5], d_[4], 0x07030602u), ua = __builtin_amdgcn_perm(d_[7], d_[6], 0x05010400u), ub = __builtin_amdgcn_perm(d_[7], d_[6], 0x07030602u); \
              hi_[0] = __builtin_amdgcn_perm(ua, ta, 0x05040100u); hi_[1] = __builtin_amdgcn_perm(ua, ta, 0x07060302u); hi_[2] = __builtin_amdgcn_perm(ub, tb, 0x05040100u); hi_[3] = __builtin_amdgcn_perm(ub, tb, 0x07060302u); } \
            _Pragma("unroll") for (int q_ = 0; q_ < 4; ++q_) { const int n_ = (it).nb * 64 + 4 * n4_ + q_; const int row_ = (it).up < 0 ? n_ : row_gu(n_, (it).up); u32x2 o_; o_.x = lo_[q_]; o_.y = hi_[q_]; \
                __builtin_nontemporal_store(o_, (GAS u32x2*)((it).dst + (size_t)row_ * (it).K + (it).kb * 64 + 8 * c_)); } } } \
        LDS_WAIT(); asm volatile("" ::: "memory"); } while (0)
__device__ __forceinline__ void p_convert_experts(const Frame& F, const Args& a, int cw, int ncw, int i0, int i1) {
    __syncthreads();
    LAS unsigned* scr = (LAS unsigned*)(F.lds + F.wave * 4352);
    const int stride = ncw * NWAVES; int r = i0 + cw * NWAVES + F.wave;
    for (; r < i1; r += 2 * stride) {
        f32x4 v0[16], v1[16]; const int r1 = r + stride; const bool h1 = r1 < i1;
        const ExpItem it0 = exp_item(F, a, r), it1 = exp_item(F, a, h1 ? r1 : r);
        EXP_LOAD(v0, it0); if (h1) EXP_LOAD(v1, it1);
        __builtin_amdgcn_sched_barrier(0);
        EXP_STORE(v0, it0);
        if (h1) EXP_STORE(v1, it1);
    }
    __syncthreads();
}
#undef EXP_LOAD
#undef EXP_STORE

__device__ __forceinline__ void p1_h1(const Frame& F, const Args& a) {
    const int gw = F.vcu * NWAVES + F.wave, NGW = F.G * NWAVES;
    const float* mod = wsp<float>(F, WS_MOD); h16* h1 = wsp<h16>(F, A_H1);
    { float* gpa = wsp<float>(F, WS_GPA); float* gs = wsp<float>(F, WS_GS); float* gpf = wsp<float>(F, WS_GPF);
      for (int i = F.vcu * NTHR + F.tid; i < 4 * DM; i += F.G * NTHR) { const int b = i >> 11, c = i & (DM - 1);
          gpa[i] = a.attn_post_g[c] * mod[b * 12288 + 2 * 2048 + c]; gs[i] = a.ffn_pre_g[c] * (1.0f + mod[b * 12288 + 4 * 2048 + c]); gpf[i] = a.ffn_post_g[c] * mod[b * 12288 + 5 * 2048 + c]; } }
    f32x4 g[8];
#pragma unroll
    for (int j = 0; j < 8; ++j) g[j] = *(const f32x4*)(a.attn_pre_g + 4 * F.lane + 256 * j);
    for (int t = gw; t < NTOK; t += 2 * NGW) {
        const int t1 = (t + NGW < NTOK) ? t + NGW : t;
        f32x4 v[2][8];
#pragma unroll
        for (int z = 0; z < 2; ++z) { const GAS f32x4* xr = (const GAS f32x4*)(a.x + (size_t)(z ? t1 : t) * DM) + F.lane;
#pragma unroll
            for (int j = 0; j < 8; ++j) v[z][j] = xr[64 * j]; }
        f32x4 sc[8], sh[8]; const int b0 = t >> 12;
#pragma unroll
        for (int j = 0; j < 8; ++j) { const int c = 4 * F.lane + 256 * j; sc[j] = *(const f32x4*)(mod + b0 * 12288 + 2048 + c); sh[j] = *(const f32x4*)(mod + b0 * 12288 + c); }
        __builtin_amdgcn_sched_barrier(0);
#pragma unroll
        for (int z = 0; z < 2; ++z) { const int tt = z ? t1 : t, b = tt >> 12; float ss = 0.f;
            if (z == 1 && t1 == t) break;
            if (z == 1 && b != b0) {
#pragma unroll
                for (int j = 0; j < 8; ++j) { const int c = 4 * F.lane + 256 * j; sc[j] = *(const f32x4*)(mod + b * 12288 + 2048 + c); sh[j] = *(const f32x4*)(mod + b * 12288 + c); } }
#pragma unroll
            for (int j = 0; j < 8; ++j) ss += (v[z][j][0] * v[z][j][0] + v[z][j][1] * v[z][j][1]) + (v[z][j][2] * v[z][j][2] + v[z][j][3] * v[z][j][3]);
            const float rstd = 1.0f / sqrtf(wave_sum(ss) * (1.0f / DM) + EPS);
#pragma unroll
            for (int j = 0; j < 8; ++j) { const int c = 4 * F.lane + 256 * j;
                const f32x4 h = v[z][j] * rstd * g[j] * (sc[j] + 1.0f) + sh[j];
                *(GAS unsigned*)((unsigned char*)h1 + (size_t)tt * DM + c) = pk4_fp8(h[0], h[1], h[2], h[3]); } }
    }
}

__device__ __forceinline__ void p4_attention(const Frame& F) {
    const char* qm = (const char*)wsp<h16>(F, A_QM); const char* kv = (const char*)wsp<h16>(F, A_KV); const char* kr = (const char*)wsp<h16>(F, A_KR);
    const char* dil = (const char*)wsp<h16>(F, A_DIL); char* omla = (char*)wsp<h16>(F, A_OMLA); char* od = (char*)wsp<h16>(F, A_OD); float* lse = wsp<float>(F, WS_LSE);
#ifndef MK_REP4
#define MK_REP4 0
#endif
    _Pragma("unroll") for (int rep4a = 0; rep4a < (MK_REP4 == 1 ? 2 : 1); ++rep4a)
    for (int it = F.vcu; it < 256; it += F.G) {
        const int bh = it >> 3, x = it & 7, b = bh >> 3, h = bh & 7;
#pragma unroll 1
        for (int half = 0; half < 2; ++half) {
            const int qb = half ? 15 - x : x; const size_t tok0 = (size_t)b * SEQ;
            att::AUnit u;
            u.Q = qm + (tok0 + qb * 256) * 3072 + h * 256; u.qs = 3072; u.QR = qm + (tok0 + qb * 256) * 3072 + 2048 + h * 128;
            u.K = kv + tok0 * 4096 + h * 512; u.kvs = 4096; u.V = u.K + 256; u.KR = kr + tok0 * 128; u.krs = 128;
            u.O = omla + (tok0 + qb * 256) * 3072 + h * 256; u.os = 3072; u.LSE = nullptr; u.ls = 0;
            u.P0 = qb * 256; u.jlo = 0; u.jhi = qb * 4 + 4; u.W = 0x40000000u;
            att::attn_unit<true>(F.lds, u);
        }
    }
    _Pragma("unroll") for (int rep4b = 0; rep4b < (MK_REP4 == 2 ? 2 : 1); ++rep4b)
    for (int un = F.vcu; un < 768; un += F.G) {
        const int b = un / 192, rem = un - b * 192, head = rem >> 4, sub = rem & 15, g = head >> 2;
        const int d = (g == 0) ? 1 : (g == 1) ? 4 : 16; const int r = sub % d, jb = sub / d;
        const size_t tok0 = (size_t)b * SEQ + r; const unsigned rs = (unsigned)d * 9216u;
        att::AUnit u;
        u.Q = dil + (tok0 + (size_t)d * 256 * jb) * 9216 + head * 256; u.qs = rs; u.QR = nullptr;
        u.K = dil + tok0 * 9216 + 3072 + head * 256; u.kvs = rs; u.V = dil + tok0 * 9216 + 6144 + head * 256; u.KR = nullptr; u.krs = 0;
        u.O = od + (tok0 + (size_t)d * 256 * jb) * 3072 + head * 256; u.os = (unsigned)d * 3072u;
        u.LSE = lse + (tok0 + (size_t)d * 256 * jb) * 12 + head; u.ls = (unsigned)d * 12u;
        u.P0 = jb * 256; u.jlo = jb == 0 ? 0 : jb * 4 - 2; u.jhi = jb * 4 + 4; u.W = 129u;
        att::attn_unit<false>(F.lds, u);
    }
    __syncthreads();
}
__device__ __forceinline__ void p5_combine(const Frame& F) {
    const int gw = F.vcu * NWAVES + F.wave, NGW = F.G * NWAVES;
    const h16* od = wsp<h16>(F, A_OD); const float* lse = wsp<float>(F, WS_LSE); h16* odil = wsp<h16>(F, A_ODIL);
    for (int t = gw; t < NTOK; t += NGW) {
        const int hs = F.lane >> 4, dc = (F.lane & 15) * 8;
        const float l0 = lse[(size_t)t * 12 + hs], l1 = lse[(size_t)t * 12 + 4 + hs], l2 = lse[(size_t)t * 12 + 8 + hs];
        const float mx = fmaxf(l0, fmaxf(l1, l2));
        float w0 = __builtin_amdgcn_exp2f(l0 - mx), w1 = __builtin_amdgcn_exp2f(l1 - mx), w2 = __builtin_amdgcn_exp2f(l2 - mx);
        const float inv = 1.0f / (w0 + w1 + w2); w0 *= inv; w1 *= inv; w2 *= inv;
        f32x4 a0, a1, b0, b1, c0, c1;
        unpk8(*(const GAS u32x4*)(od + (size_t)t * 1536 + hs * 128 + dc), a0, a1);
        unpk8(*(const GAS u32x4*)(od + (size_t)t * 1536 + 512 + hs * 128 + dc), b0, b1);
        unpk8(*(const GAS u32x4*)(od + (size_t)t * 1536 + 1024 + hs * 128 + dc), c0, c1);
        const f32x4 r0 = a0 * w0 + b0 * w1 + c0 * w2, r1 = a1 * w0 + b1 * w1 + c1 * w2;
        *(GAS u32x4*)(odil + (size_t)t * 1536 + 1024 + hs * 128 + dc) = pk8(r0, r1);
    }
}

__device__ __forceinline__ void p8_router(const Frame& F, const Args& a) {
    constexpr int HP = 4128;
    LAS unsigned char* h2l = F.lds; LAS float* lg = (LAS float*)(F.lds + 32 * HP);
    LAS unsigned* lcnt = (LAS unsigned*)(F.lds + 32 * HP + 8192); LAS unsigned* lbase = lcnt + 64; LAS unsigned* rec = lbase + 64; LAS float* recw = (LAS float*)(rec + 192);
    if (F.tid < 64) lcnt[F.tid] = 0u;
    const float* mod = wsp<float>(F, WS_MOD); const float* gpa = wsp<float>(F, WS_GPA); const float* gs = wsp<float>(F, WS_GS); const h16* yat = wsp<h16>(F, A_YAT); unsigned char* h2 = wsp<unsigned char>(F, A_H2); const h16* wr_t = wsp<h16>(F, W_R);
    unsigned* cnt = wsp<unsigned>(F, WS_CTL) + CW_CNT; unsigned* list = wsp<unsigned>(F, WS_LIST); unsigned* tokpos = wsp<unsigned>(F, WS_TOKPOS); float* tokw = wsp<float>(F, WS_TOKW);
    h16* xmid = wsp<h16>(F, A_XMID);
    const int fr = F.lane & 15, fq = F.lane >> 4;
    for (int tb = F.vcu; tb < NTOK / 32; tb += F.G) {
        __syncthreads();
#ifndef MK_REP8
#define MK_REP8 0
#endif
#pragma unroll 1
        for (int q8 = 0; q8 < (MK_REP8 == 1 ? 8 : 4); q8 += 2) { const int q = q8 & 3;
            const int tl = F.wave * 4 + q, t = tb * 32 + tl, b = t >> 12;
            h16x4 yh[2][8]; f32x4 xv[2][8];
#pragma unroll
            for (int z = 0; z < 2; ++z)
#pragma unroll
                for (int j = 0; j < 8; ++j) { yh[z][j] = *(const GAS h16x4*)(yat + (size_t)(t + z) * DM + 4 * F.lane + 256 * j); xv[z][j] = *(const GAS f32x4*)(a.x + (size_t)(t + z) * DM + 4 * F.lane + 256 * j); }
            __builtin_amdgcn_sched_barrier(0);
            float ss[2] = {0.f, 0.f};
#pragma unroll
            for (int z = 0; z < 2; ++z)
#pragma unroll
                for (int j = 0; j < 8; ++j) { const float y0 = (float)yh[z][j][0], y1 = (float)yh[z][j][1], y2 = (float)yh[z][j][2], y3 = (float)yh[z][j][3]; ss[z] += (y0 * y0 + y1 * y1) + (y2 * y2 + y3 * y3); }
            const float r10 = 1.0f / sqrtf(wave_sum(ss[0]) * (1.0f / DM) + EPS), r11 = 1.0f / sqrtf(wave_sum(ss[1]) * (1.0f / DM) + EPS);
            float ss2[2] = {0.f, 0.f};
            int lo1 = 4 * F.lane; asm volatile("" : "+v"(lo1));
            f32x4 gpv[8], gsv[4], shv[4];
#pragma unroll
            for (int j = 0; j < 8; ++j) gpv[j] = *(const f32x4*)(gpa + b * 2048 + lo1 + 256 * j);
#pragma unroll
            for (int j = 0; j < 4; ++j) { gsv[j] = *(const f32x4*)(gs + b * 2048 + lo1 + 256 * j); shv[j] = *(const f32x4*)(mod + b * 12288 + 3 * 2048 + lo1 + 256 * j); }
            __builtin_amdgcn_sched_barrier(0);
#pragma unroll
            for (int j = 0; j < 8; ++j) { const int c = lo1 + 256 * j;
#pragma unroll
                for (int z = 0; z < 2; ++z) { const float r1 = z ? r11 : r10;
                    const f32x4 yv = (f32x4){(float)yh[z][j][0], (float)yh[z][j][1], (float)yh[z][j][2], (float)yh[z][j][3]};
                    const f32x4 xm = xv[z][j] + gpv[j] * (yv * r1);
                    { u32x2 wx; wx.x = pkh(xm[0], xm[1]); wx.y = pkh(xm[2], xm[3]); *(GAS u32x2*)(xmid + (size_t)(t + z) * DM + c) = wx; } xv[z][j] = xm;
                    ss2[z] += (xm[0] * xm[0] + xm[1] * xm[1]) + (xm[2] * xm[2] + xm[3] * xm[3]); } }
            const float r20 = 1.0f / sqrtf(wave_sum(ss2[0]) * (1.0f / DM) + EPS), r21 = 1.0f / sqrtf(wave_sum(ss2[1]) * (1.0f / DM) + EPS);
#pragma unroll
            for (int jh = 0; jh < 8; jh += 4) {
                f32x4 gs2[4], sh2[4];
                if (jh == 0) {
#pragma unroll
                    for (int j = 0; j < 4; ++j) { gs2[j] = gsv[j]; sh2[j] = shv[j]; }
                } else {
#pragma unroll
                    for (int j = 0; j < 4; ++j) { gs2[j] = *(const f32x4*)(gs + b * 2048 + lo1 + 256 * (4 + j)); sh2[j] = *(const f32x4*)(mod + b * 12288 + 3 * 2048 + lo1 + 256 * (4 + j)); }
                    __builtin_amdgcn_sched_barrier(0);
                }
#pragma unroll
                for (int jj = 0; jj < 4; ++jj) { const int j = jh + jj, c = lo1 + 256 * j;
#pragma unroll
                    for (int z = 0; z < 2; ++z) { const float r2 = z ? r21 : r20;
                        const f32x4 h = xv[z][j] * r2 * gs2[jj] + sh2[jj];
                        u32x2 w; w.x = pkh(h[0], h[1]); w.y = pkh(h[2], h[3]);
                        *(GAS unsigned*)(h2 + (size_t)(t + z) * DM + c) = pk4_fp8(h[0], h[1], h[2], h[3]);
                        *(LAS u32x2*)(h2l + (tl + z) * HP + c * 2) = w; } }
            }
        }
        __syncthreads();
        {
            const int et = F.wave & 3, kh = F.wave >> 2; f32x4 acc0 = (f32x4){0.f, 0.f, 0.f, 0.f}, acc1 = acc0;
            const LAS unsigned char* ap = h2l + fr * HP + fq * 16 + kh * 2048; const h16* bp = wr_t + (size_t)(et * 64 + kh * 32) * 512 + F.lane * 8;
#pragma unroll 1
            for (int kb = 0; kb < 32; kb += 16) {
                h16x8 bv[16];
#pragma unroll
                for (int i = 0; i < 16; ++i) bv[i] = *(const GAS h16x8*)(bp + (kb + i) * 512);
                __builtin_amdgcn_sched_barrier(0);
#pragma unroll
                for (int i = 0; i < 16; ++i) { const h16x8 a0 = *(const LAS h16x8*)(ap + (kb + i) * 64), a1 = *(const LAS h16x8*)(ap + 16 * HP + (kb + i) * 64);
                    acc0 = __builtin_amdgcn_mfma_f32_16x16x32_f16(a0, bv[i], acc0, 0, 0, 0); acc1 = __builtin_amdgcn_mfma_f32_16x16x32_f16(a1, bv[i], acc1, 0, 0, 0); }
                __builtin_amdgcn_sched_barrier(0);
            }
            __syncthreads();
            LAS float* pt = (LAS float*)h2l;
            if (kh == 1) {
#pragma unroll
                for (int j = 0; j < 4; ++j) { pt[(4 * fq + j) * 64 + et * 16 + fr] = acc0[j]; pt[(16 + 4 * fq + j) * 64 + et * 16 + fr] = acc1[j]; } }
            __syncthreads();
            if (kh == 0) {
#pragma unroll
                for (int j = 0; j < 4; ++j) { lg[(4 * fq + j) * 64 + et * 16 + fr] = acc0[j] + pt[(4 * fq + j) * 64 + et * 16 + fr]; lg[(16 + 4 * fq + j) * 64 + et * 16 + fr] = acc1[j] + pt[(16 + 4 * fq + j) * 64 + et * 16 + fr]; } }
        }
        __syncthreads();
#pragma unroll 1
        for (int q = 0; q < 4; ++q) {
            const int tl = F.wave * 4 + q, e = F.lane;
            const float score = sigmoidf_(lg[tl * 64 + e]); const float biased = score + a.router_bias[e];
            float m1 = biased;
            m1 = fmaxf(m1, __shfl_xor(m1, 1)); m1 = fmaxf(m1, __shfl_xor(m1, 2)); m1 = fmaxf(m1, __shfl_xor(m1, 4));
            const unsigned long long bal = __ballot(biased == m1); const unsigned gb = (unsigned)(bal >> (e & 56)) & 0xFFu; const int first = __builtin_ctz(gb);
            float v2 = ((e & 7) == first) ? -__builtin_inff() : biased;
            v2 = fmaxf(v2, __shfl_xor(v2, 1)); v2 = fmaxf(v2, __shfl_xor(v2, 2)); v2 = fmaxf(v2, __shfl_xor(v2, 4));
            const float gs = m1 + v2; const int g = e >> 3; int grank = 0;
#pragma unroll
            for (int g2 = 0; g2 < 8; ++g2) { const float s2 = __int_as_float(__builtin_amdgcn_readlane(__float_as_int(gs), g2 * 8)); grank += (s2 > gs || (s2 == gs && g2 < g)) ? 1 : 0; }
            const float sel = grank < 4 ? biased : -__builtin_inff(); int rank = 0;
#pragma unroll
            for (int e2 = 0; e2 < 64; ++e2) { const float s2 = __int_as_float(__builtin_amdgcn_readlane(__float_as_int(sel), e2)); rank += (s2 > sel || (s2 == sel && e2 < e)) ? 1 : 0; }
            const bool chosen = rank < TOPK;
            const float wsum = wave_sum(chosen ? score : 0.f);
            if (chosen) { const float w = score / (wsum + 1e-20f) * 2.5f;
                const unsigned sl = __hip_atomic_fetch_add(lcnt + e, 1u, __ATOMIC_RELAXED, __HIP_MEMORY_SCOPE_WORKGROUP);
                rec[tl * 6 + rank] = ((unsigned)e << 20) | sl; recw[tl * 6 + rank] = w; }
        }
        __syncthreads();
        if (F.tid < 64) { const unsigned n = lcnt[F.tid]; lbase[F.tid] = n ? __hip_atomic_fetch_add(cnt + 64 * F.tid, n, __ATOMIC_RELAXED, __HIP_MEMORY_SCOPE_AGENT) : 0u; lcnt[F.tid] = 0u; }
        __syncthreads();
        if (F.tid < 192) { const int tl = F.tid / 6, r = F.tid - tl * 6, t = tb * 32 + tl; const unsigned rc = rec[F.tid]; const unsigned e = rc >> 20, slot = lbase[e] + (rc & 0xFFFFFu);
            list[(size_t)e * LISTCAP + slot] = (unsigned)t; tokpos[(size_t)t * 6 + r] = (e << 20) | slot; tokw[(size_t)t * 6 + r] = recw[F.tid]; }
    }
}

__device__ __forceinline__ void p11_final(const Frame& F, const Args& a) {
    const int gw = F.vcu * NWAVES + F.wave, NGW = F.G * NWAVES;
    const LAS int* tstart = (const LAS int*)(F.lds + LDS_TAB);
    const h16* xmid = wsp<h16>(F, A_XMID);
    const float* mod = wsp<float>(F, WS_MOD); const unsigned char* ys = wsp<unsigned char>(F, A_YS); const unsigned* tokpos = wsp<unsigned>(F, WS_TOKPOS); const float* tokw = wsp<float>(F, WS_TOKW);
#define P11_META(t_, PR, W_) do { PR = 0; W_ = 0.f; \
        if (F.lane < 6) { const unsigned p_ = tokpos[(size_t)(t_) * 6 + F.lane]; PR = (unsigned)tstart[p_ >> 20] * 256u + (p_ & 0xFFFFFu); W_ = tokw[(size_t)(t_) * 6 + F.lane]; } \
        if (F.lane == 6) { PR = (unsigned)tstart[64] * 256u + (unsigned)(t_); W_ = 1.0f; } } while (0)
#define P11_ROWS(t_, PR) do { _Pragma("unroll") for (int k = 0; k < 7; ++k) { const unsigned pr = __shfl(PR, k); \
            _Pragma("unroll") for (int j = 0; j < 4; ++j) raw[k][j] = *(const GAS u32x2*)(ys + (size_t)pr * DM + 8 * F.lane + 512 * j); } \
        _Pragma("unroll") for (int j = 0; j < 4; ++j) xraw[j] = *(const GAS u32x4*)(xmid + (size_t)(t_) * DM + 8 * F.lane + 512 * j); } while (0)
    u32x2 raw[7][4]; u32x4 xraw[4]; unsigned prow = 0, prow_n = 0, prow_nn = 0; float w = 0.f, w_n = 0.f, w_nn = 0.f;
    f32x4 pf[8]; const float* gpf = wsp<float>(F, WS_GPF);
    int t = gw;
    if (t < NTOK) { P11_META(t, prow, w); P11_ROWS(t, prow);
#pragma unroll
        for (int j = 0; j < 8; ++j) { const int c = 8 * F.lane + 512 * (j >> 1) + 4 * (j & 1); pf[j] = *(const f32x4*)(gpf + (t >> 12) * 2048 + c); }
        if (t + NGW < NTOK) P11_META(t + NGW, prow_n, w_n); }
    while (t < NTOK) {
        const int tn = t + NGW, tnn = tn + NGW;
        __builtin_amdgcn_sched_barrier(0);
        f32x4 acc[8], xm[8];
#pragma unroll
        for (int j = 0; j < 8; ++j) acc[j] = (f32x4){0.f, 0.f, 0.f, 0.f};
#pragma unroll
        for (int k = 0; k < 7; ++k) { const float wk = __shfl(w, k);
#pragma unroll
            for (int j = 0; j < 4; ++j) { const f32x2 a0 = __builtin_amdgcn_cvt_pk_f32_fp8((int)raw[k][j].x, false), a1 = __builtin_amdgcn_cvt_pk_f32_fp8((int)raw[k][j].x, true),
                                                      b0 = __builtin_amdgcn_cvt_pk_f32_fp8((int)raw[k][j].y, false), b1 = __builtin_amdgcn_cvt_pk_f32_fp8((int)raw[k][j].y, true);
                acc[2 * j] += (f32x4){a0[0], a0[1], a1[0], a1[1]} * wk; acc[2 * j + 1] += (f32x4){b0[0], b0[1], b1[0], b1[1]} * wk; } }
#pragma unroll
        for (int j = 0; j < 4; ++j) unpk8(xraw[j], xm[2 * j], xm[2 * j + 1]);
        float ss = 0.f;
#pragma unroll
        for (int j = 0; j < 8; ++j) ss += (acc[j][0] * acc[j][0] + acc[j][1] * acc[j][1]) + (acc[j][2] * acc[j][2] + acc[j][3] * acc[j][3]);
        const float rstd = 1.0f / sqrtf(wave_sum(ss) * (1.0f / DM) + EPS);
#pragma unroll
        for (int j = 0; j < 8; ++j) xm[j] = xm[j] + pf[j] * (acc[j] * rstd);
        __builtin_amdgcn_sched_barrier(0);
        if (tn < NTOK) { P11_ROWS(tn, prow_n);
#pragma unroll
            for (int j = 0; j < 8; ++j) { const int c = 8 * F.lane + 512 * (j >> 1) + 4 * (j & 1); pf[j] = *(const f32x4*)(gpf + (tn >> 12) * 2048 + c); }
            if (tnn < NTOK) P11_META(tnn, prow_nn, w_nn); }
        __builtin_amdgcn_sched_barrier(0);
#pragma unroll
        for (int j = 0; j < 8; ++j) { const int c = 8 * F.lane + 512 * (j >> 1) + 4 * (j & 1); *(GAS f32x4*)(a.out + (size_t)t * DM + c) = xm[j]; }
        t = tn; prow = prow_n; w = w_n; prow_n = prow_nn; w_n = w_nn;
    }
#undef P11_META
#undef P11_ROWS
}

constexpr int NPHASE = 12;
__global__ void __launch_bounds__(NTHR, 2) mk_fwd(Args args) {
    extern __shared__ __attribute__((aligned(16))) unsigned char lds_raw[];
    Frame F;
    F.lds = (LAS unsigned char*)lds_raw;
    F.tid = threadIdx.x; F.lane = F.tid & 63; F.wave = __builtin_amdgcn_readfirstlane(F.tid >> 6);
    F.G = gridDim.x; { const int bx = blockIdx.x; F.vcu = (F.G % 8 == 0) ? (bx % 8) * (F.G / 8) + bx / 8 : bx; }
    F.ws = args.ws;
    unsigned* ctl = (unsigned*)(args.ws + WS_CTL);
    const int lo = args.ph_lo, hi = args.ph_hi;
    if (F.tid < 16) ((LAS unsigned*)(F.lds + LDS_MISC))[F.tid] = 0u;
    __syncthreads();
    XcdBarrier bar; bar.bar = ctl + CW_BAR; bar.x = 0; bar.st = nullptr;
    if (hi - lo > 1) bar = xcd_barrier_post(ctl + CW_BAR, (volatile LAS unsigned*)(F.lds + LDS_MISC));
#ifndef MK_ONLY
#define MK_ONLY -1
#endif
#define IN(k) ((MK_ONLY < 0 || (k) == MK_ONLY) && lo <= (k) && (k) < hi)
#ifndef MK_TP
#define MK_TP -1
#endif
#ifndef MK_TK
#define MK_TK 8
#endif
    unsigned long long tp_prev = 0ull, tp_dt = 0ull;
    if (MK_TP >= 0 && blockIdx.x == 0 && F.tid == 0) tp_prev = wall_clock64();
    const unsigned long long tp_start = tp_prev;
#define SEAM(k) do { if (IN(k) && IN((k) + 1)) xcd_barrier(bar); \
        if (MK_TP >= 0 && blockIdx.x == 0 && F.tid == 0) { const unsigned long long now_ = wall_clock64(); if ((k) == MK_TP) tp_dt = now_ - tp_prev; tp_prev = now_; } } while (0)
#ifndef MK_REP
#define MK_REP -1
#endif
#define REPS(k) _Pragma("unroll") for (int rep_ = 0; rep_ < ((k) == MK_REP ? 2 : 1); ++rep_)

    if (IN(0)) REPS(0) { p0_prologue(F, args); } SEAM(0);
    if (IN(1)) REPS(1) { p1_h1(F, args); } SEAM(1);
    const bool split = F.G > 4 * NCONV; const int GG = split ? F.G - NCONV : F.G; const bool conv = split && (int)blockIdx.x >= GG; const int cw = (int)blockIdx.x - GG;
    constexpr int CONV_DEF = (N_EXP_ITEMS / 100) * 33, CONV_CUT = (N_EXP_ITEMS / 100) * 26;
    if (IN(0)) p_convert_experts(F, args, F.vcu, F.G, split ? CONV_DEF : 0, N_EXP_ITEMS);
    if (IN(2)) REPS(2) {
        if (conv) p_convert_experts(F, args, cw, NCONV, 0, CONV_CUT);
        else {
        pg8::StaticOrder S; S.init(wsp<h16>(F, A_H1), DM / 2, wsp<h16>(F, W_IN), DM / 2, NPROJ, GG, (int)blockIdx.x);
        EpiIn E{wsp<h16>(F, A_QA), wsp<h16>(F, A_KR), wsp<h16>(F, A_DIL), wsp<h16>(F, A_GATE), wsp<float>(F, WS_ROWSQ), wsp<float>(F, WS_COSD), wsp<float>(F, WS_SIND), wsp<float>(F, WS_COSM), wsp<float>(F, WS_SINM)};
        pg8::gemm_phase<EpiIn, pg8::StaticOrder, false, true>(F.lds, DM / 2, DM / 2, S, E);
        }
    } SEAM(2);
    if (IN(3)) REPS(3) {
        if (conv) p_convert_experts(F, args, cw, NCONV, CONV_CUT, CONV_DEF);
        else {
        UpOrder S{(const char*)wsp<h16>(F, A_QA), (const char*)wsp<h16>(F, W_QUP), (const char*)wsp<h16>(F, W_KVUP), GG, split ? (int)blockIdx.x : F.vcu};
        EpiUp E{wsp<h16>(F, A_QM), wsp<h16>(F, A_KV), wsp<float>(F, WS_ROWSQ), wsp<float>(F, WS_COSM), wsp<float>(F, WS_SINM)};
        pg8::gemm_phase<EpiUp, UpOrder, false>(F.lds, 512, 1024, S, E);
        }
    } SEAM(3);
    if (IN(4)) REPS(4) { p4_attention(F); } SEAM(4);
    if (IN(5)) REPS(5) { p5_combine(F); } SEAM(5);
    if (IN(6)) REPS(6) {
        pg8::StaticOrder S; S.init(wsp<h16>(F, A_CAT), 1536, wsp<h16>(F, W_MO), 1536, DM, F.G, (int)blockIdx.x);
        EpiMerge E{wsp<h16>(F, A_MRG), wsp<h16>(F, A_GATE)};
        pg8::gemm_phase<EpiMerge, pg8::StaticOrder, false>(F.lds, 1536, 1536, S, E);
    } SEAM(6);
    if (IN(7)) REPS(7) {
        pg8::StaticOrder S; S.init(wsp<h16>(F, A_MRG), DM / 2, wsp<h16>(F, W_OUT), DM / 2, DM, F.G, (int)blockIdx.x);
        EpiOut<0> E{wsp<h16>(F, A_YAT), DM, nullptr, 0, nullptr, 1.0f};
        pg8::gemm_phase<EpiOut<0>, pg8::StaticOrder, false, true>(F.lds, DM / 2, DM / 2, S, E);
    } SEAM(7);
    if (IN(8)) { p8_router(F, args);
        if (MK_REP == 8) { xcd_barrier(bar); if (blockIdx.x == 0 && F.tid < 64) (ctl + CW_CNT)[64 * F.tid] = 0u; xcd_barrier(bar); p8_router(F, args); }
        if (MK_REP == 100) { for (int i = 0; i < 10; ++i) xcd_barrier(bar); }
    } SEAM(8);
    if (IN(9)) REPS(9) {
        moe_tables(F, ctl + CW_CNT);
        MoeOrder<4, true> S{(const LAS int*)(F.lds + LDS_TAB), (const LAS int*)(F.lds + LDS_TAB + 512), (const LAS int*)(F.lds + LDS_TAB + 1024),
                            (const char*)wsp<h16>(F, A_H2), (const char*)wsp<h16>(F, W_GU), wsp<unsigned>(F, WS_LIST), F.G, F.vcu};
        EpiSwiglu E{wsp<unsigned char>(F, A_ACT)};
        S.fill_rows(F.tid);
        pg8::gemm_phase<EpiSwiglu, MoeOrder<4, true>, true, true>(F.lds, DM / 2, DM / 2, S, E);
    } SEAM(9);
    if (IN(10)) REPS(10) {
        if (!IN(9)) moe_tables(F, ctl + CW_CNT);
        MoeOrder<8, false> S{(const LAS int*)(F.lds + LDS_TAB), (const LAS int*)(F.lds + LDS_TAB + 512), (const LAS int*)(F.lds + LDS_TAB + 1024),
                             (const char*)wsp<h16>(F, A_ACT), (const char*)wsp<h16>(F, W_DN), wsp<unsigned>(F, WS_LIST), F.G, F.vcu};
        EpiOut<3> E{wsp<h16>(F, A_YS), DM, nullptr, 0, nullptr, 1.0f};
        pg8::gemm_phase<EpiOut<3>, MoeOrder<8, false>, false, true>(F.lds, 256, 256, S, E);
    } SEAM(10);
    if (IN(11)) REPS(11) { if (!IN(10)) moe_tables(F, ctl + CW_CNT); p11_final(F, args); }
    if (MK_TP >= 12 && hi - lo > 1) xcd_barrier(bar);
    if (MK_TP >= 0 && blockIdx.x == 0 && F.tid == 0) {
        if (MK_TP == 11 || MK_TP == 12) { VM_WAIT(); tp_dt = wall_clock64() - tp_prev; }
        if (MK_TP == 13) { VM_WAIT(); tp_dt = wall_clock64() - tp_start; }
        const unsigned long long t0_ = wall_clock64();
        while (wall_clock64() - t0_ < tp_dt * MK_TK) __builtin_amdgcn_s_sleep(8);
    }
#undef IN
#undef SEAM
}

#if MK_DIAG
constexpr size_t WS_SAVE = 15 * MiB;
__device__ __forceinline__ unsigned hsh(unsigned a) { a ^= a >> 16; a *= 0x7feb352dU; a ^= a >> 15; a *= 0x846ca68bU; a ^= a >> 16; return a; }
__device__ __forceinline__ void dg_put(unsigned* ctl, int slot, float got, float want, float atol) {
    float e = fabsf(got - want) / (fabsf(want) + atol); if (!(e < 1e30f)) e = 1e30f;
    atomicMax(ctl + CW_DIAG + slot, __float_as_uint(e));
}
__device__ __forceinline__ float dg_dot(const h16* arow, const float* W, int K, int ldw, int col) { float s = 0.f; for (int k = 0; k < K; ++k) s += (float)arow[k] * W[(size_t)k * ldw + col]; return s; }
__device__ __forceinline__ void dg_cs(float ang, float& c, float& s_) { const double a = (double)ang; const double tw = 6.283185307179586476925; const double r = a - tw * floor(a / tw); c = cosf((float)r); s_ = sinf((float)r); }
__device__ __forceinline__ int dg_tstart(const unsigned* cnt, int e) { int s = 0; for (int j = 0; j < e; ++j) s += ((j < 64 ? (int)cnt[64 * j] : NTOK) + 255) >> 8; return s; }
__global__ void __launch_bounds__(256) diag_check(Args a, int phase) {
    unsigned char* ws = a.ws; unsigned* ctl = (unsigned*)(ws + WS_CTL);
    const int gid = blockIdx.x * 256 + threadIdx.x; const unsigned h0 = hsh(gid * 7919u + phase * 104729u + 12345u), h1v = hsh(h0 + 1u), h2v = hsh(h0 + 2u);
    const float* mod = (const float*)(ws + WS_MOD);
    __shared__ float red[256 * 6]; __shared__ float sc64[64]; __shared__ float bs64[64];
    if (phase == 0) {
        if (gid < 512) { const int b = h0 & 3, j = h1v % 12288; float s = 0.f; for (int k = 0; k < DM; ++k) { const float v = a.c[b * DM + k]; s += v / (1.f + expf(-v)) * a.w_ada[(size_t)k * 12288 + j]; }
            dg_put(ctl, 0, mod[b * 12288 + j], s + a.b_ada[j], 0.02f); }
        else if (gid < 4096) { const int which = h0 % 9; const int e = h1v & 63; float got, want;
            if (which == 0) { const int k = h2v % DM, n = hsh(h2v) % 9792; got = (float)((const h16*)(ws + W_IN))[(size_t)row_in(n) * DM + k]; want = a.w_in[(size_t)k * 9792 + n]; }
            else if (which == 1) { const int k = h2v % 512, n = hsh(h2v) % 1536; got = (float)((const h16*)(ws + W_QUP))[(size_t)row_qup(n) * 512 + k]; want = a.w_q_up[(size_t)k * 1536 + n] * a.q_a_norm_g[k]; }
            else if (which == 2) { const int k = h2v % 512, n = hsh(h2v) % 2048; got = (float)((const h16*)(ws + W_KVUP))[(size_t)n * 512 + k]; want = a.w_kv_up[(size_t)k * 2048 + n] * a.kv_a_norm_g[k]; }
            else if (which == 3) { const int k = h2v % 1024, n = hsh(h2v) % 2048; got = (float)((const h16*)(ws + W_MO))[(size_t)n * 1024 + k]; want = a.w_mla_o[(size_t)k * 2048 + n]; }
            else if (which == 4) { const int k = h2v % 512, n = hsh(h2v) % 2048; got = (float)((const h16*)(ws + W_DO))[(size_t)n * 512 + k]; want = a.w_dil_o[(size_t)k * 2048 + n]; }
            else if (which == 5) { const int k = h2v % DM, n = hsh(h2v) % 2048; got = (float)((const h16*)(ws + W_OUT))[(size_t)n * DM + k]; want = a.w_out[(size_t)k * DM + n]; }
            else if (which == 6) { const int k = h2v % DM, n = hsh(h2v) % 64; got = (float)((const h16*)(ws + W_R))[(size_t)n * DM + k]; want = a.w_router[(size_t)k * 64 + n]; }
            else if (which == 7) { const int k = h2v % DM, n = hsh(h2v) % 512, up = (h2v >> 20) & 1; const int ee = (h1v % 65);
                got = (float)((const h16*)(ws + W_GU))[((size_t)ee * 1024 + (n >> 7) * 256 + up * 128 + (n & 127)) * DM + k];
                const float* src = ee < 64 ? (up ? a.w_exp_up : a.w_exp_gate) + (size_t)ee * DM * 512 : (up ? a.w_sh_up : a.w_sh_gate); want = src[(size_t)k * 512 + n]; }
            else { const int k = h2v % 512, n = hsh(h2v) % DM; const int ee = (h1v % 65);
                got = (float)((const h16*)(ws + W_DN))[((size_t)ee * 2048 + n) * 512 + k]; const float* src = ee < 64 ? a.w_exp_down + (size_t)ee * 512 * DM : a.w_sh_down; want = src[(size_t)k * DM + n]; }
            (void)e; dg_put(ctl, 0, got, want, 1e-3f); }
        else if (gid < 8192) { const int t = h0 % NTOK, j = h1v % 48; const float pf = (float)a.pos[t]; float c, s_;
            if (j < 16) { dg_cs(pf * a.invf_d[j], c, s_); dg_put(ctl, 0, ((const float*)(ws + WS_COSD))[t * 16 + j], c, 0.05f); dg_put(ctl, 0, ((const float*)(ws + WS_SIND))[t * 16 + j], s_, 0.05f); }
            else { dg_cs(pf * a.invf_m[j - 16], c, s_); dg_put(ctl, 0, ((const float*)(ws + WS_COSM))[t * 32 + j - 16], c, 0.05f); dg_put(ctl, 0, ((const float*)(ws + WS_SINM))[t * 32 + j - 16], s_, 0.05f); } }
    } else if (phase == 1) {
        if (gid < 2048) { const int t = h0 % NTOK, c = h1v % DM, b = t >> 12; float ss = 0.f; for (int k = 0; k < DM; ++k) { const float v = a.x[(size_t)t * DM + k]; ss += v * v; }
            const float rstd = 1.f / sqrtf(ss / DM + EPS); const float want = a.x[(size_t)t * DM + c] * rstd * a.attn_pre_g[c] * (1.f + mod[b * 12288 + 2048 + c]) + mod[b * 12288 + c];
            dg_put(ctl, 1, (float)((const h16*)(ws + A_H1))[(size_t)t * DM + c], want, 0.05f); }
    } else if (phase == 2) {
        const h16* h1 = (const h16*)(ws + A_H1);
        if (gid < 4096) { const int t = h0 % NTOK; int c = h1v % 9792; const h16* ar = h1 + (size_t)t * DM; const float pf = (float)a.pos[t]; float got, want;
            if (c < 1024) { want = dg_dot(ar, a.w_in, DM, 9792, c); got = (float)((const h16*)(ws + A_QA))[(size_t)t * 1024 + c]; }
            else if (c < 1088) { const int i = (c - 1024) & 31, second = (c - 1024) >> 5; const float t1 = dg_dot(ar, a.w_in, DM, 9792, 1024 + i), t2 = dg_dot(ar, a.w_in, DM, 9792, 1024 + 32 + i);
                float cs, sn; dg_cs(pf * a.invf_m[i], cs, sn); want = second ? t2 * cs + t1 * sn : t1 * cs - t2 * sn; got = (float)((const h16*)(ws + A_KR))[(size_t)t * 64 + 2 * i + second]; }
            else if (c < 5696) { const int dc = c - 1088, part = dc / 1536, hd = (dc % 1536) >> 7, dim = dc & 127;
                if (part < 2 && dim < 32) { const int i = dim & 15, second = dim >> 4; const int cb = c - dim; const float t1 = dg_dot(ar, a.w_in, DM, 9792, cb + i), t2 = dg_dot(ar, a.w_in, DM, 9792, cb + 16 + i);
                    float cs, sn; dg_cs(pf * a.invf_d[i], cs, sn); want = second ? t2 * cs + t1 * sn : t1 * cs - t2 * sn; if (part == 0) want *= QS_D;
                    got = (float)((const h16*)(ws + A_DIL))[(size_t)t * 4608 + part * 1536 + hd * 128 + 2 * i + second]; }
                else { want = dg_dot(ar, a.w_in, DM, 9792, c); if (part == 0) want *= QS_D; got = (float)((const h16*)(ws + A_DIL))[(size_t)t * 4608 + dc]; } }
            else { want = 1.f / (1.f + expf(-dg_dot(ar, a.w_in, DM, 9792, c))); got = (float)((const h16*)(ws + A_GATE))[(size_t)t * 4096 + (c - 5696)]; }
            dg_put(ctl, 2, got, want, 0.05f); }
        else if (gid < 4608) { const int t = h0 % NTOK, which = h1v & 1; const h16* qa = (const h16*)(ws + A_QA) + (size_t)t * 1024 + which * 512; float ss = 0.f; for (int k = 0; k < 512; ++k) ss += (float)qa[k] * (float)qa[k];
            const float* rq = (const float*)(ws + WS_ROWSQ) + (size_t)t * 16 + which * 8; float g = 0.f; for (int k = 0; k < 8; ++k) g += rq[k]; dg_put(ctl, 2, g, ss, 1.0f); }
    } else if (phase == 3) {
        if (gid < 4096) { const int t = h0 % NTOK, which = h1v & 1; const h16* qa = (const h16*)(ws + A_QA) + (size_t)t * 1024 + which * 512; const float pf = (float)a.pos[t];
            float ss = 0.f; for (int k = 0; k < 512; ++k) ss += (float)qa[k] * (float)qa[k]; const float rstd = 1.f / sqrtf(ss / 512.f + EPS); float got, want;
            if (which == 0) { const int cq = h2v % 1536, hd = cq / 192, j = cq % 192;
                if (j < 128) { float s_ = 0.f; for (int k = 0; k < 512; ++k) s_ += (float)qa[k] * rstd * a.q_a_norm_g[k] * a.w_q_up[(size_t)k * 1536 + cq]; want = s_ * QS_M; got = (float)((const h16*)(ws + A_QM))[(size_t)t * 1536 + hd * 128 + j]; }
                else { const int i = (j - 128) & 31, second = (j - 128) >> 5; float t1 = 0.f, t2 = 0.f;
                    for (int k = 0; k < 512; ++k) { const float nv = (float)qa[k] * rstd * a.q_a_norm_g[k]; t1 += nv * a.w_q_up[(size_t)k * 1536 + hd * 192 + 128 + i]; t2 += nv * a.w_q_up[(size_t)k * 1536 + hd * 192 + 160 + i]; }
                    float cs, sn; dg_cs(pf * a.invf_m[i], cs, sn); want = (second ? t2 * cs + t1 * sn : t1 * cs - t2 * sn) * QS_M; got = (float)((const h16*)(ws + A_QM))[(size_t)t * 1536 + 1024 + hd * 64 + 2 * i + second]; } }
            else { const int c = h2v % 2048; float s_ = 0.f; for (int k = 0; k < 512; ++k) s_ += (float)qa[k] * rstd * a.kv_a_norm_g[k] * a.w_kv_up[(size_t)k * 2048 + c]; want = s_; got = (float)((const h16*)(ws + A_KV))[(size_t)t * 2048 + c]; }
            dg_put(ctl, 3, got, want, 0.05f); }
    } else if (phase == 4) {
        const unsigned hb = hsh(blockIdx.x * 2654435761u + 777u); const int t = hb % NTOK, b = t >> 12, sp = t & 4095; const int tid = threadIdx.x;
        float m = -1e30f, l = 0.f, o0 = 0.f, o1 = 0.f, o2 = 0.f, o3 = 0.f; const int dsel = (hb >> 16) & 31;
        if (blockIdx.x < 96) { const int hd = (hb >> 21) & 7; const h16* q = (const h16*)(ws + A_QM) + (size_t)t * 1536;
            for (int kp = tid; kp <= sp; kp += 256) { const size_t tk = (size_t)b * SEQ + kp; const h16* kk = (const h16*)(ws + A_KV) + tk * 2048 + hd * 256; const h16* kr = (const h16*)(ws + A_KR) + tk * 64;
                float s_ = 0.f; for (int d = 0; d < 128; ++d) s_ += (float)q[hd * 128 + d] * (float)kk[d]; for (int d = 0; d < 64; ++d) s_ += (float)q[1024 + hd * 64 + d] * (float)kr[d];
                const float mn = fmaxf(m, s_), al = exp2f(m - mn), pp = exp2f(s_ - mn); l = l * al + pp; o0 = o0 * al + pp * (float)kk[128 + dsel]; o1 = o1 * al + pp * (float)kk[128 + dsel + 32]; o2 = o2 * al + pp * (float)kk[128 + dsel + 64]; o3 = o3 * al + pp * (float)kk[128 + dsel + 96]; m = mn; }
        } else { const int head = (hb >> 21) % 12, g = head >> 2, dd = g == 0 ? 1 : g == 1 ? 4 : 16; const h16* q = (const h16*)(ws + A_DIL) + (size_t)t * 4608 + head * 128;
            for (int j = tid; j <= 128; j += 256) { const int kp = sp - dd * j; if (kp < 0) continue; const size_t tk = (size_t)b * SEQ + kp; const h16* kk = (const h16*)(ws + A_DIL) + tk * 4608 + 1536 + head * 128; const h16* vv = (const h16*)(ws + A_DIL) + tk * 4608 + 3072 + head * 128;
                float s_ = 0.f; for (int d = 0; d < 128; ++d) s_ += (float)q[d] * (float)kk[d];
                const float mn = fmaxf(m, s_), al = exp2f(m - mn), pp = exp2f(s_ - mn); l = l * al + pp; o0 = o0 * al + pp * (float)vv[dsel]; o1 = o1 * al + pp * (float)vv[dsel + 32]; o2 = o2 * al + pp * (float)vv[dsel + 64]; o3 = o3 * al + pp * (float)vv[dsel + 96]; m = mn; } }
        red[tid * 6 + 0] = m; red[tid * 6 + 1] = l; red[tid * 6 + 2] = o0; red[tid * 6 + 3] = o1; red[tid * 6 + 4] = o2; red[tid * 6 + 5] = o3; __syncthreads();
        if (tid == 0) { float M = -1e30f; for (int i = 0; i < 256; ++i) M = fmaxf(M, red[i * 6]); float L = 0.f, O0 = 0.f, O1 = 0.f, O2 = 0.f, O3 = 0.f;
            for (int i = 0; i < 256; ++i) { const float w = exp2f(red[i * 6] - M); L += red[i * 6 + 1] * w; O0 += red[i * 6 + 2] * w; O1 += red[i * 6 + 3] * w; O2 += red[i * 6 + 4] * w; O3 += red[i * 6 + 5] * w; }
            if (blockIdx.x < 96) { const int hd = (hb >> 21) & 7; const h16* og = (const h16*)(ws + A_OMLA) + (size_t)t * 1024 + hd * 128;
                dg_put(ctl, 4, (float)og[dsel], O0 / L, 0.02f); dg_put(ctl, 4, (float)og[dsel + 32], O1 / L, 0.02f); dg_put(ctl, 4, (float)og[dsel + 64], O2 / L, 0.02f); dg_put(ctl, 4, (float)og[dsel + 96], O3 / L, 0.02f); }
            else { const int head = (hb >> 21) % 12; const h16* og = (const h16*)(ws + A_OD) + (size_t)t * 1536 + head * 128;
                dg_put(ctl, 5, (float)og[dsel], O0 / L, 0.02f); dg_put(ctl, 5, (float)og[dsel + 32], O1 / L, 0.02f); dg_put(ctl, 5, (float)og[dsel + 64], O2 / L, 0.02f); dg_put(ctl, 5, (float)og[dsel + 96], O3 / L, 0.02f);
                dg_put(ctl, 5, ((const float*)(ws + WS_LSE))[(size_t)t * 12 + head], M + log2f(L), 0.5f); } }
    } else if (phase == 5) {
        if (gid < 2048) { const int t = h0 % NTOK, n = h1v % DM; const float want = dg_dot((const h16*)(ws + A_OMLA) + (size_t)t * 1024, a.w_mla_o, 1024, DM, n) * (float)((const h16*)(ws + A_GATE))[(size_t)t * 4096 + n];
            dg_put(ctl, 6, (float)((const h16*)(ws + A_M1))[(size_t)t * DM + n], want, 0.05f); }
        else if (gid < 4096) { const int t = h0 % NTOK, hs = h1v & 3, d = h2v & 127; const float* ls = (const float*)(ws + WS_LSE) + (size_t)t * 12; const h16* od = (const h16*)(ws + A_OD) + (size_t)t * 1536;
            const float mx = fmaxf(ls[hs], fmaxf(ls[4 + hs], ls[8 + hs])); const float w0 = exp2f(ls[hs] - mx), w1 = exp2f(ls[4 + hs] - mx), w2 = exp2f(ls[8 + hs] - mx);
            const float want = (w0 * (float)od[hs * 128 + d] + w1 * (float)od[512 + hs * 128 + d] + w2 * (float)od[1024 + hs * 128 + d]) / (w0 + w1 + w2);
            dg_put(ctl, 7, (float)((const h16*)(ws + A_ODIL))[(size_t)t * 512 + hs * 128 + d], want, 0.02f); }
    } else if (phase == 6) {
        if (gid < 2048) { const int t = h0 % NTOK, n = h1v % DM; const float want = (float)((const h16*)(ws + A_M1))[(size_t)t * DM + n] + dg_dot((const h16*)(ws + A_ODIL) + (size_t)t * 512, a.w_dil_o, 512, DM, n) * (float)((const h16*)(ws + A_GATE))[(size_t)t * 4096 + 2048 + n];
            dg_put(ctl, 8, (float)((const h16*)(ws + A_MRG))[(size_t)t * DM + n], want, 0.05f); }
    } else if (phase == 7) {
        if (gid < 2048) { const int t = h0 % NTOK, n = h1v % DM; const float want = dg_dot((const h16*)(ws + A_MRG) + (size_t)t * DM, a.w_out, DM, DM, n);
            dg_put(ctl, 9, (float)((const h16*)(ws + A_YAT))[(size_t)t * DM + n], want, 0.05f); }
    } else if (phase == 8) {
        if (gid < 1024) { const int t = h0 % NTOK, c = h1v % DM, b = t >> 12; const h16* y = (const h16*)(ws + A_YAT) + (size_t)t * DM; float ss = 0.f; for (int k = 0; k < DM; ++k) ss += (float)y[k] * (float)y[k];
            const float r1 = 1.f / sqrtf(ss / DM + EPS); float ss2 = 0.f, xc = 0.f;
            for (int k = 0; k < DM; ++k) { const float xm = a.x[(size_t)t * DM + k] + mod[b * 12288 + 4096 + k] * ((float)y[k] * r1 * a.attn_post_g[k]); ss2 += xm * xm; if (k == c) xc = xm; }
            const float r2 = 1.f / sqrtf(ss2 / DM + EPS);
            dg_put(ctl, 10, a.out[(size_t)t * DM + c], xc, 0.05f);
            dg_put(ctl, 10, (float)((const h16*)(ws + A_H2))[(size_t)t * DM + c], xc * r2 * a.ffn_pre_g[c] * (1.f + mod[b * 12288 + 4 * 2048 + c]) + mod[b * 12288 + 3 * 2048 + c], 0.05f); }
        if (blockIdx.x >= 8 && blockIdx.x < 72) {
            const unsigned hb = hsh(blockIdx.x * 2654435761u + 99u); const int t = hb % NTOK; const int tid = threadIdx.x;
            if (tid < 64) { const float lgt = dg_dot((const h16*)(ws + A_H2) + (size_t)t * DM, a.w_router, DM, 64, tid); const float sc = 1.f / (1.f + expf(-lgt)); sc64[tid] = sc; bs64[tid] = sc + a.router_bias[tid]; }
            __syncthreads();
            if (tid == 0) { unsigned gsel = 0u; float bad = 0.f;
                for (int r = 0; r < 4; ++r) { int best = -1; float bv = -1e30f; for (int g = 0; g < 8; ++g) { if (gsel >> g & 1u) continue; float m1 = -1e30f, m2 = -1e30f; for (int j = 0; j < 8; ++j) { const float v = bs64[g * 8 + j]; if (v > m1) { m2 = m1; m1 = v; } else if (v > m2) m2 = v; } if (m1 + m2 > bv) { bv = m1 + m2; best = g; } } gsel |= 1u << best; }
                unsigned long long esel = 0ull; float wsum = 0.f;
                for (int r = 0; r < 6; ++r) { int best = -1; float bv = -1e30f; for (int e = 0; e < 64; ++e) { if (!(gsel >> (e >> 3) & 1u) || (esel >> e & 1ull)) continue; if (bs64[e] > bv) { bv = bs64[e]; best = e; } } esel |= 1ull << best; wsum += sc64[best];
                    const unsigned pk = ((const unsigned*)(ws + WS_TOKPOS))[(size_t)t * 6 + r]; const int ge = pk >> 20, slot = pk & 0xFFFFF; if (ge != best) bad += 1.f; else if (((const unsigned*)(ws + WS_LIST))[(size_t)ge * LISTCAP + slot] != (unsigned)t) bad += 1.f; }
                for (int r = 0; r < 6; ++r) { const unsigned pk = ((const unsigned*)(ws + WS_TOKPOS))[(size_t)t * 6 + r]; const int ge = pk >> 20; const float w = ((const float*)(ws + WS_TOKW))[(size_t)t * 6 + r]; if (fabsf(w - sc64[ge] / (wsum + 1e-20f) * 2.5f) > 0.01f) bad += 1.f; }
                atomicAdd((float*)(ctl + CW_DIAG + 11), bad / (64.f * 12.f)); }
        }
        if (gid == 0) { unsigned tot = 0; for (int e = 0; e < 64; ++e) tot += ctl[CW_CNT + 64 * e]; dg_put(ctl, 10, (float)tot, (float)(NTOK * 6), 1.0f); }
    } else if (phase == 9 || phase == 10) {
        const unsigned* cnt = ctl + CW_CNT;
        if (gid < 2048) { const int t = h0 % NTOK, k = h1v % 7; int e, slot; if (k == 6) { e = 64; slot = t; } else { const unsigned pk = ((const unsigned*)(ws + WS_TOKPOS))[(size_t)t * 6 + k]; e = pk >> 20; slot = pk & 0xFFFFF; }
            const size_t prow = (size_t)dg_tstart(cnt, e) * 256 + slot;
            if (phase == 9) { const int n = h2v % 512; const float* wg = e < 64 ? a.w_exp_gate + (size_t)e * DM * 512 : a.w_sh_gate; const float* wu = e < 64 ? a.w_exp_up + (size_t)e * DM * 512 : a.w_sh_up;
                const h16* hr = (const h16*)(ws + A_H2) + (size_t)t * DM; const float g = dg_dot(hr, wg, DM, 512, n), u = dg_dot(hr, wu, DM, 512, n);
                dg_put(ctl, 12, (float)((const h16*)(ws + A_ACT))[prow * 512 + n], g / (1.f + expf(-g)) * u, 0.05f); }
            else { const int n = h2v % DM; const float* wd = e < 64 ? a.w_exp_down + (size_t)e * 512 * DM : a.w_sh_down;
                dg_put(ctl, 13, (float)((const h16*)(ws + A_YS))[prow * DM + n], dg_dot((const h16*)(ws + A_ACT) + prow * 512, wd, 512, DM, n), 0.05f); } }
    } else if (phase == 100) {
        const int si = blockIdx.x; if (si < 64) { const int t = hsh(si * 31337u + 5u) % NTOK; float* sv = (float*)(ws + WS_SAVE) + (size_t)si * DM; for (int c = threadIdx.x; c < DM; c += 256) sv[c] = a.out[(size_t)t * DM + c]; }
    } else if (phase == 11) {
        const int si = blockIdx.x; if (si < 64) { const int t = hsh(si * 31337u + 5u) % NTOK, b = t >> 12; const unsigned* cnt = ctl + CW_CNT; const float* sv = (const float*)(ws + WS_SAVE) + (size_t)si * DM; const int tid = threadIdx.x;
            float vals[8]; float ss = 0.f;
#pragma unroll
            for (int q = 0; q < 8; ++q) { const int c = tid + 256 * q; float s_ = (float)((const h16*)(ws + A_YS))[((size_t)dg_tstart(cnt, 64) * 256 + t) * DM + c];
                for (int k = 0; k < 6; ++k) { const unsigned pk = ((const unsigned*)(ws + WS_TOKPOS))[(size_t)t * 6 + k]; const int e = pk >> 20, slot = pk & 0xFFFFF;
                    s_ += ((const float*)(ws + WS_TOKW))[(size_t)t * 6 + k] * (float)((const h16*)(ws + A_YS))[((size_t)dg_tstart(cnt, e) * 256 + slot) * DM + c]; }
                vals[q] = s_; ss += s_ * s_; }
            red[tid] = ss; __syncthreads(); if (tid == 0) { float tot = 0.f; for (int i = 0; i < 256; ++i) tot += red[i]; red[256] = tot; } __syncthreads();
            const float rstd = 1.f / sqrtf(red[256] / DM + EPS);
#pragma unroll
            for (int q = 0; q < 8; ++q) { const int c = tid + 256 * q; dg_put(ctl, 14, a.out[(size_t)t * DM + c], sv[c] + mod[b * 12288 + 5 * 2048 + c] * (vals[q] * rstd * a.ffn_post_g[c]), 0.05f); } }
    }
}
__global__ void __launch_bounds__(256) diag_final(Args a) {
    unsigned* ctl = (unsigned*)(a.ws + WS_CTL); int code = 0;
    for (int sl = 14; sl >= 0; --sl) { const float e = __uint_as_float(ctl[CW_DIAG + sl]); const float thr = (sl == 11) ? 0.08f : 0.03f; if (!(e <= thr)) code = sl + 1; }
    if (code == 0) return;
    const float f = 1.0f + 0.5f * (float)code;
    for (size_t i = (size_t)blockIdx.x * 256 + threadIdx.x; i < (size_t)NTOK * DM; i += (size_t)gridDim.x * 256) a.out[i] = a.x[i] * f;
}
#endif

extern "C" void kernel_launch(void* const* d_in, const int* in_sizes, int n_in, void* d_out, int out_size, void* d_ws, size_t ws_size, hipStream_t stream) {
    static int grid = 0;
    if (grid == 0) {
        if (n_in != 25 || in_sizes[0] != NTOK * DM || out_size != NTOK * DM || ws_size < WS_END) {
            fprintf(stderr, "kernel_launch: unexpected shapes / workspace (n_in %d, ws %zu, need %zu); nothing launched\n", n_in, ws_size, (size_t)WS_END); grid = -1; return; }
        int dev = 0, cus = 0, per_cu = 0;
        if (hipGetDevice(&dev) != hipSuccess || hipDeviceGetAttribute(&cus, hipDeviceAttributeMultiprocessorCount, dev) != hipSuccess) { grid = -1; return; }
        if (hipFuncSetAttribute((const void*)mk_fwd, hipFuncAttributeMaxDynamicSharedMemorySize, LDS_BYTES) != hipSuccess) { fprintf(stderr, "kernel_launch: hipFuncSetAttribute failed\n"); grid = -1; return; }
        if (hipOccupancyMaxActiveBlocksPerMultiprocessor(&per_cu, (const void*)mk_fwd, NTHR, LDS_BYTES) != hipSuccess || per_cu < 1)
            fprintf(stderr, "kernel_launch: note: occupancy query reports %d workgroups per CU\n", per_cu);
        (void)hipGetLastError();
        grid = cus;
    }
    if (grid < 0) return;
    if (hipMemsetAsync((char*)d_ws + WS_CTL, 0, CTL_ZERO_BYTES, stream) != hipSuccess) return;
    Args a{};
    a.x = (const float*)d_in[0]; a.c = (const float*)d_in[1]; a.pos = (const int*)d_in[2]; a.w_ada = (const float*)d_in[3]; a.b_ada = (const float*)d_in[4];
    a.attn_pre_g = (const float*)d_in[5]; a.w_in = (const float*)d_in[6]; a.q_a_norm_g = (const float*)d_in[7]; a.w_q_up = (const float*)d_in[8];
    a.kv_a_norm_g = (const float*)d_in[9]; a.w_kv_up = (const float*)d_in[10]; a.w_mla_o = (const float*)d_in[11]; a.w_dil_o = (const float*)d_in[12];
    a.w_out = (const float*)d_in[13]; a.attn_post_g = (const float*)d_in[14]; a.ffn_pre_g = (const float*)d_in[15]; a.w_router = (const float*)d_in[16];
    a.router_bias = (const float*)d_in[17]; a.w_exp_gate = (const float*)d_in[18]; a.w_exp_up = (const float*)d_in[19]; a.w_exp_down = (const float*)d_in[20];
    a.w_sh_gate = (const float*)d_in[21]; a.w_sh_up = (const float*)d_in[22]; a.w_sh_down = (const float*)d_in[23]; a.ffn_post_g = (const float*)d_in[24];
    a.out = (float*)d_out; a.ws = (unsigned char*)d_ws;
    for (int i = 0; i < 16; ++i) a.invf_d[i] = 1.0f / powf(500000.0f, (float)(2 * i) / 32.0f);
    for (int i = 0; i < 32; ++i) a.invf_m[i] = 1.0f / powf(500000.0f, (float)(2 * i) / 64.0f);
#if MK_LAUNCHES == 1
    a.ph_lo = 0; a.ph_hi = NPHASE;
    hipLaunchKernelGGL(mk_fwd, dim3(grid), dim3(NTHR), LDS_BYTES, stream, a);
#else
#ifndef MK_STOP
#define MK_STOP NPHASE
#endif
    for (int p = 0; p < MK_STOP; ++p) { a.ph_lo = p; a.ph_hi = p + 1;
#if MK_DIAG
        if (p == 11) hipLaunchKernelGGL(diag_check, dim3(256), dim3(256), 0, stream, a, 100);
#endif
        hipLaunchKernelGGL(mk_fwd, dim3(grid), dim3(NTHR), LDS_BYTES, stream, a);
#if MK_DIAG
        hipLaunchKernelGGL(diag_check, dim3(256), dim3(256), 0, stream, a, p);
#endif
    }
#if MK_DIAG
    hipLaunchKernelGGL(diag_final, dim3(1024), dim3(256), 0, stream, a);
#endif
#endif
}
```
